# Optimizing an MI355X kernel written in HIP

```python
import math
import jax, jax.numpy as jnp
from jax import lax
import numpy as np

D_MODEL = 2048
BATCH = 2
SEQ = 8192
DEPTH = 1

BLOCK = 128
N_META = 16
PAD = BLOCK - N_META
HEAD_DIM = 64
ATTN_WIDTH = D_MODEL // 2
N_Q_HEADS = ATTN_WIDTH // HEAD_DIM
N_KV_HEADS = N_Q_HEADS // 8
Q_PER_KV = N_Q_HEADS // N_KV_HEADS
KV_WIDTH = N_KV_HEADS * HEAD_DIM
WINDOW = 128
POOL_WINDOWS = (2, 4, 8, 16)
N_POOL_GROUPS = len(POOL_WINDOWS)
POOL_WIDTH = D_MODEL // 2
POOL_GROUP_WIDTH = POOL_WIDTH // N_POOL_GROUPS
N_BUCKETS = 32
MAX_DISTANCE = 128
N_GROUPS = 8
EXPERTS_PER_GROUP = 8
N_EXPERTS = N_GROUPS * EXPERTS_PER_GROUP
TOP_K = 2
D_EXPERT = D_MODEL // 4
MOE_BLOCK = 128
RMS_EPS = 1e-6
IN_WIDTH = ATTN_WIDTH + 2 * KV_WIDTH + POOL_WIDTH + 2 * D_MODEL

kernel_name = "hybrid_swa_pool_hmoe_block"


def rms_norm(x, g):
    xf = x.astype(jnp.float32)
    y = xf * lax.rsqrt(jnp.mean(xf * xf, axis=-1, keepdims=True) + RMS_EPS)
    return (y * g.astype(jnp.float32)).astype(x.dtype)


def t5_bucket(dist):
    max_exact = N_BUCKETS // 2
    d = jnp.maximum(dist, 0)
    large = max_exact + (jnp.log(jnp.maximum(d, 1).astype(jnp.float32) / max_exact)
                         / math.log(MAX_DISTANCE / max_exact) * (N_BUCKETS - max_exact)).astype(jnp.int32)
    large = jnp.minimum(large, N_BUCKETS - 1)
    return jnp.where(d < max_exact, d, large)


def sliding_window_attention(q, k, v, sinks, rel_bias):
    b, lp = q.shape[:2]
    nb = lp // BLOCK
    scale = HEAD_DIM ** -0.5
    qb = q.reshape(b, nb, BLOCK, N_KV_HEADS, Q_PER_KV, HEAD_DIM)
    kb = k.reshape(b, nb, BLOCK, N_KV_HEADS, HEAD_DIM)
    vb = v.reshape(b, nb, BLOCK, N_KV_HEADS, HEAD_DIM)
    zk = jnp.zeros_like(kb[:, :1])
    kwin = jnp.concatenate([jnp.concatenate([zk, kb[:, :-1]], axis=1), kb], axis=2)
    vwin = jnp.concatenate([jnp.concatenate([zk, vb[:, :-1]], axis=1), vb], axis=2)
    kmeta = k[:, PAD:BLOCK]
    vmeta = v[:, PAD:BLOCK]

    blk = jnp.arange(nb)[:, None, None]
    qi = jnp.arange(BLOCK)
    kj = jnp.arange(2 * BLOCK)
    q_pos = blk * BLOCK + qi[None, :, None]
    k_pos = (blk - 1) * BLOCK + kj[None, None, :]
    dist = q_pos - k_pos
    win_ok = (dist >= 0) & (dist < WINDOW) & (k_pos >= PAD)
    dist_local = qi[:, None] + BLOCK - kj[None, :]
    rb = rel_bias.astype(jnp.float32)
    win_bias = rb[t5_bucket(dist_local)].reshape(BLOCK, 2 * BLOCK, N_KV_HEADS, Q_PER_KV).transpose(2, 3, 0, 1)
    m_pos = PAD + jnp.arange(N_META)
    mdist = q_pos - m_pos[None, None, :]
    meta_ok = mdist >= WINDOW
    meta_bias = rb[t5_bucket(mdist)].reshape(nb, BLOCK, N_META, N_KV_HEADS, Q_PER_KV).transpose(0, 3, 4, 1, 2)

    s_win = jnp.einsum('bnqhgd,bnkhd->bnhgqk', qb, kwin).astype(jnp.float32) * scale + win_bias[None, None]
    s_win = jnp.where(win_ok[None, :, None, None], s_win, -jnp.inf)
    s_meta = jnp.einsum('bnqhgd,bmhd->bnhgqm', qb, kmeta).astype(jnp.float32) * scale + meta_bias[None]
    s_meta = jnp.where(meta_ok[None, :, None, None], s_meta, -jnp.inf)
    sink = sinks.astype(jnp.float32).reshape(N_KV_HEADS, Q_PER_KV)[None, None, :, :, None, None]
    mx = jnp.maximum(jnp.maximum(s_win.max(-1, keepdims=True), s_meta.max(-1, keepdims=True)), sink)
    p_win = jnp.exp(s_win - mx)
    p_meta = jnp.exp(s_meta - mx)
    denom = p_win.sum(-1, keepdims=True) + p_meta.sum(-1, keepdims=True) + jnp.exp(sink - mx)
    p_win = (p_win / denom).astype(v.dtype)
    p_meta = (p_meta / denom).astype(v.dtype)
    o = (jnp.einsum('bnhgqk,bnkhd->bnqhgd', p_win, vwin)
         + jnp.einsum('bnhgqm,bmhd->bnqhgd', p_meta, vmeta))
    return o.reshape(b, lp, ATTN_WIDTH)


def multiscale_pool(u, valid, w_group, scale):
    b, lp, _ = u.shape
    ug = (u.astype(jnp.float32) * valid[None, :, None]).reshape(b, lp, N_POOL_GROUPS, POOL_GROUP_WIDTH)
    c = jnp.cumsum(ug, axis=1)
    cnt = jnp.cumsum(valid.astype(jnp.float32))
    outs = []
    for gi, w in enumerate(POOL_WINDOWS):
        cp = jnp.pad(c[:, :, gi], ((0, 0), (w, 0), (0, 0)))
        win_sum = cp[:, w:] - cp[:, :lp]
        cntp = jnp.pad(cnt, (w, 0))
        n_valid = jnp.maximum(cntp[w:] - cntp[:lp], 1.0)
        outs.append(win_sum / n_valid[None, :, None] - ug[:, :, gi])
    mixed = jnp.stack(outs, axis=2).astype(u.dtype)
    y = jnp.einsum('bsgc,gcd->bsgd', mixed, w_group)
    return y.reshape(b, lp, POOL_WIDTH) * scale


def hierarchical_moe(x, w_rg, b_rg, w_re, b_re, w_gate, w_up, w_down):
    n, d = x.shape
    xf = x.astype(jnp.float32)
    g_logits = xf @ w_rg.astype(jnp.float32) + b_rg.astype(jnp.float32)
    g_prob = jax.nn.softmax(g_logits, axis=-1)
    grp = jnp.argmax(g_logits, axis=-1)
    p_grp = jnp.take_along_axis(g_prob, grp[:, None], axis=1)[:, 0]
    e_logits = (xf @ w_re.astype(jnp.float32) + b_re.astype(jnp.float32)).reshape(n, N_GROUPS, EXPERTS_PER_GROUP)
    e_in_grp = jnp.take_along_axis(e_logits, grp[:, None, None], axis=1)[:, 0]
    top_l, top_i = lax.top_k(e_in_grp, TOP_K)
    top_w = jax.nn.softmax(top_l, axis=-1) * p_grp[:, None]
    expert = grp[:, None] * EXPERTS_PER_GROUP + top_i

    a = n * TOP_K
    e_flat = expert.reshape(a)
    w_flat = top_w.reshape(a)
    tok = jnp.repeat(jnp.arange(n, dtype=jnp.int32), TOP_K)
    order = jnp.argsort(e_flat)
    e_sorted = e_flat[order]
    counts = jnp.bincount(e_flat, length=N_EXPERTS)
    starts = jnp.cumsum(counts) - counts
    padded = (counts + MOE_BLOCK - 1) // MOE_BLOCK * MOE_BLOCK
    pad_ends = jnp.cumsum(padded)
    pad_starts = pad_ends - padded
    dest = pad_starts[e_sorted] + (jnp.arange(a) - starts[e_sorted])
    n_blocks = a // MOE_BLOCK + N_EXPERTS
    slots = n_blocks * MOE_BLOCK
    slot_tok = jnp.full((slots,), n, jnp.int32).at[dest].set(tok[order])
    slot_w = jnp.zeros((slots,), x.dtype).at[dest].set(w_flat[order].astype(x.dtype))
    block_expert = jnp.minimum(jnp.searchsorted(pad_ends, jnp.arange(n_blocks) * MOE_BLOCK, side='right'),
                               N_EXPERTS - 1).astype(jnp.int32)
    x_pad = jnp.concatenate([x, jnp.zeros((1, d), x.dtype)], axis=0)

    def run_block(args):
        e, toks, ws = args
        xb = x_pad[toks]
        hb = jax.nn.silu(xb @ w_gate[e]) * (xb @ w_up[e])
        return (hb @ w_down[e]) * ws[:, None]

    yb = lax.map(run_block, (block_expert, slot_tok.reshape(n_blocks, MOE_BLOCK),
                             slot_w.reshape(n_blocks, MOE_BLOCK)))
    y = jax.ops.segment_sum(yb.reshape(slots, d), slot_tok, num_segments=n + 1)
    return y[:n]


def setup_inputs(seed: int = 0) -> dict:
    key = jax.random.key(seed)
    ks = jax.random.split(key, 20)

    def nrm(k, shape, s):
        return jax.random.normal(k, shape, jnp.float32) * s

    return {
        "x": nrm(ks[0], (BATCH, SEQ, D_MODEL), 1.0),
        "meta_tokens": nrm(ks[1], (N_META, D_MODEL), 1.0),
        "rel_bias": nrm(ks[2], (N_BUCKETS, N_Q_HEADS), 0.5),
        "norm_mix": 1.0 + nrm(ks[3], (DEPTH, D_MODEL), 0.02),
        "w_in": nrm(ks[4], (DEPTH, D_MODEL, IN_WIDTH), D_MODEL ** -0.5),
        "attn_sinks": nrm(ks[5], (DEPTH, N_Q_HEADS), 0.5),
        "pool_mix": nrm(ks[6], (DEPTH, N_POOL_GROUPS, POOL_GROUP_WIDTH, POOL_GROUP_WIDTH), POOL_GROUP_WIDTH ** -0.5),
        "pool_scale": 1.0 + nrm(ks[7], (DEPTH, POOL_WIDTH), 0.02),
        "w_attn_branch": nrm(ks[8], (DEPTH, ATTN_WIDTH, D_MODEL), ATTN_WIDTH ** -0.5),
        "w_pool_branch": nrm(ks[9], (DEPTH, POOL_WIDTH, D_MODEL), POOL_WIDTH ** -0.5),
        "w_out": nrm(ks[10], (DEPTH, D_MODEL, D_MODEL), D_MODEL ** -0.5),
        "norm_ffn": 1.0 + nrm(ks[11], (DEPTH, D_MODEL), 0.02),
        "w_router_group": nrm(ks[12], (DEPTH, D_MODEL, N_GROUPS), D_MODEL ** -0.5),
        "b_router_group": nrm(ks[13], (DEPTH, N_GROUPS), 0.01),
        "w_router_expert": nrm(ks[14], (DEPTH, D_MODEL, N_EXPERTS), D_MODEL ** -0.5),
        "b_router_expert": nrm(ks[15], (DEPTH, N_EXPERTS), 0.01),
        "w_gate": nrm(ks[16], (DEPTH, N_EXPERTS, D_MODEL, D_EXPERT), D_MODEL ** -0.5),
        "w_up": nrm(ks[17], (DEPTH, N_EXPERTS, D_MODEL, D_EXPERT), D_MODEL ** -0.5),
        "w_down": nrm(ks[18], (DEPTH, N_EXPERTS, D_EXPERT, D_MODEL), D_EXPERT ** -0.5),
        "norm_final": 1.0 + nrm(ks[19], (D_MODEL,), 0.02),
    }


def reference(x, meta_tokens, rel_bias, norm_mix, w_in, attn_sinks, pool_mix, pool_scale,
              w_attn_branch, w_pool_branch, w_out, norm_ffn, w_router_group, b_router_group,
              w_router_expert, b_router_expert, w_gate, w_up, w_down, norm_final):
    b, s, d = x.shape
    lead = jnp.concatenate([jnp.zeros((PAD, d), x.dtype), meta_tokens.astype(x.dtype)], axis=0)
    h = jnp.concatenate([jnp.broadcast_to(lead[None], (b, BLOCK, d)), x], axis=1)
    lp = s + BLOCK
    valid = jnp.arange(lp) >= PAD
    cuts = np.cumsum([ATTN_WIDTH, KV_WIDTH, KV_WIDTH, POOL_WIDTH, D_MODEL]).tolist()
    for layer in range(DEPTH):
        hn = rms_norm(h, norm_mix[layer])
        proj = hn @ w_in[layer]
        q, k, v, u, g_a, g_p = jnp.split(proj, cuts, axis=-1)
        attn = sliding_window_attention(q.reshape(b, lp, N_Q_HEADS, HEAD_DIM),
                                        k.reshape(b, lp, N_KV_HEADS, HEAD_DIM),
                                        v.reshape(b, lp, N_KV_HEADS, HEAD_DIM),
                                        attn_sinks[layer], rel_bias)
        pool = multiscale_pool(u, valid, pool_mix[layer], pool_scale[layer])
        merged = (jax.nn.sigmoid(g_a) * (attn @ w_attn_branch[layer])
                  + jax.nn.sigmoid(g_p) * (pool @ w_pool_branch[layer]))
        h = h + merged @ w_out[layer]

        hv = h[:, PAD:]
        hn2 = rms_norm(hv, norm_ffn[layer]).reshape(b * (lp - PAD), d)
        ffn = hierarchical_moe(hn2, w_router_group[layer], b_router_group[layer],
                               w_router_expert[layer], b_router_expert[layer],
                               w_gate[layer], w_up[layer], w_down[layer])
        h = h.at[:, PAD:].add(ffn.reshape(b, lp - PAD, d))
    return rms_norm(h[:, BLOCK:], norm_final)
```

```cpp
#include <hip/hip_runtime.h>
#include <cstdio>
#include <cstdint>

#define GAS __attribute__((address_space(1)))
#define LAS __attribute__((address_space(3)))
typedef unsigned short bf16;
typedef short bf16x8 __attribute__((ext_vector_type(8)));
typedef float f32x2 __attribute__((ext_vector_type(2)));
typedef float f32x4 __attribute__((ext_vector_type(4)));
typedef float f32x16 __attribute__((ext_vector_type(16)));
typedef unsigned u32x2 __attribute__((ext_vector_type(2)));
typedef unsigned u32x4 __attribute__((ext_vector_type(4)));
typedef int i32x4 __attribute__((ext_vector_type(4)));

#ifndef MK_LAUNCHES
#define MK_LAUNCHES 1
#endif
#ifndef PROBE_DUP
#define PROBE_DUP -1
#endif
#ifndef PROBE_SUB
#define PROBE_SUB 0
#endif
constexpr int NPHASE = 9;

constexpr int DM = 2048, SEQ = 8192, M = 16384;
constexpr int NMETA = 16, MROWS = M + 256;
constexpr int INW = 6400, KOFF = 1024, VOFF = 1152, UOFF = 1280, GAOFF = 2304, GPOFF = 4352;
constexpr int PW = 2304, GW = 4096;
constexpr int NEXP = 64, DEXP = 512, CAP = 16384;
constexpr float RMS_EPS = 1e-6f;

constexpr size_t MiB = 1u << 20;
constexpr size_t WS_CTL = 0, CTL_ZERO_BYTES = 1 * MiB;
constexpr size_t WS_WIN = 1 * MiB;
constexpr size_t WS_WAB = 26 * MiB;
constexpr size_t WS_WPT = 34 * MiB;
constexpr size_t WS_WO = 38 * MiB;
constexpr size_t WS_PMS = 46 * MiB;
constexpr size_t WS_WR = 46 * MiB + 512 * 1024;
constexpr size_t WS_SSQ = 47 * MiB;
constexpr size_t WS_LTOK = 49 * MiB, WS_LR = 53 * MiB, WS_LW = 57 * MiB;
constexpr size_t WS_TINFO = 61 * MiB;
constexpr size_t WS_WGU = 64 * MiB;
constexpr size_t WS_WIN8 = 13 * MiB;
constexpr size_t WS_HN8 = 416 * MiB;
constexpr size_t WS_H8 = 384 * MiB;
constexpr size_t WS_WD = 320 * MiB;
constexpr size_t WS_HN = 448 * MiB;
constexpr size_t WS_PROJ = 513 * MiB;
constexpr size_t WS_GATE = 593 * MiB;
constexpr size_t WS_AP = 717 * MiB;
constexpr size_t WS_H1 = 781 * MiB;
constexpr size_t WS_END = 909 * MiB;
constexpr int CW_TMO = 0, CW_CNT = 1024  , CW_BAR = 4096;

constexpr int RING_BYTES = 131072, RING_OFF = 512;
constexpr int L_MISC = RING_OFF + RING_BYTES;
constexpr int L_ESTART = L_MISC + 256;
constexpr int L_TSTART = L_ESTART + 320;
constexpr int L_UD = L_TSTART + 320;
constexpr int L_TAB = L_UD + 256;
constexpr int L_CVT = L_TAB + 8192;
constexpr int LDS_BYTES = 157696;
static_assert(L_CVT + 16384 <= LDS_BYTES && LDS_BYTES <= 163840, "LDS map");

#define LDS_WAIT() asm volatile("s_waitcnt lgkmcnt(0)" ::: "memory")
#define VM_WAIT() asm volatile("s_waitcnt vmcnt(0)" ::: "memory")
__device__ __forceinline__ unsigned cvt_pk_bf16(float lo, float hi) { unsigned r; asm volatile("v_cvt_pk_bf16_f32 %0, %1, %2" : "=v"(r) : "v"(lo), "v"(hi)); return r; }
__device__ __forceinline__ float bf_lo(unsigned w) { return __uint_as_float(w << 16); }
__device__ __forceinline__ float bf_hi(unsigned w) { return __uint_as_float(w & 0xffff0000u); }
__device__ __forceinline__ float sigmoidf_(float x) { return __builtin_amdgcn_rcpf(1.0f + __expf(-x)); }

namespace pg8 {
constexpr int BM = 256, BK = 64, HALF = 128, HTB = HALF * BK * 2, STAGE_BYTES = 8 * HTB, NXCD = 8, WGM = 8;
__host__ __device__ __forceinline__ int lds_byte(int r, int c) { const int st = (r >> 4) * 2 + (c >> 5), rr = r & 15, cc = c & 31, ob = rr * 64 + cc * 2; return st * 1024 + (ob ^ (((ob >> 9) & 1) << 5)); }
__host__ __device__ __forceinline__ void stage_rc(int b, int& R, int& C) { const int st = b / 1024, sb = b % 1024, swz = sb ^ (((sb >> 9) & 1) << 5); R = (st >> 1) * 16 + swz / 64; C = (st & 1) * 32 + (swz % 64) / 2; }
__host__ __device__ __forceinline__ int perm32(int rho) { const int n = rho >> 4, i = rho & 15; return 8 * (i >> 2) + 4 * n + (i & 3); }

struct Unit { const char* a; const char* b; int pm, pn, x0, x1; };

__device__ __forceinline__ void tile_of(int L, int nM, int nN, int& pm, int& pn) {
    const int nwg = nM * nN; int wgid = L;
    { const int q = nwg / NXCD, r = nwg % NXCD, xcd = wgid % NXCD, off = wgid / NXCD; wgid = (xcd < r ? xcd * (q + 1) : r * (q + 1) + (xcd - r) * q) + off; }
    const int nig = WGM * nN, gid = wgid / nig, fm = gid * WGM, gsz = (nM - fm) < WGM ? (nM - fm) : WGM;
    pm = fm + ((wgid % nig) % gsz); pn = (wgid % nig) / gsz;
}

typedef int i32x8 __attribute__((ext_vector_type(8)));
template <class Epi, class Sched, bool GATHER, bool HALFSKIP = false, bool FP8 = false>
__device__ __forceinline__ void gemm_phase(LAS unsigned char* lds, const int lda, const int ldb, const int K, const Sched& S, const Epi& E, LAS const unsigned* rowtab  ) {
    const int tid = threadIdx.x, wid = __builtin_amdgcn_readfirstlane(tid >> 6), lane = tid & 63, wr = wid >> 2, wc = wid & 3, fr = lane & 15, fq = lane >> 4;
    const int nt = K / BK;
    unsigned voffB[2], voffBh[2], cv0[2], cv1[2], nv0[2], nv1[2]; int Rr[2]; unsigned Cc[2];
#pragma unroll
    for (int i = 0; i < 2; ++i) { int R, C; stage_rc(tid * 16 + i * 8192, R, C); const int Rb = (R & ~31) + perm32(R & 31);
        voffB[i] = (unsigned)(Rb * ldb + C) * 2u; voffBh[i] = voffB[i] + (unsigned)(HALF * ldb) * 2u; Rr[i] = R; Cc[i] = (unsigned)C * 2u;
        cv0[i] = (unsigned)(R * lda + C) * 2u; cv1[i] = cv0[i] + (unsigned)(HALF * lda) * 2u; nv0[i] = cv0[i]; nv1[i] = cv1[i]; }
    const size_t kstep = (size_t)(BK * 2);
    const unsigned ldsw = (unsigned)wid * 1024u;
    const int aoff = lds_byte(wr * 64 + fr, fq * 8), boff = lds_byte(wc * 32 + fr, fq * 8);
#define PG8_SA(b, h) (((b) * 2 + (h)) * HTB)
#define PG8_SB(b, h) ((4 + (b) * 2 + (h)) * HTB)
#define PG8_STAGE2O(bufoff, gbase, v0, v1, OFF) do { \
        __builtin_amdgcn_global_load_lds((const unsigned*)((const char*)(gbase) + (v0)), (LAS unsigned*)(lds + ((bufoff) - (OFF)) + ldsw), 16, OFF, 0); \
        __builtin_amdgcn_global_load_lds((const unsigned*)((const char*)(gbase) + (v1)), (LAS unsigned*)(lds + ((bufoff) - (OFF)) + ldsw + 8192), 16, OFF, 0); } while (0)
#define PG8_STAGE2(bufoff, gbase, v0, v1) PG8_STAGE2O(bufoff, gbase, v0, v1, 0)
#define PG8_STAGEB(bufoff, gbase) PG8_STAGE2(bufoff, gbase, voffB[0], voffB[1])
#define PG8_STAGEBO(bufoff, gbase, OFF) PG8_STAGE2O(bufoff, gbase, voffB[0], voffB[1], OFF)
#define PG8_STAGEBH(bufoff, gbase, OFF) PG8_STAGE2O(bufoff, gbase, voffBh[0], voffBh[1], OFF)
#define PG8_LDA(dst, b, h) do { if constexpr (FP8) { _Pragma("unroll") for (int m = 0; m < 4; ++m) dst##8[m] = *(const LAS i32x8*)(lds + PG8_SA(b, h) + aoff8 + m * 2048); } \
        else { _Pragma("unroll") for (int m = 0; m < 4; ++m) _Pragma("unroll") for (int k = 0; k < 2; ++k) dst[m][k] = *(const LAS bf16x8*)(lds + PG8_SA(b, h) + aoff + m * 2048 + k * 1024); } } while (0)
#define PG8_LDB(dst, b, h) do { if constexpr (FP8) { _Pragma("unroll") for (int n = 0; n < 2; ++n) dst##8[n] = *(const LAS i32x8*)(lds + PG8_SB(b, h) + boff8 + n * 2048); } \
        else { _Pragma("unroll") for (int n = 0; n < 2; ++n) _Pragma("unroll") for (int k = 0; k < 2; ++k) dst[n][k] = *(const LAS bf16x8*)(lds + PG8_SB(b, h) + boff + n * 2048 + k * 1024); } } while (0)
#define PG8_MMA(ai, bj, At, Bt) do { __builtin_amdgcn_s_setprio(1); \
        if constexpr (FP8) { _Pragma("unroll") for (int m = 0; m < 4; ++m) _Pragma("unroll") for (int n = 0; n < 2; ++n) \
            asm volatile("v_mfma_scale_f32_16x16x128_f8f6f4 %0, %1, %2, %0, %3, %3 op_sel_hi:[0,0,0]" : "+v"(acc[ai][bj][m][n]) : "v"(Bt##8[n]), "v"(At##8[m]), "v"(mxscale)); } \
        else { _Pragma("unroll") for (int m = 0; m < 4; ++m) _Pragma("unroll") for (int n = 0; n < 2; ++n) _Pragma("unroll") for (int k = 0; k < 2; ++k) \
            acc[ai][bj][m][n] = __builtin_amdgcn_mfma_f32_16x16x32_bf16(Bt[n][k], At[m][k], acc[ai][bj][m][n], 0, 0, 0); } __builtin_amdgcn_s_setprio(0); } while (0)
#define PG8_WAIT_V(n) asm volatile("s_waitcnt vmcnt(" #n ")" ::: "memory")
#define PG8_WAIT_L(n) asm volatile("s_waitcnt lgkmcnt(" #n ")" ::: "memory")
#define PG8_BAR __builtin_amdgcn_s_barrier()
#define PG8_SCHED __builtin_amdgcn_sched_barrier(0)
    Unit cur, nxt; int ui = 0;
    if (!S.next(0, cur)) return;
    if constexpr (GATHER) {
#pragma unroll
        for (int i = 0; i < 2; ++i) { cv0[i] = rowtab[Rr[i]] + Cc[i]; cv1[i] = rowtab[HALF + Rr[i]] + Cc[i]; }
    }
    f32x4 acc[2][2][4][2];
#pragma unroll
    for (int a = 0; a < 2; ++a)
#pragma unroll
        for (int b = 0; b < 2; ++b)
#pragma unroll
            for (int m = 0; m < 4; ++m)
#pragma unroll
                for (int n = 0; n < 2; ++n) acc[a][b][m][n] = (f32x4){0.f, 0.f, 0.f, 0.f};
    bf16x8 At[4][2], B0[2][2], B1[2][2];
    i32x8 At8[4], B08[2], B18[2];
    const int mxscale = 0x7f7f7f7f;
    const int aoff8 = ((fq >> 1) * 1024) + (((wr * 64 + fr) & 15) * 64 + (fq & 1) * 32 ^ (((((wr * 64 + fr) & 15) * 64) >> 9) & 1) << 5) + (((wr * 64 + fr) >> 4) * 2048);
    const int boff8 = ((fq >> 1) * 1024) + (((wc * 32 + fr) & 15) * 64 + (fq & 1) * 32 ^ (((((wc * 32 + fr) & 15) * 64) >> 9) & 1) << 5) + (((wc * 32 + fr) >> 4) * 2048);
    const char* cA = cur.a; const char* cB = cur.b;
    PG8_STAGEBO(PG8_SB(0, 0), cB, 0); PG8_STAGEBH(PG8_SB(0, 1), cB, 0); PG8_STAGE2(PG8_SA(0, 0), cA, cv0[0], cv0[1]); PG8_STAGE2(PG8_SA(0, 1), cA, cv1[0], cv1[1]);
    if (wr == 1) PG8_BAR;
    PG8_WAIT_V(2); PG8_BAR;
    PG8_STAGEBO(PG8_SB(1, 0), cB, 128); PG8_STAGE2O(PG8_SA(1, 0), cA, cv0[0], cv0[1], 128); PG8_STAGEBH(PG8_SB(1, 1), cB, 128);
    PG8_WAIT_V(6); PG8_BAR;
    for (;;) {
        const bool has_next = S.next(ui + 1, nxt);
        const bool skip_hi = HALFSKIP && cur.x0 <= 128;
        const char* nA = has_next ? nxt.a : cA; const char* nB = has_next ? nxt.b : cB;
        if constexpr (GATHER) {
            if (has_next) {
#pragma unroll
                for (int i = 0; i < 2; ++i) { nv0[i] = rowtab[(ui + 1) * 256 + Rr[i]] + Cc[i]; nv1[i] = rowtab[(ui + 1) * 256 + HALF + Rr[i]] + Cc[i]; }
            } else {
#pragma unroll
                for (int i = 0; i < 2; ++i) { nv0[i] = cv0[i]; nv1[i] = cv1[i]; }
            }
        }
#pragma unroll 1
        for (int t = 0; t < nt; t += 2) {
            const bool last = (t == nt - 2);
            if constexpr (Epi::HAS_MID) { if (t == Epi::MID_T) E.mid(acc, cur, wr, wc, fr, fq); }
            const char* pA = cA + (size_t)t * kstep; const char* pB = cB + (size_t)t * kstep;
            const char* qA = last ? nA - 256 : pA; const char* qB = last ? nB - 256 : pB;
            unsigned x00, x01, x10, x11;
            if constexpr (GATHER) { x00 = last ? nv0[0] : cv0[0]; x01 = last ? nv0[1] : cv0[1]; x10 = last ? nv1[0] : cv1[0]; x11 = last ? nv1[1] : cv1[1]; }
            else { x00 = cv0[0]; x01 = cv0[1]; x10 = cv1[0]; x11 = cv1[1]; }
            PG8_LDB(B0, 0, 0); PG8_LDB(B1, 0, 1); PG8_SCHED; PG8_LDA(At, 0, 0); PG8_STAGE2O(PG8_SA(1, 1), pA, cv1[0], cv1[1], 128);
            PG8_WAIT_V(8); PG8_WAIT_L(0); PG8_BAR; PG8_MMA(0, 0, At, B0); PG8_MMA(0, 1, At, B1); PG8_BAR; PG8_SCHED;
            PG8_LDA(At, 0, 1); PG8_STAGEBO(PG8_SB(0, 0), qB, 256); PG8_STAGEBH(PG8_SB(0, 1), qB, 256); PG8_STAGE2O(PG8_SA(0, 0), qA, x00, x01, 256);
            PG8_WAIT_V(8); PG8_WAIT_L(0); PG8_BAR; if (!skip_hi) { PG8_MMA(1, 0, At, B0); PG8_MMA(1, 1, At, B1); } PG8_BAR; PG8_SCHED;
            PG8_LDB(B0, 1, 0); PG8_LDB(B1, 1, 1); PG8_SCHED; PG8_LDA(At, 1, 0); PG8_STAGE2O(PG8_SA(0, 1), qA, x10, x11, 256);
            PG8_WAIT_V(8); PG8_WAIT_L(0); PG8_BAR; PG8_MMA(0, 0, At, B0); PG8_MMA(0, 1, At, B1); PG8_BAR; PG8_SCHED;
            PG8_LDA(At, 1, 1); PG8_STAGEBO(PG8_SB(1, 0), qB, 384); PG8_STAGEBH(PG8_SB(1, 1), qB, 384); PG8_STAGE2O(PG8_SA(1, 0), qA, x00, x01, 384);
            PG8_WAIT_V(8); PG8_WAIT_L(0); PG8_BAR; if (!skip_hi) { PG8_MMA(1, 0, At, B0); PG8_MMA(1, 1, At, B1); } PG8_BAR; PG8_SCHED;
        }
        if (wr == 0) PG8_BAR;
        if constexpr (FP8) asm volatile("s_nop 15\n\ts_nop 15" ::: "memory");
        E(acc, cur, ui, wr, wc, fr, fq);
        if constexpr (Epi::HAS_POST) E.post(ui);
        if (!has_next) break;
#pragma unroll
        for (int a = 0; a < 2; ++a)
#pragma unroll
            for (int b = 0; b < 2; ++b)
#pragma unroll
                for (int m = 0; m < 4; ++m)
#pragma unroll
                    for (int n = 0; n < 2; ++n) acc[a][b][m][n] = (f32x4){0.f, 0.f, 0.f, 0.f};
        cur = nxt; cA = nA; cB = nB; ++ui;
        if constexpr (GATHER) {
#pragma unroll
            for (int i = 0; i < 2; ++i) { cv0[i] = nv0[i]; cv1[i] = nv1[i]; }
        }
        if (wr == 1) PG8_BAR;
    }
    PG8_WAIT_V(0);
    PG8_BAR;
#undef PG8_SA
#undef PG8_SB
#undef PG8_STAGE2
#undef PG8_STAGE2O
#undef PG8_STAGEB
#undef PG8_STAGEBO
#undef PG8_STAGEBH
#undef PG8_LDA
#undef PG8_LDB
#undef PG8_MMA
#undef PG8_WAIT_V
#undef PG8_WAIT_L
#undef PG8_BAR
#undef PG8_SCHED
}
}

#define XB_TMO      128
#define XB_XCNT(j)  (256  + 64 * (j))
#define XB_XSUB(j)  (1280 + 64 * (j))
#define XB_XGEN(j)  (2304 + 64 * (j))
#define XB_TOP      3328
#define XB_TOPGEN   3392
#define XCD_BAR_WORDS 3456
#define XB_SPIN_CAP (1u << 18)

__device__ __forceinline__ unsigned xb_ld(unsigned* p)              { return __hip_atomic_load(p, __ATOMIC_RELAXED, __HIP_MEMORY_SCOPE_AGENT); }
__device__ __forceinline__ unsigned xb_add(unsigned* p, unsigned v) { return __hip_atomic_fetch_add(p, v, __ATOMIC_RELAXED, __HIP_MEMORY_SCOPE_AGENT); }
__device__ __forceinline__ unsigned xb_xcc_id() { return (unsigned)__builtin_amdgcn_s_getreg((3 << 11) | 20) & 0xFu; }
#define XB_SPIN(cond, bar) do { unsigned _sp = 0; while (cond) { __builtin_amdgcn_s_sleep(1); \
    if ((++_sp & 255u) == 0u) { if (xb_ld(&(bar)[XB_TMO])) break; if (_sp > XB_SPIN_CAP) { atomicAdd(&(bar)[XB_TMO], 1u); break; } } } } while (0)

struct XcdBarrier {
    unsigned* bar; unsigned x;
    volatile LAS unsigned* st;
};

__device__ __forceinline__ XcdBarrier xcd_barrier_post(unsigned* bar, volatile LAS unsigned* st) {
    XcdBarrier b; b.bar = bar; b.x = xb_xcc_id(); b.st = st;
    if (threadIdx.x == 0) (void)xb_add(&bar[XB_XCNT(b.x)], 1u);
    return b;
}
__device__ __forceinline__ void xcd_barrier_complete(unsigned* bar, unsigned x, unsigned& nloc, unsigned& nx) {
    const unsigned G = gridDim.x * gridDim.y * gridDim.z;
    unsigned sum, cnt, mine, sp = 0u;
    for (;;) {
        sum = 0u; cnt = 0u; mine = 0u;
#pragma unroll
        for (unsigned j = 0; j < 16; ++j) { const unsigned c = xb_ld(&bar[XB_XCNT(j)]); sum += c; cnt += (c > 0u) ? 1u : 0u; mine = (j == x) ? c : mine; }
        if (sum == G) break;
        __builtin_amdgcn_s_sleep(1);
        if ((++sp & 255u) == 0u) { if (xb_ld(&bar[XB_TMO])) break; if (sp > XB_SPIN_CAP) { atomicAdd(&bar[XB_TMO], 1u); break; } }
    }
    nloc = mine > 0u ? mine : 1u; nx = cnt > 0u ? cnt : 1u;
}

__device__ __forceinline__ void xcd_barrier(const XcdBarrier& b) {
    asm volatile("s_waitcnt vmcnt(0)" ::: "memory");
    __syncthreads();
    if (threadIdx.x == 0) {
        unsigned* bar = b.bar;
        __builtin_amdgcn_s_waitcnt(0);
        unsigned nloc = b.st[0], nx = b.st[1];
        if (nloc == 0u) { xcd_barrier_complete(bar, b.x, nloc, nx); b.st[0] = nloc; b.st[1] = nx; }
        const unsigned old = xb_add(&bar[XB_XSUB(b.x)], 1u);
        const unsigned gen = old / nloc;
        if (old + 1u == (gen + 1u) * nloc) {
            __builtin_amdgcn_fence(__ATOMIC_RELEASE, "agent");
            asm volatile("s_waitcnt vmcnt(0)" ::: "memory");
            const unsigned og = xb_add(&bar[XB_TOP], 1u);
            const unsigned tg = og / nx;
            if (og + 1u == (tg + 1u) * nx) xb_add(&bar[XB_TOPGEN], 1u);
            else XB_SPIN(xb_ld(&bar[XB_TOPGEN]) == tg, bar);
            __builtin_amdgcn_fence(__ATOMIC_ACQUIRE, "agent");
            xb_add(&bar[XB_XGEN(b.x)], 1u);
            asm volatile("s_waitcnt vmcnt(0)" ::: "memory");
        } else {
            XB_SPIN(xb_ld(&bar[XB_XGEN(b.x)]) == gen, bar);
            __builtin_amdgcn_fence(__ATOMIC_ACQUIRE, "agent");
            asm volatile("s_waitcnt vmcnt(0)" ::: "memory");
        }
    }
    __syncthreads();
}

constexpr int NWAVES = 8;
struct Args { const float* in[20]; float* out; unsigned char* ws; int ph_lo, ph_hi; };
enum { I_X = 0, I_META, I_RELB, I_NMIX, I_WIN, I_SINK, I_PMIX, I_PSCL, I_WAB, I_WPB, I_WOUT, I_NFFN, I_WRG, I_BRG, I_WRE, I_BRE, I_WG, I_WU, I_WD, I_NFIN };
struct Frame {
    LAS unsigned char* lds;
    volatile LAS unsigned* MISC;
    unsigned* ctl;
    int tid, lane, wave, vcu, G;
    unsigned char* ws;
#define WSP(name, T, off) __device__ __forceinline__ T* name() const { return (T*)(ws + (off)); }
    WSP(WIN, bf16, WS_WIN) WSP(WAB, bf16, WS_WAB) WSP(WPT, bf16, WS_WPT) WSP(WO, bf16, WS_WO) WSP(PMS, bf16, WS_PMS) WSP(WR, bf16, WS_WR) WSP(WGU, bf16, WS_WGU) WSP(WD, bf16, WS_WD)
    WSP(HN, bf16, WS_HN) WSP(PROJ, bf16, WS_PROJ) WSP(AP, bf16, WS_AP) WSP(MERGED, bf16, WS_HN) WSP(H1B, bf16, WS_AP) WSP(HID, bf16, WS_HN) WSP(Y, bf16, WS_PROJ)
    WSP(SSQ, float, WS_SSQ) WSP(H1, float, WS_H1) WSP(LR, float, WS_LR) WSP(LW, float, WS_LW) WSP(LTOK, int, WS_LTOK) WSP(TINFO, i32x4, WS_TINFO) WSP(GATE, unsigned char, WS_GATE) WSP(H8, unsigned char, WS_H8) WSP(HN8, unsigned char, WS_HN8) WSP(WIN8, unsigned char, WS_WIN8)
#undef WSP
};

__device__ __forceinline__ float wave_sum(float v) {
#pragma unroll
    for (int o = 1; o < 64; o <<= 1) v += __shfl_xor(v, o);
    return v;
}

template <bool SCALE>
__device__ __forceinline__ void p0_item(const float* W, int N, int k0, int n0, bf16* WT, int ldt, int wrow0, const float* ks, LAS float* scr, int lane) {
#pragma unroll 8
    for (int i = 0; i < 32; ++i) { const int kk = 2 * i + (lane >> 5); float v = W[(size_t)(k0 + kk) * N + n0 + (lane & 31)]; if constexpr (SCALE) v *= ks[k0 + kk]; scr[kk * 33 + (lane & 31)] = v; }
    LDS_WAIT(); asm volatile("" ::: "memory");
    const int c = lane & 7;
#pragma unroll
    for (int j = 0; j < 4; ++j) { const int n = (lane >> 3) + 8 * j; const LAS float* s = scr + (8 * c) * 33 + n;
        u32x4 o; o.x = cvt_pk_bf16(s[0 * 33], s[1 * 33]); o.y = cvt_pk_bf16(s[2 * 33], s[3 * 33]); o.z = cvt_pk_bf16(s[4 * 33], s[5 * 33]); o.w = cvt_pk_bf16(s[6 * 33], s[7 * 33]);
        *(u32x4*)(WT + (size_t)(wrow0 + n) * ldt + k0 + 8 * c) = o; }
    LDS_WAIT(); asm volatile("" ::: "memory");
}
__device__ __forceinline__ void p0_item8(const float* W, int N, int k0, int n0, unsigned char* WT, int ldt, int wrow0, float scl, LAS float* scr, int lane) {
#pragma unroll 8
    for (int i = 0; i < 32; ++i) { const int kk = 2 * i + (lane >> 5); scr[kk * 33 + (lane & 31)] = W[(size_t)(k0 + kk) * N + n0 + (lane & 31)] * scl; }
    LDS_WAIT(); asm volatile("" ::: "memory");
    const int c = lane & 7;
#pragma unroll
    for (int j = 0; j < 4; ++j) { const int n = (lane >> 3) + 8 * j; const LAS float* s = scr + (8 * c) * 33 + n;
        int p0 = __builtin_amdgcn_cvt_pk_fp8_f32(s[0 * 33], s[1 * 33], 0, false); p0 = __builtin_amdgcn_cvt_pk_fp8_f32(s[2 * 33], s[3 * 33], p0, true);
        int p1 = __builtin_amdgcn_cvt_pk_fp8_f32(s[4 * 33], s[5 * 33], 0, false); p1 = __builtin_amdgcn_cvt_pk_fp8_f32(s[6 * 33], s[7 * 33], p1, true);
        *(u32x2*)(WT + (size_t)(wrow0 + n) * ldt + k0 + 8 * c) = (u32x2){(unsigned)p0, (unsigned)p1}; }
    LDS_WAIT(); asm volatile("" ::: "memory");
}
__device__ __forceinline__ void rms_row_to_bf16(const float* xrow, const float* g, bf16* orow, unsigned char* o8row, int lane) {
    const f32x4* xr = (const f32x4*)xrow + lane; const f32x4* gr = (const f32x4*)g + lane;
    f32x4 v[8]; float s = 0.f;
#pragma unroll
    for (int j = 0; j < 8; ++j) { v[j] = xr[64 * j]; s += (v[j].x * v[j].x + v[j].y * v[j].y) + (v[j].z * v[j].z + v[j].w * v[j].w); }
    const float r = 1.0f / sqrtf(wave_sum(s) * (1.0f / DM) + RMS_EPS);
    u32x2* o8 = (u32x2*)orow + lane;
#pragma unroll
    for (int j = 0; j < 8; ++j) { const f32x4 gg = gr[64 * j]; const float y0 = v[j].x * r * gg.x, y1 = v[j].y * r * gg.y, y2 = v[j].z * r * gg.z, y3 = v[j].w * r * gg.w;
        u32x2 w; w.x = cvt_pk_bf16(y0, y1); w.y = cvt_pk_bf16(y2, y3); o8[64 * j] = w;
        if (o8row) { const float z0 = __builtin_fminf(__builtin_fmaxf(y0 * 8.0f, -448.0f), 448.0f), z1 = __builtin_fminf(__builtin_fmaxf(y1 * 8.0f, -448.0f), 448.0f), z2 = __builtin_fminf(__builtin_fmaxf(y2 * 8.0f, -448.0f), 448.0f), z3 = __builtin_fminf(__builtin_fmaxf(y3 * 8.0f, -448.0f), 448.0f);
            int p = __builtin_amdgcn_cvt_pk_fp8_f32(z0, z1, 0, false); p = __builtin_amdgcn_cvt_pk_fp8_f32(z2, z3, p, true); ((unsigned*)o8row)[lane + 64 * j] = (unsigned)p; } }
}
__device__ __forceinline__ void p0_prologue(Frame& F, const Args& A) {
    LAS float* scr = (LAS float*)(F.lds + F.wave * 16384);
    const int gw = F.vcu * NWAVES + F.wave, NGW = F.G * NWAVES, lane = F.lane;
    constexpr int I_IN = 32 * 200, I_AB = 16 * 64, I_PB = 16 * 64, I_WO = 32 * 64;
    constexpr int NITEMS = I_IN + I_AB + I_PB + I_WO;
    for (int it = gw; it < NITEMS; it += NGW) {
        int r = it;
        if (r < I_IN) { const int kb = r / 200, nb = r % 200;
            if (nb < 72) p0_item<false>(A.in[I_WIN], INW, 64 * kb, 32 * nb, F.WIN(), 2048, 32 * nb, nullptr, scr, lane);
            else p0_item8(A.in[I_WIN], INW, 64 * kb, 32 * nb, F.WIN8(), 2048, 32 * (nb - 72), 1024.0f, scr, lane);
            continue; } r -= I_IN;
        if (r < I_AB) { const int kb = r >> 6, nb = r & 63; p0_item<false>(A.in[I_WAB], 2048, 64 * kb, 32 * nb, F.WAB(), 2048, 32 * nb, nullptr, scr, lane); continue; } r -= I_AB;
        if (r < I_PB) { const int kb = r >> 6, nb = r & 63; p0_item<false>(A.in[I_WPB], 2048, 64 * kb, 32 * nb, F.WPT(), 1024, 32 * nb, nullptr, scr, lane); continue; } r -= I_PB;
        { const int kb = r >> 6, nb = r & 63; p0_item<false>(A.in[I_WOUT], 2048, 64 * kb, 32 * nb, F.WO(), 2048, 32 * nb, nullptr, scr, lane); }
    }
    const int gt = F.vcu * (NWAVES * 64) + F.tid, NGT = F.G * NWAVES * 64;
    for (int i = gt; i < 4 * 256 * 256 / 2; i += NGT) { const int e = 2 * i, g = e >> 16, j = e & 255; const float s0 = A.in[I_PSCL][g * 256 + j], s1 = A.in[I_PSCL][g * 256 + j + 1];
        ((unsigned*)F.PMS())[i] = cvt_pk_bf16(A.in[I_PMIX][e] * s0, A.in[I_PMIX][e + 1] * s1); }
    for (int i = gt; i < 80 * 2048; i += NGT) { const int n = i >> 11, k = i & 2047; float v = 0.f;
        if (n < 8) v = A.in[I_WRG][k * 8 + n] * A.in[I_NFFN][k]; else if (n < 72) v = A.in[I_WRE][k * 64 + (n - 8)] * A.in[I_NFFN][k];
        F.WR()[i] = (bf16)(cvt_pk_bf16(v, 0.f) & 0xffffu); }
    for (int m = gw; m < M + NMETA; m += NGW) rms_row_to_bf16(m < M ? A.in[I_X] + (size_t)m * DM : A.in[I_META] + (size_t)(m - M) * DM, A.in[I_NMIX], F.HN() + (size_t)m * DM, m < M ? F.HN8() + (size_t)m * DM : nullptr, lane);
}

struct CvtJob { const float *wg, *wu, *wd, *ks; bf16 *WGU, *WD; int first, count, slot, wave; LAS unsigned char* scr; };
constexpr int CVT_ITEMS = 3 * 2048;
__device__ __forceinline__ void cvt_decode(const CvtJob& J, int q, int wave, const float*& W, int& N, bf16*& WT, int& ldt, int& wrow0, int& k0, bool& scale) {
    const int seg = q >> 11, r = q & 2047, e = r >> 5;
    if (seg < 2) { const int kb = r & 31, n0 = 64 * wave; k0 = 64 * kb; N = 512; ldt = 2048; scale = true;
        W = (seg ? J.wu : J.wg) + (size_t)e * 2048 * 512 + n0; WT = (bf16*)((unsigned char*)J.WGU + (size_t)e * 1024 * 2048); wrow0 = 256 * (n0 >> 7) + (n0 & 127) + (seg ? 128 : 0); }
    else { const int nq = (r >> 3) & 3, kb = r & 7, n0 = 512 * nq + 64 * wave; k0 = 64 * kb; N = 2048; ldt = 512; scale = false;
        W = J.wd + (size_t)e * 512 * 2048 + n0; WT = (bf16*)((unsigned char*)J.WD + (size_t)e * 2048 * 512); wrow0 = n0; }
}
__device__ __forceinline__ void cvt_load(f32x4 (&v)[16], const float* W, int N, int k0, int lane) {
    const float* p = W + (size_t)(k0 + 8 * (lane >> 4)) * N + 4 * (lane & 15);
#pragma unroll
    for (int i = 0; i < 16; ++i) v[i] = __builtin_nontemporal_load((const f32x4*)(p + (size_t)(i + (i >> 3) * 24) * N));
}
__device__ __forceinline__ void cvt_store(const f32x4 (&v)[16], bf16* WT, int ldt, int wrow0, int k0, const float* ks, bool scale, LAS unsigned char* scr  , int lane) {
    const int nl = lane & 15, kg = lane >> 4, kq = k0 + 8 * kg;
    float s[16];
    if (scale) {
#pragma unroll
        for (int i = 0; i < 4; ++i) { const f32x4 t = *(const f32x4*)(ks + kq + 4 * (i & 1) + 32 * (i >> 1)); s[4 * i] = t.x; s[4 * i + 1] = t.y; s[4 * i + 2] = t.z; s[4 * i + 3] = t.w; }
    } else {
#pragma unroll
        for (int i = 0; i < 16; ++i) s[i] = 1.0f;
    }
    LAS unsigned char* wp0 = scr + 128 * nl + 16 * (kg ^ (nl & 7)); LAS unsigned char* wp1 = scr + 128 * nl + 16 * ((4 + kg) ^ (nl & 7));
    const int R = lane >> 3, p = lane & 7;
    LAS const unsigned char* rp = scr + 128 * R + 16 * (p ^ (R & 7));
#pragma unroll
    for (int j = 0; j < 4; ++j) {
        u32x4 o0, o1;
        o0.x = cvt_pk_bf16(v[0][j] * s[0], v[1][j] * s[1]); o0.y = cvt_pk_bf16(v[2][j] * s[2], v[3][j] * s[3]); o0.z = cvt_pk_bf16(v[4][j] * s[4], v[5][j] * s[5]); o0.w = cvt_pk_bf16(v[6][j] * s[6], v[7][j] * s[7]);
        o1.x = cvt_pk_bf16(v[8][j] * s[8], v[9][j] * s[9]); o1.y = cvt_pk_bf16(v[10][j] * s[10], v[11][j] * s[11]); o1.z = cvt_pk_bf16(v[12][j] * s[12], v[13][j] * s[13]); o1.w = cvt_pk_bf16(v[14][j] * s[14], v[15][j] * s[15]);
        *(LAS u32x4*)wp0 = o0; *(LAS u32x4*)wp1 = o1;
        LDS_WAIT();
        const u32x4 a = *(LAS const u32x4*)rp, b = *(LAS const u32x4*)(rp + 1024);
        LDS_WAIT();
        bf16* dst = WT + (size_t)(wrow0 + 4 * R + j) * ldt + k0 + 8 * p;
        __builtin_nontemporal_store(a, (u32x4*)dst); __builtin_nontemporal_store(b, (u32x4*)(dst + (size_t)32 * ldt));
    }
}
__device__ __forceinline__ void cvt_store8(const f32x4 (&v)[16], unsigned char* WT, int ldt, int wrow0, int k0, const float* ks  , float scl, LAS unsigned char* scr, int lane) {
    const int nl = lane & 15, kg = lane >> 4, R = lane >> 2, p = lane & 3, kq = k0 + 8 * kg;
    float s[16];
    if (ks) {
#pragma unroll
        for (int i = 0; i < 4; ++i) { const f32x4 t = *(const f32x4*)(ks + kq + 4 * (i & 1) + 32 * (i >> 1)); s[4 * i] = t.x * scl; s[4 * i + 1] = t.y * scl; s[4 * i + 2] = t.z * scl; s[4 * i + 3] = t.w * scl; }
    } else {
#pragma unroll
        for (int i = 0; i < 16; ++i) s[i] = scl;
    }
    LAS unsigned char* wp = scr + 80 * nl + 8 * kg; LAS const unsigned char* rp = scr + 80 * R + 16 * p;
#pragma unroll
    for (int j = 0; j < 4; ++j) {
        int a0 = __builtin_amdgcn_cvt_pk_fp8_f32(v[0][j] * s[0], v[1][j] * s[1], 0, false); a0 = __builtin_amdgcn_cvt_pk_fp8_f32(v[2][j] * s[2], v[3][j] * s[3], a0, true);
        int a1 = __builtin_amdgcn_cvt_pk_fp8_f32(v[4][j] * s[4], v[5][j] * s[5], 0, false); a1 = __builtin_amdgcn_cvt_pk_fp8_f32(v[6][j] * s[6], v[7][j] * s[7], a1, true);
        int b0 = __builtin_amdgcn_cvt_pk_fp8_f32(v[8][j] * s[8], v[9][j] * s[9], 0, false); b0 = __builtin_amdgcn_cvt_pk_fp8_f32(v[10][j] * s[10], v[11][j] * s[11], b0, true);
        int b1 = __builtin_amdgcn_cvt_pk_fp8_f32(v[12][j] * s[12], v[13][j] * s[13], 0, false); b1 = __builtin_amdgcn_cvt_pk_fp8_f32(v[14][j] * s[14], v[15][j] * s[15], b1, true);
        *(LAS u32x2*)wp = (u32x2){(unsigned)a0, (unsigned)a1}; *(LAS u32x2*)(wp + 32) = (u32x2){(unsigned)b0, (unsigned)b1};
        LDS_WAIT();
        const u32x4 o = *(LAS const u32x4*)rp;
        LDS_WAIT();
        __builtin_nontemporal_store(o, (u32x4*)(WT + (size_t)(wrow0 + 4 * R + j) * ldt + k0 + 16 * p));
    }
}
__device__ __forceinline__ void cvt_run(const CvtJob& J, int lane) {
    int q = J.first; const int qe = J.first + J.count;
    for (; q + 1 < qe; q += 2) {
        const float *W0, *W1; bf16 *T0, *T1; int N0, N1, l0, l1, r0, r1, k0, k1; bool s0, s1;
        cvt_decode(J, q, J.wave, W0, N0, T0, l0, r0, k0, s0); cvt_decode(J, q + 1, J.wave, W1, N1, T1, l1, r1, k1, s1);
        f32x4 va[16], vb[16]; cvt_load(va, W0, N0, k0, lane); cvt_load(vb, W1, N1, k1, lane);
        cvt_store8(va, (unsigned char*)T0, l0, r0, k0, s0 ? J.ks : nullptr, s0 ? 1024.0f : 512.0f, J.scr, lane); cvt_store8(vb, (unsigned char*)T1, l1, r1, k1, s1 ? J.ks : nullptr, s1 ? 1024.0f : 512.0f, J.scr, lane);
    }
    if (q < qe) { const float* W0; bf16* T0; int N0, l0, r0, k0; bool s0; cvt_decode(J, q, J.wave, W0, N0, T0, l0, r0, k0, s0);
        f32x4 va[16]; cvt_load(va, W0, N0, k0, lane); cvt_store8(va, (unsigned char*)T0, l0, r0, k0, s0 ? J.ks : nullptr, s0 ? 1024.0f : 512.0f, J.scr, lane); }
}

using pg8::Unit;
struct DenseOrder {
    const char* A; const char* B; int nM, nN, nwg, G, c, lda, ldb;
    __device__ __forceinline__ bool next(int i, Unit& u) const {
        const long L = (long)i * G + c; if (L >= nwg) return false;
        int pm, pn; pg8::tile_of((int)L, nM, nN, pm, pn); u.pm = pm; u.pn = pn; u.x0 = 0; u.x1 = 0;
        u.a = A + (size_t)pm * 256 * lda * 2; u.b = B + (size_t)pn * 256 * ldb * 2; return true; }
};
struct EpiProj {
    static constexpr bool HAS_MID = false; static constexpr int MID_T = 0;
    static constexpr bool HAS_POST = true;
    bf16* O; CvtJob job; int lane;
    __device__ __forceinline__ void post(int ui) const { if (ui == job.slot) cvt_run(job, lane); }
    __device__ __forceinline__ void operator()(const f32x4 (&acc)[2][2][4][2], const Unit& u, int, int wr, int wc, int fr, int fq) const {
        const int row0 = u.pm * 256 + wr * 64 + fr, col0 = u.pn * 256 + wc * 32 + 8 * fq;
#pragma unroll
        for (int ai = 0; ai < 2; ++ai)
#pragma unroll
            for (int m = 0; m < 4; ++m) { bf16* rowp = O + (size_t)(row0 + ai * 128 + m * 16) * PW + col0;
#pragma unroll
                for (int bj = 0; bj < 2; ++bj) { const f32x4 v0 = acc[ai][bj][m][0], v1 = acc[ai][bj][m][1];
                    u32x4 w; w.x = cvt_pk_bf16(v0[0], v0[1]); w.y = cvt_pk_bf16(v0[2], v0[3]); w.z = cvt_pk_bf16(v1[0], v1[1]); w.w = cvt_pk_bf16(v1[2], v1[3]);
                    *(u32x4*)(rowp + bj * 128) = w; } }
    }
};
struct EpiGate {
    static constexpr bool HAS_MID = false; static constexpr int MID_T = 0;
    static constexpr bool HAS_POST = true;
    unsigned char* G; CvtJob job; int lane, n1;
    __device__ __forceinline__ void post(int ui) const { if (ui + n1 == job.slot) cvt_run(job, lane); }
    __device__ __forceinline__ void operator()(const f32x4 (&acc)[2][2][4][2], const Unit& u, int, int wr, int wc, int fr, int fq) const {
        const int row0 = u.pm * 256 + wr * 64 + fr, col0 = u.pn * 256 + wc * 32 + 8 * fq;
#pragma unroll
        for (int ai = 0; ai < 2; ++ai)
#pragma unroll
            for (int m = 0; m < 4; ++m) { unsigned char* rowp = G + (size_t)(row0 + ai * 128 + m * 16) * GW + col0;
#pragma unroll
                for (int bj = 0; bj < 2; ++bj) { const f32x4 v0 = acc[ai][bj][m][0] * (1.0f / 8192.0f), v1 = acc[ai][bj][m][1] * (1.0f / 8192.0f); unsigned q[8];
#pragma unroll
                    for (int e = 0; e < 4; ++e) { q[e] = (unsigned)fminf(sigmoidf_(v0[e]) * 256.0f, 255.0f); q[4 + e] = (unsigned)fminf(sigmoidf_(v1[e]) * 256.0f, 255.0f); }
                    u32x2 w; w.x = q[0] | (q[1] << 8) | (q[2] << 16) | (q[3] << 24); w.y = q[4] | (q[5] << 8) | (q[6] << 16) | (q[7] << 24);
                    *(u32x2*)(rowp + bj * 128) = w; } }
    }
};
struct FoldOrder {
    const char* WPT; const char* PMS; int idx;
    __device__ __forceinline__ bool next(int i, Unit& u) const {
        if (i > 0 || idx < 0) return false; u.pm = idx >> 2; u.pn = idx & 3; u.x0 = 0; u.x1 = 0;
        u.a = WPT + ((size_t)u.pm * 256 * 1024 + (size_t)u.pn * 256) * 2; u.b = PMS + (size_t)u.pn * 65536 * 2; return true; }
};
struct EpiFold {
    static constexpr bool HAS_MID = false; static constexpr int MID_T = 0;
    static constexpr bool HAS_POST = false;
    bf16* O;
    __device__ __forceinline__ void operator()(const f32x4 (&acc)[2][2][4][2], const Unit& u, int, int wr, int wc, int fr, int fq) const {
        const int row0 = u.pm * 256 + wr * 64 + fr, col0 = 1024 + u.pn * 256 + wc * 32 + 8 * fq;
#pragma unroll
        for (int ai = 0; ai < 2; ++ai)
#pragma unroll
            for (int m = 0; m < 4; ++m) { bf16* rowp = O + (size_t)(row0 + ai * 128 + m * 16) * 2048 + col0;
#pragma unroll
                for (int bj = 0; bj < 2; ++bj) { const f32x4 v0 = acc[ai][bj][m][0], v1 = acc[ai][bj][m][1];
                    u32x4 w; w.x = cvt_pk_bf16(v0[0], v0[1]); w.y = cvt_pk_bf16(v0[2], v0[3]); w.z = cvt_pk_bf16(v1[0], v1[1]); w.w = cvt_pk_bf16(v1[2], v1[3]);
                    *(u32x4*)(rowp + bj * 128) = w; } }
    }
};
struct EpiBranch {
    static constexpr bool HAS_MID = true; static constexpr int MID_T = 16;
    static constexpr bool HAS_POST = false;
    const unsigned char* GATE; bf16* MG;
    static __device__ __forceinline__ void dec8(const u32x2 g, float (&f)[8]) {
        constexpr float S = 1.0f / 256.0f, H = 0.5f / 256.0f;
        f[0] = (float)(g.x & 0xffu) * S + H; f[1] = (float)((g.x >> 8) & 0xffu) * S + H; f[2] = (float)((g.x >> 16) & 0xffu) * S + H; f[3] = (float)(g.x >> 24) * S + H;
        f[4] = (float)(g.y & 0xffu) * S + H; f[5] = (float)((g.y >> 8) & 0xffu) * S + H; f[6] = (float)((g.y >> 16) & 0xffu) * S + H; f[7] = (float)(g.y >> 24) * S + H;
    }
    __device__ __forceinline__ void mid(f32x4 (&acc)[2][2][4][2], const Unit& u, int wr, int wc, int fr, int fq) const {
        const unsigned off0 = (unsigned)(u.pm * 256 + wr * 64 + fr) * (unsigned)GW + (unsigned)(u.pn * 256 + wc * 32 + 8 * fq);
#pragma unroll
        for (int ai = 0; ai < 2; ++ai)
#pragma unroll
            for (int m = 0; m < 4; ++m) { const unsigned off = off0 + (unsigned)(ai * 128 + m * 16) * (unsigned)GW;
#pragma unroll
                for (int bj = 0; bj < 2; ++bj) { const u32x2 ga = *(const u32x2*)(GATE + off + bj * 128), gb = *(const u32x2*)(GATE + off + 2048 + bj * 128); float fa[8], fb[8]; dec8(ga, fa); dec8(gb, fb);
#pragma unroll
                    for (int e = 0; e < 4; ++e) { acc[ai][bj][m][0][e] *= fa[e] * __builtin_amdgcn_rcpf(fb[e]); acc[ai][bj][m][1][e] *= fa[4 + e] * __builtin_amdgcn_rcpf(fb[4 + e]); } }
                asm volatile("" ::: "memory"); }
    }
    __device__ __forceinline__ void operator()(const f32x4 (&acc)[2][2][4][2], const Unit& u, int, int wr, int wc, int fr, int fq) const {
        const unsigned row0 = (unsigned)(u.pm * 256 + wr * 64 + fr), col0 = (unsigned)(u.pn * 256 + wc * 32 + 8 * fq);
        const unsigned goff0 = row0 * (unsigned)GW + 2048u + col0, moff0 = row0 * 2048u + col0;
#pragma unroll
        for (int ai = 0; ai < 2; ++ai)
#pragma unroll
            for (int m = 0; m < 4; ++m) { const unsigned goff = goff0 + (unsigned)(ai * 128 + m * 16) * (unsigned)GW, moff = moff0 + (unsigned)(ai * 128 + m * 16) * 2048u;
#pragma unroll
                for (int bj = 0; bj < 2; ++bj) { const u32x2 gb = *(const u32x2*)(GATE + goff + bj * 128); float fb[8]; dec8(gb, fb);
                    const f32x4 v0 = acc[ai][bj][m][0], v1 = acc[ai][bj][m][1];
                    u32x4 w; w.x = cvt_pk_bf16(v0[0] * fb[0], v0[1] * fb[1]); w.y = cvt_pk_bf16(v0[2] * fb[2], v0[3] * fb[3]); w.z = cvt_pk_bf16(v1[0] * fb[4], v1[1] * fb[5]); w.w = cvt_pk_bf16(v1[2] * fb[6], v1[3] * fb[7]);
                    *(u32x4*)(MG + moff + bj * 128) = w; } }
    }
};
struct EpiOut {
    static constexpr bool HAS_MID = false; static constexpr int MID_T = 0;
    static constexpr bool HAS_POST = false;
    const float* X; bf16* H1B; float* SSQ; unsigned char* H8;
    __device__ __forceinline__ void operator()(const f32x4 (&acc)[2][2][4][2], const Unit& u, int, int wr, int wc, int fr, int fq) const {
        const int row0 = u.pm * 256 + wr * 64 + fr, col0 = u.pn * 256 + wc * 32 + 8 * fq;
#pragma unroll
        for (int ai = 0; ai < 2; ++ai)
#pragma unroll
            for (int m = 0; m < 4; ++m) { const int row = row0 + ai * 128 + m * 16; const size_t off = (size_t)row * 2048 + col0; float ss = 0.f;
#pragma unroll
                for (int bj = 0; bj < 2; ++bj) { const f32x4 x0 = *(const f32x4*)(X + off + bj * 128), x1 = *(const f32x4*)(X + off + bj * 128 + 4);
                    const f32x4 v0 = acc[ai][bj][m][0] + x0, v1 = acc[ai][bj][m][1] + x1;
                    ss += (v0[0] * v0[0] + v0[1] * v0[1]) + (v0[2] * v0[2] + v0[3] * v0[3]) + (v1[0] * v1[0] + v1[1] * v1[1]) + (v1[2] * v1[2] + v1[3] * v1[3]);
                    u32x4 w; w.x = cvt_pk_bf16(v0[0], v0[1]); w.y = cvt_pk_bf16(v0[2], v0[3]); w.z = cvt_pk_bf16(v1[0], v1[1]); w.w = cvt_pk_bf16(v1[2], v1[3]);
                    *(u32x4*)(H1B + off + bj * 128) = w;
                    f32x4 z0 = v0 * 8.0f, z1 = v1 * 8.0f;
#pragma unroll
                    for (int e = 0; e < 4; ++e) { z0[e] = __builtin_fminf(__builtin_fmaxf(z0[e], -448.0f), 448.0f); z1[e] = __builtin_fminf(__builtin_fmaxf(z1[e], -448.0f), 448.0f); }
                    int p0 = __builtin_amdgcn_cvt_pk_fp8_f32(z0[0], z0[1], 0, false); p0 = __builtin_amdgcn_cvt_pk_fp8_f32(z0[2], z0[3], p0, true);
                    int p1 = __builtin_amdgcn_cvt_pk_fp8_f32(z1[0], z1[1], 0, false); p1 = __builtin_amdgcn_cvt_pk_fp8_f32(z1[2], z1[3], p1, true);
                    *(u32x2*)(H8 + off + bj * 128) = (u32x2){(unsigned)p0, (unsigned)p1}; }
                ss += __shfl_xor(ss, 16); ss += __shfl_xor(ss, 32);
                if (fq == 0) SSQ[(size_t)(u.pn * 4 + wc) * M + row] = ss; }
    }
};
struct MoeOrder {
    LAS const int* ud; int nunits; const char* A; const char* B; size_t a_row_bytes  , b_exp_bytes, b_panel_bytes;
    __device__ __forceinline__ bool next(int i, Unit& u) const {
        if (i >= nunits) return false;
        const int e = __builtin_amdgcn_readfirstlane(ud[i * 8 + 0]), pn = __builtin_amdgcn_readfirstlane(ud[i * 8 + 1]), nv = __builtin_amdgcn_readfirstlane(ud[i * 8 + 2]), rs = __builtin_amdgcn_readfirstlane(ud[i * 8 + 3]);
        u.pm = e; u.pn = pn; u.x0 = nv; u.x1 = rs; u.a = A + (size_t)rs * a_row_bytes; u.b = B + (size_t)e * b_exp_bytes + (size_t)pn * b_panel_bytes; return true; }
};
struct EpiGU {
    static constexpr bool HAS_MID = false; static constexpr int MID_T = 0;
    static constexpr bool HAS_POST = false;
    bf16* HID; LAS const float* rtab;
    __device__ __forceinline__ void operator()(const f32x4 (&acc)[2][2][4][2], const Unit& u, int ui, int wr, int wc, int fr, int fq) const {
        const int col0 = u.pn * 128 + wc * 32 + 8 * fq; const int nv = u.x0, rs = u.x1;
#pragma unroll
        for (int ai = 0; ai < 2; ++ai)
#pragma unroll
            for (int m = 0; m < 4; ++m) { const int rr = ai * 128 + wr * 64 + m * 16 + fr; const float r = rtab[ui * 256 + rr] * (1.0f / 8192.0f);
                int pk[2];
#pragma unroll
                for (int n = 0; n < 2; ++n) { f32x4 g = acc[ai][0][m][n] * r; const f32x4 uu = acc[ai][1][m][n] * r;
#pragma unroll
                    for (int e = 0; e < 4; ++e) g[e] = __builtin_fminf(__builtin_fmaxf(g[e] * sigmoidf_(g[e]) * uu[e] * 8.0f, -448.0f), 448.0f);
                    int p = __builtin_amdgcn_cvt_pk_fp8_f32(g[0], g[1], 0, false); pk[n] = __builtin_amdgcn_cvt_pk_fp8_f32(g[2], g[3], p, true); }
                const int p0 = pk[0], p1 = pk[1];
                if (rr < nv) *(u32x2*)((unsigned char*)HID + (size_t)(rs + rr) * DEXP + col0) = (u32x2){(unsigned)p0, (unsigned)p1}; }
    }
};
struct EpiDown {
    static constexpr bool HAS_MID = false; static constexpr int MID_T = 0;
    static constexpr bool HAS_POST = false;
    bf16* Y; LAS const float* wtab;
    __device__ __forceinline__ void operator()(const f32x4 (&acc)[2][2][4][2], const Unit& u, int ui, int wr, int wc, int fr, int fq) const {
        const int col0 = u.pn * 256 + wc * 32 + 8 * fq; const int nv = u.x0, rs = u.x1;
#pragma unroll
        for (int ai = 0; ai < 2; ++ai)
#pragma unroll
            for (int m = 0; m < 4; ++m) { const int rr = ai * 128 + wr * 64 + m * 16 + fr; const float wt = wtab[ui * 256 + rr] * (1.0f / 4096.0f); bf16* rowp = Y + (size_t)(rs + rr) * 2048 + col0;
#pragma unroll
                for (int bj = 0; bj < 2; ++bj) { const f32x4 v0 = acc[ai][bj][m][0] * wt, v1 = acc[ai][bj][m][1] * wt;
                    u32x4 w; w.x = cvt_pk_bf16(v0[0], v0[1]); w.y = cvt_pk_bf16(v0[2], v0[3]); w.z = cvt_pk_bf16(v1[0], v1[1]); w.w = cvt_pk_bf16(v1[2], v1[3]);
                    if (rr < nv) *(u32x4*)(rowp + bj * 128) = w; } }
    }
};

__device__ __forceinline__ void meta_proj_task(Frame& F, int task) {
    const int lane = F.lane, n0 = KOFF + 16 * task;
    const bf16* ap = F.HN() + (size_t)(M + (lane & 15)) * DM + 8 * (lane >> 4);
    const bf16* bp = F.WIN() + (size_t)(n0 + (lane & 15)) * DM + 8 * (lane >> 4);
    f32x4 acc = (f32x4){0.f, 0.f, 0.f, 0.f};
#pragma unroll 8
    for (int ks = 0; ks < 64; ++ks) { const bf16x8 a = *(const bf16x8*)(ap + 32 * ks), b = *(const bf16x8*)(bp + 32 * ks); acc = __builtin_amdgcn_mfma_f32_16x16x32_bf16(a, b, acc, 0, 0, 0); }
#pragma unroll
    for (int r = 0; r < 4; ++r) F.PROJ()[(size_t)(M + 4 * (lane >> 4) + r) * PW + n0 + (lane & 15)] = (bf16)(cvt_pk_bf16(acc[r], 0.f) & 0xffffu);
}

__device__ __forceinline__ int t5_bucket(int d) {
    if (d < 16) return d;
    return 16 + (d >= 19) + (d >= 21) + (d >= 24) + (d >= 27) + (d >= 31) + (d >= 35) + (d >= 40) + (d >= 46) + (d >= 52) + (d >= 59) + (d >= 67) + (d >= 77) + (d >= 87) + (d >= 99) + (d >= 113);
}
constexpr int A_KL = 0, A_KROW = 144;
constexpr int A_VT = 288 * 144, A_VROW = 584;
constexpr int A_BT = A_VT + 64 * 584;
static_assert(A_BT + 4096 <= RING_BYTES, "attention LDS");

template <int T>
__device__ __forceinline__ void attn_qtile(LAS const unsigned char* lds, LAS const float* BT, const bf16* Qrow, bf16* Orow, float sink, int blk, int lane) {
    const int r32 = lane & 31, hi = lane >> 5, qi = 32 * T + r32;
    bf16x8 qf[4];
#pragma unroll
    for (int ds = 0; ds < 4; ++ds) qf[ds] = *(const bf16x8*)(Qrow + (size_t)r32 * PW + ds * 16 + hi * 8);
    f32x16 s[6];
#pragma unroll
    for (int ti = 0; ti < 6; ++ti) {
        const int kkb = (ti == 0) ? 0 : (ti <= 4 - T ? 32 + 32 * (T + ti - 1) : 160 + 32 * (ti - (5 - T)));
        f32x16 a = (f32x16){0.f, 0.f, 0.f, 0.f, 0.f, 0.f, 0.f, 0.f, 0.f, 0.f, 0.f, 0.f, 0.f, 0.f, 0.f, 0.f};
#pragma unroll
        for (int ds = 0; ds < 4; ++ds) { const bf16x8 kf = *(const LAS bf16x8*)(lds + A_KL + (kkb + r32) * A_KROW + ds * 32 + hi * 16); a = __builtin_amdgcn_mfma_f32_32x32x16_bf16(kf, qf[ds], a, 0, 0, 0); }
        s[ti] = a;
    }
    float mx = sink;
#pragma unroll
    for (int r = 0; r < 8; ++r) { const int i = (r & 3) + 8 * (r >> 2) + 4 * hi; int dist = 16 + 128 * blk + qi - i; dist = dist > 127 ? 127 : dist;
        const float x = s[0][r] * 0.125f + BT[dist]; s[0][r] = x; mx = fmaxf(mx, x); }
#pragma unroll
    for (int ti = 1; ti < 6; ++ti) {
        const bool prev = ti <= 4 - T; const int jt = prev ? (T + ti - 1) : (ti - (5 - T));
#pragma unroll
        for (int r = 0; r < 16; ++r) { const int i = (r & 3) + 8 * (r >> 2) + 4 * hi, j = 32 * jt + i;
            int dist; bool vis;
            if (prev) { dist = 128 + qi - j; vis = (blk > 0) && (jt > T || j > qi); } else { dist = qi - j; vis = (jt < T) || (j <= qi); }
            dist = dist < 0 ? 0 : (dist > 127 ? 127 : dist);
            const float x = vis ? s[ti][r] * 0.125f + BT[dist] : -1e30f; s[ti][r] = x; mx = fmaxf(mx, x); }
    }
    mx = fmaxf(mx, __shfl_xor(mx, 32));
    float l = 0.f;
#pragma unroll
    for (int r = 0; r < 8; ++r) { const float p = __expf(s[0][r] - mx); s[0][r] = p; l += p; }
#pragma unroll
    for (int ti = 1; ti < 6; ++ti)
#pragma unroll
        for (int r = 0; r < 16; ++r) { const float p = __expf(s[ti][r] - mx); s[ti][r] = p; l += p; }
    l += __shfl_xor(l, 32); l += __expf(sink - mx);
    f32x16 o[2];
    o[0] = (f32x16){0.f, 0.f, 0.f, 0.f, 0.f, 0.f, 0.f, 0.f, 0.f, 0.f, 0.f, 0.f, 0.f, 0.f, 0.f, 0.f}; o[1] = o[0];
#pragma unroll
    for (int ti = 0; ti < 6; ++ti) {
        const int kkb = (ti == 0) ? 0 : (ti <= 4 - T ? 32 + 32 * (T + ti - 1) : 160 + 32 * (ti - (5 - T)));
#pragma unroll
        for (int s2 = 0; s2 < 2; ++s2) {
            if (ti == 0 && s2 == 1) continue;
            u32x4 pw; pw.x = cvt_pk_bf16(s[ti][8 * s2 + 0], s[ti][8 * s2 + 1]); pw.y = cvt_pk_bf16(s[ti][8 * s2 + 2], s[ti][8 * s2 + 3]); pw.z = cvt_pk_bf16(s[ti][8 * s2 + 4], s[ti][8 * s2 + 5]); pw.w = cvt_pk_bf16(s[ti][8 * s2 + 6], s[ti][8 * s2 + 7]);
            const bf16x8 pf = __builtin_bit_cast(bf16x8, pw);
#pragma unroll
            for (int dt = 0; dt < 2; ++dt) { LAS const unsigned char* vp = lds + A_VT + (dt * 32 + r32) * A_VROW + (kkb + 16 * s2 + 4 * hi) * 2;
                const u32x2 lo = *(const LAS u32x2*)vp, hi2 = *(const LAS u32x2*)(vp + 16);
                const bf16x8 vf = __builtin_bit_cast(bf16x8, (u32x4){lo.x, lo.y, hi2.x, hi2.y});
                o[dt] = __builtin_amdgcn_mfma_f32_32x32x16_bf16(vf, pf, o[dt], 0, 0, 0); }
        }
    }
    const float inv = 1.0f / l;
#pragma unroll
    for (int dt = 0; dt < 2; ++dt)
#pragma unroll
        for (int g4 = 0; g4 < 4; ++g4) { u32x2 w; w.x = cvt_pk_bf16(o[dt][4 * g4 + 0] * inv, o[dt][4 * g4 + 1] * inv); w.y = cvt_pk_bf16(o[dt][4 * g4 + 2] * inv, o[dt][4 * g4 + 3] * inv);
            *(u32x2*)(Orow + (size_t)r32 * 2048 + dt * 32 + 8 * g4 + 4 * hi) = w; }
}

template <int W>
__device__ __forceinline__ void mixed_task(const bf16* ub  , bf16* ob  , int b, int s0) {
    constexpr int NR = 16 + W - 1;
    u32x4 u[NR];
#pragma unroll
    for (int i = 0; i < NR; ++i) { const int s = s0 - (W - 1) + i; const size_t row = s >= 0 ? (size_t)(b * SEQ + s) : (size_t)(M + 16 + s); u[i] = *(const u32x4*)(ub + row * PW); }
    constexpr float iw = 1.0f / (float)W;
#pragma unroll
    for (int t = 0; t < 16; ++t) {
        float a[8];
#pragma unroll
        for (int e = 0; e < 8; ++e) a[e] = 0.f;
#pragma unroll
        for (int j = 0; j < W; ++j) { const u32x4 v = u[t + j];
            a[0] += bf_lo(v.x); a[1] += bf_hi(v.x); a[2] += bf_lo(v.y); a[3] += bf_hi(v.y); a[4] += bf_lo(v.z); a[5] += bf_hi(v.z); a[6] += bf_lo(v.w); a[7] += bf_hi(v.w); }
        const u32x4 own = u[t + W - 1];
        u32x4 o; o.x = cvt_pk_bf16(a[0] * iw - bf_lo(own.x), a[1] * iw - bf_hi(own.x)); o.y = cvt_pk_bf16(a[2] * iw - bf_lo(own.y), a[3] * iw - bf_hi(own.y));
        o.z = cvt_pk_bf16(a[4] * iw - bf_lo(own.z), a[5] * iw - bf_hi(own.z)); o.w = cvt_pk_bf16(a[6] * iw - bf_lo(own.w), a[7] * iw - bf_hi(own.w));
        *(u32x4*)(ob + (size_t)t * 2048) = o;
    }
}

__device__ __forceinline__ void attn_unit(Frame& F, const Args& A, int b, int blk, int kvh) {
    LAS unsigned char* lds = F.lds; const int tid = F.tid; const int m0 = b * SEQ + blk * 128;
    for (int c = tid; c < 288 * 8; c += NWAVES * 64) { const int kk = c >> 3, ch = c & 7; int row = -1;
        if (kk < 16) row = M + kk; else if (kk >= 160) row = m0 + (kk - 160); else if (kk >= 32 && blk > 0) row = m0 - 128 + (kk - 32);
        u32x4 kv = (u32x4){0u, 0u, 0u, 0u}, vv = kv;
        if (row >= 0) { const bf16* p = F.PROJ() + (size_t)row * PW + kvh * 64 + ch * 8; kv = *(const u32x4*)(p + KOFF); vv = *(const u32x4*)(p + VOFF); }
        *(LAS u32x4*)(lds + A_KL + kk * A_KROW + ch * 16) = kv;
        if (kk < 16 || kk >= 32) { LAS bf16* vt = (LAS bf16*)(lds + A_VT) + (size_t)(ch * 8) * 292 + kk;
            vt[0 * 292] = (bf16)(vv.x & 0xffffu); vt[1 * 292] = (bf16)(vv.x >> 16); vt[2 * 292] = (bf16)(vv.y & 0xffffu); vt[3 * 292] = (bf16)(vv.y >> 16);
            vt[4 * 292] = (bf16)(vv.z & 0xffffu); vt[5 * 292] = (bf16)(vv.z >> 16); vt[6 * 292] = (bf16)(vv.w & 0xffffu); vt[7 * 292] = (bf16)(vv.w >> 16); }
    }
    LAS float* BTall = (LAS float*)(lds + A_BT);
    for (int t = tid; t < 8 * 128; t += NWAVES * 64) { const int g = t >> 7, d = t & 127; BTall[t] = A.in[I_RELB][t5_bucket(d) * 16 + kvh * 8 + g]; }
    __syncthreads();
    const int g = F.wave, hq = kvh * 8 + g; const float sink = A.in[I_SINK][hq];
    const bf16* Q = F.PROJ() + (size_t)m0 * PW + hq * 64; bf16* O = F.AP() + (size_t)m0 * 2048 + hq * 64;
    LAS const float* BT = BTall + g * 128;
    attn_qtile<0>(lds, BT, Q, O, sink, blk, F.lane);
    attn_qtile<1>(lds, BT, Q + (size_t)32 * PW, O + (size_t)32 * 2048, sink, blk, F.lane);
    attn_qtile<2>(lds, BT, Q + (size_t)64 * PW, O + (size_t)64 * 2048, sink, blk, F.lane);
    attn_qtile<3>(lds, BT, Q + (size_t)96 * PW, O + (size_t)96 * 2048, sink, blk, F.lane);
    { const int grp = 2 * kvh + (F.wave & 1), r0 = 16 * (2 * (F.wave >> 1) + (F.lane >> 5)), c8 = grp * 256 + (F.lane & 31) * 8;
      const bf16* ub = F.PROJ() + UOFF + c8; bf16* ob = F.AP() + (size_t)(m0 + r0) * 2048 + 1024 + c8; const int s0 = blk * 128 + r0;
      if (grp == 0) mixed_task<2>(ub, ob, b, s0); else if (grp == 1) mixed_task<4>(ub, ob, b, s0); else if (grp == 2) mixed_task<8>(ub, ob, b, s0); else mixed_task<16>(ub, ob, b, s0); }
    __syncthreads();
}

__device__ __forceinline__ void router_group(Frame& F, const Args& A, int tg, const int dummy = 0) {
    LAS unsigned char* lds = F.lds; const int lane = F.lane, w = F.wave, q = w & 3, kh = w >> 2;
    LAS float* part = (LAS float*)lds;
    LAS float* logit = (LAS float*)(lds + 20480);
    const int t0 = tg * 64 + q * 16;
    f32x4 acc[5];
#pragma unroll
    for (int n = 0; n < 5; ++n) acc[n] = (f32x4){0.f, 0.f, 0.f, 0.f};
    constexpr int RB_OFF = 40960, RB_ROW = 272, RB_BUF = 160 * RB_ROW;
    static_assert(RB_OFF + 2 * RB_BUF <= RING_BYTES, "router LDS");
    const int srow = F.tid >> 4, sl16 = F.tid & 15;
    u32x4 sb[5]; bf16x8 an[4], ac[4];
    const bf16* ap = F.H1B() + (size_t)(t0 + (lane & 15)) * DM + kh * 1024 + 8 * (lane >> 4);
#define RT_LOADB(cc) do { _Pragma("unroll") for (int p = 0; p < 5; ++p) { const int row = p * 32 + srow, h = row >= 80 ? 1 : 0, n = row - 80 * h; \
        sb[p] = *(const u32x4*)(F.WR() + (size_t)n * DM + 1024 * h + 128 * (cc) + 8 * sl16); } } while (0)
#define RT_STOREB(bufi) do { _Pragma("unroll") for (int p = 0; p < 5; ++p) *(LAS u32x4*)(lds + RB_OFF + (bufi) * RB_BUF + (p * 32 + srow) * RB_ROW + 16 * sl16) = sb[p]; } while (0)
#define RT_LOADA(dst, cc) do { _Pragma("unroll") for (int ks = 0; ks < 4; ++ks) dst[ks] = *(const bf16x8*)(ap + 128 * (cc) + 32 * ks); } while (0)
    float ss_row = 0.f;
    if (F.tid < 64) {
#pragma unroll
        for (int p = 0; p < 32; ++p) ss_row += F.SSQ()[(size_t)p * M + tg * 64 + F.tid]; }
    RT_LOADB(0); RT_LOADA(ac, 0); RT_STOREB(0);
    __syncthreads();
#pragma unroll
    for (int cc = 0; cc < 8; ++cc) {
        if (cc < 7) { RT_LOADB(cc + 1); RT_LOADA(an, cc + 1); }
        LAS const unsigned char* bb = lds + RB_OFF + (cc & 1) * RB_BUF + (kh * 80 + (lane & 15)) * RB_ROW + 16 * (lane >> 4);
#pragma unroll
        for (int ks = 0; ks < 4; ++ks)
#pragma unroll
            for (int n = 0; n < 5; ++n) { const bf16x8 b = *(const LAS bf16x8*)(bb + n * 16 * RB_ROW + 64 * ks); acc[n] = __builtin_amdgcn_mfma_f32_16x16x32_bf16(ac[ks], b, acc[n], 0, 0, 0); }
        if (cc < 7) { RT_STOREB((cc + 1) & 1);
#pragma unroll
            for (int ks = 0; ks < 4; ++ks) ac[ks] = an[ks]; }
        __syncthreads();
    }
#undef RT_LOADB
#undef RT_STOREB
#undef RT_LOADA
    if (kh == 1) {
#pragma unroll
        for (int n = 0; n < 5; ++n) *(LAS f32x4*)(part + ((q * 5 + n) * 64 + lane) * 4) = acc[n]; }
    __syncthreads();
    if (kh == 0) {
#pragma unroll
        for (int n = 0; n < 5; ++n) { const f32x4 p = *(LAS const f32x4*)(part + ((q * 5 + n) * 64 + lane) * 4); const f32x4 v = acc[n] + p;
#pragma unroll
            for (int r = 0; r < 4; ++r) logit[(q * 16 + 4 * (lane >> 4) + r) * 80 + n * 16 + (lane & 15)] = v[r]; } }
    __syncthreads();
    if (F.tid < 64) {
        const int tt = tg * 64 + F.tid; LAS const float* lg = logit + F.tid * 80;
        const float r = 1.0f / sqrtf(ss_row * (1.0f / DM) + RMS_EPS);
        float gl[8]; int grp = 0; float gmax = -3.0e38f;
#pragma unroll
        for (int j = 0; j < 8; ++j) { gl[j] = r * lg[j] + A.in[I_BRG][j]; if (gl[j] > gmax) { gmax = gl[j]; grp = j; } }
        float den = 0.f;
#pragma unroll
        for (int j = 0; j < 8; ++j) den += __expf(gl[j] - gmax);
        const float pg = 1.0f / den;
        float l1 = -3.0e38f, l2 = -3.0e38f; int i1 = 0, i2 = 0;
#pragma unroll
        for (int j = 0; j < 8; ++j) { const float v = r * lg[8 + grp * 8 + j] + A.in[I_BRE][grp * 8 + j];
            if (v > l1) { l2 = l1; i2 = i1; l1 = v; i1 = j; } else if (v > l2) { l2 = v; i2 = j; } }
        const float e1w = 1.0f / (1.0f + __expf(l2 - l1)); const float w1 = e1w * pg, w2 = (1.0f - e1w) * pg;
        const int e1 = grp * 8 + i1, e2 = grp * 8 + i2;
        const size_t dofs = dummy ? (size_t)(WS_END - WS_LTOK) / 4 : 0;
        const int p1 = (int)atomicAdd(F.ctl + CW_CNT + (dummy ? 2048 : 0) + 16 * e1, 1u), p2 = (int)atomicAdd(F.ctl + CW_CNT + (dummy ? 2048 : 0) + 16 * e2, 1u);
        F.LTOK()[dofs + e1 * CAP + p1] = tt; F.LR()[dofs + e1 * CAP + p1] = r; F.LW()[dofs + e1 * CAP + p1] = w1;
        F.LTOK()[dofs + e2 * CAP + p2] = tt; F.LR()[dofs + e2 * CAP + p2] = r; F.LW()[dofs + e2 * CAP + p2] = w2;
        ((i32x4*)((int*)F.TINFO() + dofs))[tt] = (i32x4){e1, p1, e2, p2};
    }
    __syncthreads();
}

template <int NPN, bool GU>
__device__ __forceinline__ int moe_setup(Frame& F) {
    LAS int* es = (LAS int*)(F.lds + L_ESTART); LAS int* hs = (LAS int*)(F.lds + L_TSTART); LAS int* ls = (LAS int*)(F.lds + L_CVT); LAS int* ud = (LAS int*)(F.lds + L_UD);
    if (F.tid < NEXP) es[F.tid] = (int)__hip_atomic_load(F.ctl + CW_CNT + 16 * F.tid, __ATOMIC_RELAXED, __HIP_MEMORY_SCOPE_AGENT);
    __syncthreads();
    if (F.tid == 0) { int s = 0, h = 0, l = 0; for (int e = 0; e < NEXP; ++e) { const int c = es[e], nt = (c + 255) >> 8, lt = (nt > 0 && c - 256 * (nt - 1) <= 128) ? 1 : 0; es[e] = s; hs[e] = h; ls[e] = l; s += c; h += nt - lt; l += lt; } es[NEXP] = s; hs[NEXP] = h; ls[NEXP] = l; }
    __syncthreads();
    const int nheavy = hs[NEXP], nlight = ls[NEXP];
    if (F.tid < 8) { const int i = F.tid; const long L = (long)i * F.G + F.vcu;
        if (L < (long)(nheavy + nlight) * NPN) { const int rt = (int)(L / NPN), pn = (int)(L % NPN); int e = 0, tile;
            { while (hs[e + 1] + ls[e + 1] <= rt) ++e; tile = rt - hs[e] - ls[e]; }
            const int cnt = es[e + 1] - es[e]; int nv = cnt - 256 * tile; nv = nv > 256 ? 256 : nv;
            ud[i * 8 + 0] = e; ud[i * 8 + 1] = pn; ud[i * 8 + 2] = nv; ud[i * 8 + 3] = es[e] + 256 * tile; ud[i * 8 + 4] = tile; ud[i * 8 + 5] = 1; }
        else ud[i * 8 + 5] = 0; }
    __syncthreads();
    int nunits = 0;
#pragma unroll
    for (int i = 0; i < 8; ++i) nunits += ud[i * 8 + 5];
    LAS unsigned* tab = (LAS unsigned*)(F.lds + L_TAB);
    for (int idx = F.tid; idx < nunits * 256; idx += NWAVES * 64) { const int i = idx >> 8, rr = idx & 255; const int e = ud[i * 8 + 0], nv = ud[i * 8 + 2], tile = ud[i * 8 + 4];
        const int pos = 256 * tile + (rr < nv ? rr : nv - 1);
        if (GU) { tab[idx] = (unsigned)F.LTOK()[e * CAP + pos] * (unsigned)DM;   ((LAS float*)tab)[1024 + idx] = F.LR()[e * CAP + pos]; }
        else ((LAS float*)tab)[idx] = rr < nv ? F.LW()[e * CAP + pos] : 0.f; }
    __syncthreads();
    return nunits;
}

__device__ __forceinline__ int lane_id() { return (int)__builtin_amdgcn_mbcnt_hi(~0u, __builtin_amdgcn_mbcnt_lo(~0u, 0u)); }
__device__ __forceinline__ void final_row(Frame& F, const Args& A, int t, LAS const int* es, const int lane) {
    const i32x4 ti = F.TINFO()[t];
    const size_t s1 = (size_t)(es[ti.x] + ti.y), s2 = (size_t)(es[ti.z] + ti.w);
    const u32x2* hr = (const u32x2*)(F.H1B() + (size_t)t * DM) + lane; const u32x2* y1 = (const u32x2*)(F.Y() + s1 * DM) + lane; const u32x2* y2 = (const u32x2*)(F.Y() + s2 * DM) + lane;
    const f32x4* gr = (const f32x4*)A.in[I_NFIN] + lane;
    f32x4 v[8]; float s = 0.f;
#pragma unroll
    for (int j = 0; j < 8; ++j) { const u32x2 h = hr[64 * j]; const u32x2 a = y1[64 * j], b = y2[64 * j];
        v[j].x = bf_lo(h.x) + (bf_lo(a.x) + bf_lo(b.x)); v[j].y = bf_hi(h.x) + (bf_hi(a.x) + bf_hi(b.x)); v[j].z = bf_lo(h.y) + (bf_lo(a.y) + bf_lo(b.y)); v[j].w = bf_hi(h.y) + (bf_hi(a.y) + bf_hi(b.y));
        s += (v[j].x * v[j].x + v[j].y * v[j].y) + (v[j].z * v[j].z + v[j].w * v[j].w); }
    const float r = 1.0f / sqrtf(wave_sum(s) * (1.0f / DM) + RMS_EPS);
    f32x4* o = (f32x4*)(A.out + (size_t)t * DM) + lane;
#pragma unroll
    for (int j = 0; j < 8; ++j) { const f32x4 gg = gr[64 * j]; o[64 * j] = (f32x4){v[j].x * r * gg.x, v[j].y * r * gg.y, v[j].z * r * gg.z, v[j].w * r * gg.w}; }
}

__device__ __forceinline__ void p0_probe(Frame& F, const Args& A) {
#if PROBE_SUB > 0
    if (F.vcu < PROBE_SUB) { CvtJob job{A.in[I_WG], A.in[I_WU], A.in[I_WD], A.in[I_NFFN], F.WGU(), F.WD(), F.vcu * (CVT_ITEMS / PROBE_SUB), CVT_ITEMS / PROBE_SUB, 0, F.wave, F.lds + L_CVT + F.wave * 2048}; cvt_run(job, F.lane); }
#endif
}
__device__ __forceinline__ void p1_phase(Frame& F, const Args& A, int c) {
    if (c >= 64 && c < 74) meta_proj_task(F, (c - 64) * 8 + F.wave);
    if (c >= 128 && c < 160) {
        FoldOrder S{(const char*)F.WPT(), (const char*)F.PMS(), c - 128}; EpiFold E{F.WAB()};
        pg8::gemm_phase<EpiFold, FoldOrder, false>(F.lds + RING_OFF, 1024, 256, 256, S, E, nullptr);
    }
    CvtJob job{A.in[I_WG], A.in[I_WU], A.in[I_WD], A.in[I_NFFN], F.WGU(), F.WD(), 0, 0, 0, F.wave, F.lds + L_CVT + F.wave * 2048};
    if (c < 64) { job.first = c * 18; job.count = 18; job.slot = c % 7; } else { job.first = 1152 + (c - 64) * 26; job.count = 26; job.slot = (c - 64) % 6; }
#if PROBE_SUB > 0
    job.count = 0;
#endif
    { DenseOrder S{(const char*)F.HN(), (const char*)F.WIN(), 64, 9, 576, F.G, c, 2048, 2048}; EpiProj E{F.PROJ(), job, F.lane};
      pg8::gemm_phase<EpiProj, DenseOrder, false>(F.lds + RING_OFF, 2048, 2048, 2048, S, E, nullptr); }
    { DenseOrder S{(const char*)F.HN8(), (const char*)F.WIN8(), 64, 16, 1024, F.G, c, 1024, 1024}; EpiGate E{F.GATE(), job, F.lane, c < 64 ? 3 : 2};
      pg8::gemm_phase<EpiGate, DenseOrder, false, false, true>(F.lds + RING_OFF, 1024, 1024, 1024, S, E, nullptr); }
}
__device__ __forceinline__ void p2_phase(Frame& F, const Args& A) { const int idx = F.vcu; if (idx < 256) attn_unit(F, A, idx >> 7, (idx >> 1) & 63, idx & 1); }
__device__ __forceinline__ void p3_phase(Frame& F, int c) {
    DenseOrder S{(const char*)F.AP(), (const char*)F.WAB(), 64, 8, 512, F.G, c, 2048, 2048}; EpiBranch E{F.GATE(), F.MERGED()};
    pg8::gemm_phase<EpiBranch, DenseOrder, false>(F.lds + RING_OFF, 2048, 2048, 2048, S, E, nullptr);
}
__device__ __forceinline__ void p4_phase(Frame& F, const Args& A, int c) {
    DenseOrder S{(const char*)F.MERGED(), (const char*)F.WO(), 64, 8, 512, F.G, c, 2048, 2048}; EpiOut E{A.in[I_X], F.H1B(), F.SSQ(), F.H8()};
    pg8::gemm_phase<EpiOut, DenseOrder, false>(F.lds + RING_OFF, 2048, 2048, 2048, S, E, nullptr);
}
__device__ __forceinline__ void p6_phase(Frame& F) {
    const int nu = moe_setup<4, true>(F);
    MoeOrder S{(LAS const int*)(F.lds + L_UD), nu, (const char*)F.H8(), (const char*)F.WGU(), 0, (size_t)1024 * 2048, (size_t)256 * 2048};
    EpiGU E{F.HID(), (LAS const float*)(F.lds + L_TAB) + 1024};
    pg8::gemm_phase<EpiGU, MoeOrder, true, false, true>(F.lds + RING_OFF, 1024, 1024, 1024, S, E, (LAS const unsigned*)(F.lds + L_TAB));
}
__device__ __forceinline__ void p7_phase(Frame& F) {
    const int nu = moe_setup<8, false>(F);
    MoeOrder S{(LAS const int*)(F.lds + L_UD), nu, (const char*)F.HID(), (const char*)F.WD(), (size_t)DEXP, (size_t)2048 * 512, (size_t)256 * 512};
    EpiDown E{F.Y(), (LAS const float*)(F.lds + L_TAB)};
    pg8::gemm_phase<EpiDown, MoeOrder, false, false, true>(F.lds + RING_OFF, 256, 256, 256, S, E, nullptr);
}
__device__ __forceinline__ void p8_phase(Frame& F, const Args& A) {
    LAS int* es = (LAS int*)(F.lds + L_ESTART);
    if (F.tid < NEXP) es[F.tid] = (int)__hip_atomic_load(F.ctl + CW_CNT + 16 * F.tid, __ATOMIC_RELAXED, __HIP_MEMORY_SCOPE_AGENT);
    __syncthreads();
    if (F.tid == 0) { int s = 0; for (int e = 0; e < NEXP; ++e) { const int c = es[e]; es[e] = s; s += c; } }
    __syncthreads();
    const int lane = lane_id();
    for (int t = F.vcu * NWAVES + F.wave; t < M; t += F.G * NWAVES) final_row(F, A, t, es, lane);
}

__global__ void __launch_bounds__(NWAVES * 64, 2) mega_fwd(Args args) {
    extern __shared__ __attribute__((aligned(16))) unsigned char lds_raw[];
    Frame F;
    F.lds = (LAS unsigned char*)lds_raw;
    F.MISC = (volatile LAS unsigned*)(F.lds + L_MISC);
    F.tid = threadIdx.x; F.lane = F.tid & 63; F.wave = __builtin_amdgcn_readfirstlane(F.tid >> 6);
    F.G = gridDim.x; { const int bx = blockIdx.x; F.vcu = (F.G % 8 == 0) ? (bx % 8) * (F.G / 8) + bx / 8 : bx; }
    unsigned char* ws = args.ws;
    F.ctl = (unsigned*)(ws + WS_CTL);
    F.ws = ws;
    for (int u = F.tid; u < (LDS_BYTES - RING_BYTES) / 4; u += NWAVES * 64) ((LAS unsigned*)(F.lds + RING_BYTES))[u] = 0u;
    __syncthreads();
#if MK_LAUNCHES == 1
    XcdBarrier bar = xcd_barrier_post((unsigned*)(F.ctl + CW_BAR), F.MISC + 8);
#define GRID_BAR() xcd_barrier(bar)
#else
#define GRID_BAR() do { } while (0)
#endif
    const int lo = args.ph_lo, hi = args.ph_hi;
#define IN(k) (lo <= (k) && (k) < hi)
#define BOTH(k) (IN(k) && IN((k) + 1))
#define DUP(k) (PROBE_DUP == (k))
    const int c = (int)blockIdx.x;

    if (IN(0)) { p0_prologue(F, args); p0_probe(F, args); if (DUP(0)) { GRID_BAR(); p0_prologue(F, args); } if (BOTH(0)) GRID_BAR(); }
    if (IN(1)) { p1_phase(F, args, c); if (DUP(1)) { GRID_BAR(); p1_phase(F, args, c); } if (BOTH(1)) GRID_BAR(); }
    if (IN(2)) { p2_phase(F, args); if (DUP(2)) { GRID_BAR(); p2_phase(F, args); } if (BOTH(2)) GRID_BAR(); }
    if (IN(3)) { p3_phase(F, c); if (DUP(3)) { GRID_BAR(); p3_phase(F, c); } if (BOTH(3)) GRID_BAR(); }
    if (IN(4)) { p4_phase(F, args, c); if (DUP(4)) { GRID_BAR(); p4_phase(F, args, c); } if (BOTH(4)) GRID_BAR(); }
    if (IN(5)) { if (F.vcu < M / 64) router_group(F, args, F.vcu); if (DUP(5)) { GRID_BAR(); if (F.vcu < M / 64) router_group(F, args, F.vcu, 1); } if (BOTH(5)) GRID_BAR(); }
    if (IN(6)) { p6_phase(F); if (DUP(6)) { GRID_BAR(); p6_phase(F); } if (BOTH(6)) GRID_BAR(); }
    if (IN(7)) { p7_phase(F); if (DUP(7)) { GRID_BAR(); p7_phase(F); } if (BOTH(7)) GRID_BAR(); }
    if (IN(8)) { p8_phase(F, args); if (DUP(8)) { GRID_BAR(); p8_phase(F, args); } }
#undef IN
#undef BOTH
#undef DUP
}

extern "C" void kernel_launch(void* const* d_in, const int* in_sizes, int n_in, void* d_out, int out_size, void* d_ws, size_t ws_size, hipStream_t stream) {
    static int grid = 0;
    if (grid == 0) {
        if (n_in != 20 || out_size != M * DM || ws_size < WS_END + (PROBE_DUP == 5 ? 16 * MiB : 0)) { fprintf(stderr, "kernel_launch: unexpected shapes (n_in %d, out %d, ws %zu); nothing launched\n", n_in, out_size, ws_size); grid = -1; return; }
        int dev = 0, cus = 0, per_cu = 0;
        if (hipGetDevice(&dev) != hipSuccess || hipDeviceGetAttribute(&cus, hipDeviceAttributeMultiprocessorCount, dev) != hipSuccess) { grid = -1; return; }
        if (hipFuncSetAttribute((const void*)mega_fwd, hipFuncAttributeMaxDynamicSharedMemorySize, LDS_BYTES) != hipSuccess) { fprintf(stderr, "kernel_launch: hipFuncSetAttribute failed\n"); grid = -1; return; }
        if (hipOccupancyMaxActiveBlocksPerMultiprocessor(&per_cu, (const void*)mega_fwd, NWAVES * 64, LDS_BYTES) != hipSuccess || per_cu < 1) { fprintf(stderr, "kernel_launch: occupancy query says %d\n", per_cu); }
        (void)hipGetLastError();
        grid = cus;
        if (grid != 256) { fprintf(stderr, "kernel_launch: built for 256 CUs, device has %d; nothing launched\n", grid); grid = -1; return; }
    }
    if (grid < 0) return;
    (void)hipMemsetAsync((char*)d_ws + WS_CTL, 0, CTL_ZERO_BYTES, stream);
    Args a{};
    for (int i = 0; i < 20; ++i) a.in[i] = (const float*)d_in[i];
    a.out = (float*)d_out; a.ws = (unsigned char*)d_ws;
#if MK_LAUNCHES == 1
    a.ph_lo = 0; a.ph_hi = NPHASE;
    hipLaunchKernelGGL(mega_fwd, dim3(grid), dim3(NWAVES * 64), LDS_BYTES, stream, a);
#else
    for (int p = 0; p < NPHASE; ++p) { a.ph_lo = p; a.ph_hi = p + 1; hipLaunchKernelGGL(mega_fwd, dim3(grid), dim3(NWAVES * 64), LDS_BYTES, stream, a); }
#endif
}
```

```cpp
#include <hip/hip_runtime.h>
#include <cstdio>
#include <cstdint>

#define GAS __attribute__((address_space(1)))
#define LAS __attribute__((address_space(3)))
typedef unsigned short bf16;
typedef short bf16x8 __attribute__((ext_vector_type(8)));
typedef float f32x2 __attribute__((ext_vector_type(2)));
typedef float f32x4 __attribute__((ext_vector_type(4)));
typedef float f32x16 __attribute__((ext_vector_type(16)));
typedef unsigned u32x2 __attribute__((ext_vector_type(2)));
typedef unsigned u32x4 __attribute__((ext_vector_type(4)));
typedef int i32x4 __attribute__((ext_vector_type(4)));

#ifndef MK_LAUNCHES
#define MK_LAUNCHES 1
#endif
#ifndef PROBE_DUP
#define PROBE_DUP -1
#endif
#ifndef PROBE_SUB
#define PROBE_SUB 0
#endif
#ifndef PROBE_TIME
#define PROBE_TIME -1
#endif
constexpr int NPHASE = 9;

constexpr int DM = 2048, SEQ = 8192, M = 16384;
constexpr int NMETA = 16, MROWS = M + 256;
constexpr int INW = 6400, KOFF = 1024, VOFF = 1152, UOFF = 1280, GAOFF = 2304, GPOFF = 4352;
constexpr int PW = 2304, GW = 4096;
constexpr int NEXP = 64, DEXP = 512, CAP = 16384;
constexpr float RMS_EPS = 1e-6f;

constexpr size_t MiB = 1u << 20;
constexpr size_t WS_CTL = 0, CTL_ZERO_BYTES = 1 * MiB;
constexpr size_t WS_WIN = 1 * MiB;
constexpr size_t WS_WAB = 26 * MiB;
constexpr size_t WS_WPT = 34 * MiB;
constexpr size_t WS_WO = 38 * MiB;
constexpr size_t WS_PMS = 46 * MiB;
constexpr size_t WS_WR = 46 * MiB + 512 * 1024;
constexpr size_t WS_SSQ = 47 * MiB;
constexpr size_t WS_LTOK = 49 * MiB, WS_LR = 53 * MiB, WS_LW = 57 * MiB;
constexpr size_t WS_TINFO = 61 * MiB;
constexpr size_t WS_WGU = 64 * MiB;
constexpr size_t WS_WIN8 = 13 * MiB;
constexpr size_t WS_HN8 = 416 * MiB;
constexpr size_t WS_H8 = 384 * MiB;
constexpr size_t WS_WD = 320 * MiB;
constexpr size_t WS_HN = 448 * MiB;
constexpr size_t WS_PROJ = 513 * MiB;
constexpr size_t WS_GATE = 593 * MiB;
constexpr size_t WS_AP = 717 * MiB;
constexpr size_t WS_H1 = 781 * MiB;
constexpr size_t WS_END = 909 * MiB;
constexpr int CW_TMO = 0, CW_CNT = 1024  , CW_BAR = 4096;

constexpr int RING_BYTES = 131072, RING_OFF = 512;
constexpr int L_MISC = RING_OFF + RING_BYTES;
constexpr int L_ESTART = L_MISC + 256;
constexpr int L_TSTART = L_ESTART + 320;
constexpr int L_UD = L_TSTART + 320;
constexpr int L_TAB = L_UD + 256;
constexpr int L_CVT = L_TAB + 8192;
constexpr int LDS_BYTES = 157696;
static_assert(L_CVT + 16384 <= LDS_BYTES && LDS_BYTES <= 163840, "LDS map");

#define LDS_WAIT() asm volatile("s_waitcnt lgkmcnt(0)" ::: "memory")
#define VM_WAIT() asm volatile("s_waitcnt vmcnt(0)" ::: "memory")
__device__ __forceinline__ unsigned cvt_pk_bf16(float lo, float hi) { unsigned r; asm volatile("v_cvt_pk_bf16_f32 %0, %1, %2" : "=v"(r) : "v"(lo), "v"(hi)); return r; }
__device__ __forceinline__ float bf_lo(unsigned w) { return __uint_as_float(w << 16); }
__device__ __forceinline__ float bf_hi(unsigned w) { return __uint_as_float(w & 0xffff0000u); }
__device__ __forceinline__ float sigmoidf_(float x) { return __builtin_amdgcn_rcpf(1.0f + __expf(-x)); }

namespace pg8 {
constexpr int BM = 256, BK = 64, HALF = 128, HTB = HALF * BK * 2, STAGE_BYTES = 8 * HTB, NXCD = 8, WGM = 8;
__host__ __device__ __forceinline__ int lds_byte(int r, int c) { const int st = (r >> 4) * 2 + (c >> 5), rr = r & 15, cc = c & 31, ob = rr * 64 + cc * 2; return st * 1024 + (ob ^ (((ob >> 9) & 1) << 5)); }
__host__ __device__ __forceinline__ void stage_rc(int b, int& R, int& C) { const int st = b / 1024, sb = b % 1024, swz = sb ^ (((sb >> 9) & 1) << 5); R = (st >> 1) * 16 + swz / 64; C = (st & 1) * 32 + (swz % 64) / 2; }
__host__ __device__ __forceinline__ int perm32(int rho) { const int n = rho >> 4, i = rho & 15; return 8 * (i >> 2) + 4 * n + (i & 3); }

struct Unit { const char* a; const char* b; int pm, pn, x0, x1; };

__device__ __forceinline__ void tile_of(int L, int nM, int nN, int& pm, int& pn) {
    const int nwg = nM * nN; int wgid = L;
    { const int q = nwg / NXCD, r = nwg % NXCD, xcd = wgid % NXCD, off = wgid / NXCD; wgid = (xcd < r ? xcd * (q + 1) : r * (q + 1) + (xcd - r) * q) + off; }
    const int nig = WGM * nN, gid = wgid / nig, fm = gid * WGM, gsz = (nM - fm) < WGM ? (nM - fm) : WGM;
    pm = fm + ((wgid % nig) % gsz); pn = (wgid % nig) / gsz;
}

typedef int i32x8 __attribute__((ext_vector_type(8)));
template <class Epi, class Sched, bool GATHER, bool HALFSKIP = false, bool FP8 = false>
__device__ __forceinline__ void gemm_phase(LAS unsigned char* lds, const int lda, const int ldb, const int K, const Sched& S, const Epi& E, LAS const unsigned* rowtab  ) {
    const int tid = threadIdx.x, wid = __builtin_amdgcn_readfirstlane(tid >> 6), lane = tid & 63, wr = wid >> 2, wc = wid & 3, fr = lane & 15, fq = lane >> 4;
    const int nt = K / BK;
    unsigned voffB[2], voffBh[2], cv0[2], cv1[2], nv0[2], nv1[2]; int Rr[2]; unsigned Cc[2];
#pragma unroll
    for (int i = 0; i < 2; ++i) { int R, C; stage_rc(tid * 16 + i * 8192, R, C); const int Rb = (R & ~31) + perm32(R & 31);
        voffB[i] = (unsigned)(Rb * ldb + C) * 2u; voffBh[i] = voffB[i] + (unsigned)(HALF * ldb) * 2u; Rr[i] = R; Cc[i] = (unsigned)C * 2u;
        cv0[i] = (unsigned)(R * lda + C) * 2u; cv1[i] = cv0[i] + (unsigned)(HALF * lda) * 2u; nv0[i] = cv0[i]; nv1[i] = cv1[i]; }
    const size_t kstep = (size_t)(BK * 2);
    const unsigned ldsw = (unsigned)wid * 1024u;
    const int aoff = lds_byte(wr * 64 + fr, fq * 8), boff = lds_byte(wc * 32 + fr, fq * 8);
#define PG8_SA(b, h) (((b) * 2 + (h)) * HTB)
#define PG8_SB(b, h) ((4 + (b) * 2 + (h)) * HTB)
#define PG8_STAGE2O(bufoff, gbase, v0, v1, OFF) do { \
        __builtin_amdgcn_global_load_lds((const unsigned*)((const char*)(gbase) + (v0)), (LAS unsigned*)(lds + ((bufoff) - (OFF)) + ldsw), 16, OFF, 0); \
        __builtin_amdgcn_global_load_lds((const unsigned*)((const char*)(gbase) + (v1)), (LAS unsigned*)(lds + ((bufoff) - (OFF)) + ldsw + 8192), 16, OFF, 0); } while (0)
#define PG8_STAGE2(bufoff, gbase, v0, v1) PG8_STAGE2O(bufoff, gbase, v0, v1, 0)
#define PG8_STAGEB(bufoff, gbase) PG8_STAGE2(bufoff, gbase, voffB[0], voffB[1])
#define PG8_STAGEBO(bufoff, gbase, OFF) PG8_STAGE2O(bufoff, gbase, voffB[0], voffB[1], OFF)
#define PG8_STAGEBH(bufoff, gbase, OFF) PG8_STAGE2O(bufoff, gbase, voffBh[0], voffBh[1], OFF)
#define PG8_LDA(dst, b, h) do { if constexpr (FP8) { _Pragma("unroll") for (int m = 0; m < 4; ++m) dst##8[m] = *(const LAS i32x8*)(lds + PG8_SA(b, h) + aoff8 + m * 2048); } \
        else { _Pragma("unroll") for (int m = 0; m < 4; ++m) _Pragma("unroll") for (int k = 0; k < 2; ++k) dst[m][k] = *(const LAS bf16x8*)(lds + PG8_SA(b, h) + aoff + m * 2048 + k * 1024); } } while (0)
#define PG8_LDB(dst, b, h) do { if constexpr (FP8) { _Pragma("unroll") for (int n = 0; n < 2; ++n) dst##8[n] = *(const LAS i32x8*)(lds + PG8_SB(b, h) + boff8 + n * 2048); } \
        else { _Pragma("unroll") for (int n = 0; n < 2; ++n) _Pragma("unroll") for (int k = 0; k < 2; ++k) dst[n][k] = *(const LAS bf16x8*)(lds + PG8_SB(b, h) + boff + n * 2048 + k * 1024); } } while (0)
#define PG8_MMA(ai, bj, At, Bt) do { __builtin_amdgcn_s_setprio(1); \
        if constexpr (FP8) { _Pragma("unroll") for (int m = 0; m < 4; ++m) _Pragma("unroll") for (int n = 0; n < 2; ++n) \
            asm volatile("v_mfma_scale_f32_16x16x128_f8f6f4 %0, %1, %2, %0, %3, %3 op_sel_hi:[0,0,0]" : "+v"(acc[ai][bj][m][n]) : "v"(Bt##8[n]), "v"(At##8[m]), "v"(mxscale)); } \
        else { _Pragma("unroll") for (int m = 0; m < 4; ++m) _Pragma("unroll") for (int n = 0; n < 2; ++n) _Pragma("unroll") for (int k = 0; k < 2; ++k) \
            acc[ai][bj][m][n] = __builtin_amdgcn_mfma_f32_16x16x32_bf16(Bt[n][k], At[m][k], acc[ai][bj][m][n], 0, 0, 0); } __builtin_amdgcn_s_setprio(0); } while (0)
#define PG8_WAIT_V(n) asm volatile("s_waitcnt vmcnt(" #n ")" ::: "memory")
#define PG8_WAIT_L(n) asm volatile("s_waitcnt lgkmcnt(" #n ")" ::: "memory")
#define PG8_BAR __builtin_amdgcn_s_barrier()
#define PG8_SCHED __builtin_amdgcn_sched_barrier(0)
    Unit cur, nxt; int ui = 0;
    if (!S.next(0, cur)) return;
    if constexpr (GATHER) {
#pragma unroll
        for (int i = 0; i < 2; ++i) { cv0[i] = rowtab[Rr[i]] + Cc[i]; cv1[i] = rowtab[HALF + Rr[i]] + Cc[i]; }
    }
    f32x4 acc[2][2][4][2];
#pragma unroll
    for (int a = 0; a < 2; ++a)
#pragma unroll
        for (int b = 0; b < 2; ++b)
#pragma unroll
            for (int m = 0; m < 4; ++m)
#pragma unroll
                for (int n = 0; n < 2; ++n) acc[a][b][m][n] = (f32x4){0.f, 0.f, 0.f, 0.f};
    bf16x8 At[4][2], B0[2][2], B1[2][2];
    i32x8 At8[4], B08[2], B18[2];
    const int mxscale = 0x7f7f7f7f;
    const int aoff8 = ((fq >> 1) * 1024) + (((wr * 64 + fr) & 15) * 64 + (fq & 1) * 32 ^ (((((wr * 64 + fr) & 15) * 64) >> 9) & 1) << 5) + (((wr * 64 + fr) >> 4) * 2048);
    const int boff8 = ((fq >> 1) * 1024) + (((wc * 32 + fr) & 15) * 64 + (fq & 1) * 32 ^ (((((wc * 32 + fr) & 15) * 64) >> 9) & 1) << 5) + (((wc * 32 + fr) >> 4) * 2048);
    const char* cA = cur.a; const char* cB = cur.b;
    PG8_STAGEBO(PG8_SB(0, 0), cB, 0); PG8_STAGEBH(PG8_SB(0, 1), cB, 0); PG8_STAGE2(PG8_SA(0, 0), cA, cv0[0], cv0[1]); PG8_STAGE2(PG8_SA(0, 1), cA, cv1[0], cv1[1]);
    if (wr == 1) PG8_BAR;
    PG8_WAIT_V(2); PG8_BAR;
    PG8_STAGEBO(PG8_SB(1, 0), cB, 128); PG8_STAGE2O(PG8_SA(1, 0), cA, cv0[0], cv0[1], 128); PG8_STAGEBH(PG8_SB(1, 1), cB, 128);
    PG8_WAIT_V(6); PG8_BAR;
    for (;;) {
        const bool has_next = S.next(ui + 1, nxt);
        const bool skip_hi = HALFSKIP && cur.x0 <= 128;
        const char* nA = has_next ? nxt.a : cA; const char* nB = has_next ? nxt.b : cB;
        if constexpr (GATHER) {
            if (has_next) {
#pragma unroll
                for (int i = 0; i < 2; ++i) { nv0[i] = rowtab[(ui + 1) * 256 + Rr[i]] + Cc[i]; nv1[i] = rowtab[(ui + 1) * 256 + HALF + Rr[i]] + Cc[i]; }
            } else {
#pragma unroll
                for (int i = 0; i < 2; ++i) { nv0[i] = cv0[i]; nv1[i] = cv1[i]; }
            }
        }
#pragma unroll 1
        for (int t = 0; t < nt; t += 2) {
            const bool last = (t == nt - 2);
            if constexpr (Epi::HAS_MID) { if (t == Epi::MID_T) E.mid(acc, cur, wr, wc, fr, fq); }
            const char* pA = cA + (size_t)t * kstep; const char* pB = cB + (size_t)t * kstep;
            const char* qA = last ? nA - 256 : pA; const char* qB = last ? nB - 256 : pB;
            unsigned x00, x01, x10, x11;
            if constexpr (GATHER) { x00 = last ? nv0[0] : cv0[0]; x01 = last ? nv0[1] : cv0[1]; x10 = last ? nv1[0] : cv1[0]; x11 = last ? nv1[1] : cv1[1]; }
            else { x00 = cv0[0]; x01 = cv0[1]; x10 = cv1[0]; x11 = cv1[1]; }
            PG8_LDB(B0, 0, 0); PG8_LDB(B1, 0, 1); PG8_SCHED; PG8_LDA(At, 0, 0); PG8_STAGE2O(PG8_SA(1, 1), pA, cv1[0], cv1[1], 128);
            PG8_WAIT_V(8); PG8_WAIT_L(0); PG8_BAR; PG8_MMA(0, 0, At, B0); PG8_MMA(0, 1, At, B1); PG8_BAR; PG8_SCHED;
            PG8_LDA(At, 0, 1); PG8_STAGEBO(PG8_SB(0, 0), qB, 256); PG8_STAGEBH(PG8_SB(0, 1), qB, 256); PG8_STAGE2O(PG8_SA(0, 0), qA, x00, x01, 256);
            PG8_WAIT_V(8); PG8_WAIT_L(0); PG8_BAR; if (!skip_hi) { PG8_MMA(1, 0, At, B0); PG8_MMA(1, 1, At, B1); } PG8_BAR; PG8_SCHED;
            PG8_LDB(B0, 1, 0); PG8_LDB(B1, 1, 1); PG8_SCHED; PG8_LDA(At, 1, 0); PG8_STAGE2O(PG8_SA(0, 1), qA, x10, x11, 256);
            PG8_WAIT_V(8); PG8_WAIT_L(0); PG8_BAR; PG8_MMA(0, 0, At, B0); PG8_MMA(0, 1, At, B1); PG8_BAR; PG8_SCHED;
            PG8_LDA(At, 1, 1); PG8_STAGEBO(PG8_SB(1, 0), qB, 384); PG8_STAGEBH(PG8_SB(1, 1), qB, 384); PG8_STAGE2O(PG8_SA(1, 0), qA, x00, x01, 384);
            PG8_WAIT_V(8); PG8_WAIT_L(0); PG8_BAR; if (!skip_hi) { PG8_MMA(1, 0, At, B0); PG8_MMA(1, 1, At, B1); } PG8_BAR; PG8_SCHED;
        }
        if (wr == 0) PG8_BAR;
        if constexpr (FP8) asm volatile("s_nop 15\n\ts_nop 15" ::: "memory");
        E(acc, cur, ui, wr, wc, fr, fq);
        if constexpr (Epi::HAS_POST) E.post(ui);
        if (!has_next) break;
#pragma unroll
        for (int a = 0; a < 2; ++a)
#pragma unroll
            for (int b = 0; b < 2; ++b)
#pragma unroll
                for (int m = 0; m < 4; ++m)
#pragma unroll
                    for (int n = 0; n < 2; ++n) acc[a][b][m][n] = (f32x4){0.f, 0.f, 0.f, 0.f};
        cur = nxt; cA = nA; cB = nB; ++ui;
        if constexpr (GATHER) {
#pragma unroll
            for (int i = 0; i < 2; ++i) { cv0[i] = nv0[i]; cv1[i] = nv1[i]; }
        }
        if (wr == 1) PG8_BAR;
    }
    PG8_WAIT_V(0);
    PG8_BAR;
#undef PG8_SA
#undef PG8_SB
#undef PG8_STAGE2
#undef PG8_STAGE2O
#undef PG8_STAGEB
#undef PG8_STAGEBO
#undef PG8_STAGEBH
#undef PG8_LDA
#undef PG8_LDB
#undef PG8_MMA
#undef PG8_WAIT_V
#undef PG8_WAIT_L
#undef PG8_BAR
#undef PG8_SCHED
}
}

#define XB_TMO      128
#define XB_XCNT(j)  (256  + 64 * (j))
#define XB_XSUB(j)  (1280 + 64 * (j))
#define XB_XGEN(j)  (2304 + 64 * (j))
#define XB_TOP      3328
#define XB_TOPGEN   3392
#define XCD_BAR_WORDS 3456
#define XB_SPIN_CAP (1u << 18)

__device__ __forceinline__ unsigned xb_ld(unsigned* p)              { return __hip_atomic_load(p, __ATOMIC_RELAXED, __HIP_MEMORY_SCOPE_AGENT); }
__device__ __forceinline__ unsigned xb_add(unsigned* p, unsigned v) { return __hip_atomic_fetch_add(p, v, __ATOMIC_RELAXED, __HIP_MEMORY_SCOPE_AGENT); }
__device__ __forceinline__ unsigned xb_xcc_id() { return (unsigned)__builtin_amdgcn_s_getreg((3 << 11) | 20) & 0xFu; }
#define XB_SPIN(cond, bar) do { unsigned _sp = 0; while (cond) { __builtin_amdgcn_s_sleep(1); \
    if ((++_sp & 255u) == 0u) { if (xb_ld(&(bar)[XB_TMO])) break; if (_sp > XB_SPIN_CAP) { atomicAdd(&(bar)[XB_TMO], 1u); break; } } } } while (0)

struct XcdBarrier {
    unsigned* bar; unsigned x;
    volatile LAS unsigned* st;
};

__device__ __forceinline__ XcdBarrier xcd_barrier_post(unsigned* bar, volatile LAS unsigned* st) {
    XcdBarrier b; b.bar = bar; b.x = xb_xcc_id(); b.st = st;
    if (threadIdx.x == 0) (void)xb_add(&bar[XB_XCNT(b.x)], 1u);
    return b;
}
__device__ __forceinline__ void xcd_barrier_complete(unsigned* bar, unsigned x, unsigned& nloc, unsigned& nx) {
    const unsigned G = gridDim.x * gridDim.y * gridDim.z;
    unsigned sum, cnt, mine, sp = 0u;
    for (;;) {
        sum = 0u; cnt = 0u; mine = 0u;
#pragma unroll
        for (unsigned j = 0; j < 16; ++j) { const unsigned c = xb_ld(&bar[XB_XCNT(j)]); sum += c; cnt += (c > 0u) ? 1u : 0u; mine = (j == x) ? c : mine; }
        if (sum == G) break;
        __builtin_amdgcn_s_sleep(1);
        if ((++sp & 255u) == 0u) { if (xb_ld(&bar[XB_TMO])) break; if (sp > XB_SPIN_CAP) { atomicAdd(&bar[XB_TMO], 1u); break; } }
    }
    nloc = mine > 0u ? mine : 1u; nx = cnt > 0u ? cnt : 1u;
}

__device__ __forceinline__ void xcd_barrier(const XcdBarrier& b) {
    asm volatile("s_waitcnt vmcnt(0)" ::: "memory");
    __syncthreads();
    if (threadIdx.x == 0) {
        unsigned* bar = b.bar;
        __builtin_amdgcn_s_waitcnt(0);
        unsigned nloc = b.st[0], nx = b.st[1];
        if (nloc == 0u) { xcd_barrier_complete(bar, b.x, nloc, nx); b.st[0] = nloc; b.st[1] = nx; }
        const unsigned old = xb_add(&bar[XB_XSUB(b.x)], 1u);
        const unsigned gen = old / nloc;
        if (old + 1u == (gen + 1u) * nloc) {
            __builtin_amdgcn_fence(__ATOMIC_RELEASE, "agent");
            asm volatile("s_waitcnt vmcnt(0)" ::: "memory");
            const unsigned og = xb_add(&bar[XB_TOP], 1u);
            const unsigned tg = og / nx;
            if (og + 1u == (tg + 1u) * nx) xb_add(&bar[XB_TOPGEN], 1u);
            else XB_SPIN(xb_ld(&bar[XB_TOPGEN]) == tg, bar);
            __builtin_amdgcn_fence(__ATOMIC_ACQUIRE, "agent");
            xb_add(&bar[XB_XGEN(b.x)], 1u);
            asm volatile("s_waitcnt vmcnt(0)" ::: "memory");
        } else {
            XB_SPIN(xb_ld(&bar[XB_XGEN(b.x)]) == gen, bar);
            __builtin_amdgcn_fence(__ATOMIC_ACQUIRE, "agent");
            asm volatile("s_waitcnt vmcnt(0)" ::: "memory");
        }
    }
    __syncthreads();
}

constexpr int NWAVES = 8;
#if PROBE_TIME >= 0
#define PT_MARK(k, e) do { if ((k) == PROBE_TIME && blockIdx.x == 0 && threadIdx.x == 0) { const unsigned long long t_ = __builtin_amdgcn_s_memrealtime(); volatile LAS unsigned* m_ = (volatile LAS unsigned*)(unsigned)L_MISC;        m_[32 + 2 * (e)] = (unsigned)t_; m_[33 + 2 * (e)] = (unsigned)(t_ >> 32); } } while (0)
#else
#define PT_MARK(k, e) do { } while (0)
#endif
struct Args { const float* in[20]; float* out; unsigned char* ws; int ph_lo, ph_hi; };
enum { I_X = 0, I_META, I_RELB, I_NMIX, I_WIN, I_SINK, I_PMIX, I_PSCL, I_WAB, I_WPB, I_WOUT, I_NFFN, I_WRG, I_BRG, I_WRE, I_BRE, I_WG, I_WU, I_WD, I_NFIN };
struct Frame {
    LAS unsigned char* lds;
    volatile LAS unsigned* MISC;
    unsigned* ctl;
    int tid, lane, wave, vcu, G;
    unsigned char* ws;
#define WSP(name, T, off) __device__ __forceinline__ T* name() const { return (T*)(ws + (off)); }
    WSP(WIN, bf16, WS_WIN) WSP(WAB, bf16, WS_WAB) WSP(WPT, bf16, WS_WPT) WSP(WO, bf16, WS_WO) WSP(PMS, bf16, WS_PMS) WSP(WR, bf16, WS_WR) WSP(WGU, bf16, WS_WGU) WSP(WD, bf16, WS_WD)
    WSP(HN, bf16, WS_HN) WSP(PROJ, bf16, WS_PROJ) WSP(AP, bf16, WS_AP) WSP(MERGED, bf16, WS_HN) WSP(H1B, bf16, WS_AP) WSP(HID, bf16, WS_HN) WSP(Y, bf16, WS_PROJ)
    WSP(SSQ, float, WS_SSQ) WSP(H1, float, WS_H1) WSP(LR, float, WS_LR) WSP(LW, float, WS_LW) WSP(LTOK, int, WS_LTOK) WSP(TINFO, i32x4, WS_TINFO) WSP(GATE, unsigned char, WS_GATE) WSP(H8, unsigned char, WS_H8) WSP(HN8, unsigned char, WS_HN8) WSP(WIN8, unsigned char, WS_WIN8)
#undef WSP
};

__device__ __forceinline__ int lane_id() { return (int)__builtin_amdgcn_mbcnt_hi(~0u, __builtin_amdgcn_mbcnt_lo(~0u, 0u)); }
__device__ __forceinline__ float wave_sum(float v) {
#pragma unroll
    for (int o = 1; o < 64; o <<= 1) v += __shfl_xor(v, o);
    return v;
}

template <bool SCALE>
__device__ __forceinline__ void p0_item(const float* W, int N, int k0, int n0, bf16* WT, int ldt, int wrow0, const float* ks, LAS float* scr, int lane) {
#pragma unroll 8
    for (int i = 0; i < 32; ++i) { const int kk = 2 * i + (lane >> 5); float v = W[(size_t)(k0 + kk) * N + n0 + (lane & 31)]; if constexpr (SCALE) v *= ks[k0 + kk]; scr[kk * 33 + (lane & 31)] = v; }
    LDS_WAIT(); asm volatile("" ::: "memory");
    const int c = lane & 7;
#pragma unroll
    for (int j = 0; j < 4; ++j) { const int n = (lane >> 3) + 8 * j; const LAS float* s = scr + (8 * c) * 33 + n;
        u32x4 o; o.x = cvt_pk_bf16(s[0 * 33], s[1 * 33]); o.y = cvt_pk_bf16(s[2 * 33], s[3 * 33]); o.z = cvt_pk_bf16(s[4 * 33], s[5 * 33]); o.w = cvt_pk_bf16(s[6 * 33], s[7 * 33]);
        *(u32x4*)(WT + (size_t)(wrow0 + n) * ldt + k0 + 8 * c) = o; }
    LDS_WAIT(); asm volatile("" ::: "memory");
}
__device__ __forceinline__ void p0_item8(const float* W, int N, int k0, int n0, unsigned char* WT, int ldt, int wrow0, float scl, LAS float* scr, int lane) {
#pragma unroll 8
    for (int i = 0; i < 32; ++i) { const int kk = 2 * i + (lane >> 5); scr[kk * 33 + (lane & 31)] = W[(size_t)(k0 + kk) * N + n0 + (lane & 31)] * scl; }
    LDS_WAIT(); asm volatile("" ::: "memory");
    const int c = lane & 7;
#pragma unroll
    for (int j = 0; j < 4; ++j) { const int n = (lane >> 3) + 8 * j; const LAS float* s = scr + (8 * c) * 33 + n;
        int p0 = __builtin_amdgcn_cvt_pk_fp8_f32(s[0 * 33], s[1 * 33], 0, false); p0 = __builtin_amdgcn_cvt_pk_fp8_f32(s[2 * 33], s[3 * 33], p0, true);
        int p1 = __builtin_amdgcn_cvt_pk_fp8_f32(s[4 * 33], s[5 * 33], 0, false); p1 = __builtin_amdgcn_cvt_pk_fp8_f32(s[6 * 33], s[7 * 33], p1, true);
        *(u32x2*)(WT + (size_t)(wrow0 + n) * ldt + k0 + 8 * c) = (u32x2){(unsigned)p0, (unsigned)p1}; }
    LDS_WAIT(); asm volatile("" ::: "memory");
}
template <int NR>
__device__ __forceinline__ void rms_rows_to_bf16(const float* const (&xrow)[NR], const float* g, bf16* const (&orow)[NR], unsigned char* const (&o8row)[NR], int lane) {
    const f32x4* gr = (const f32x4*)g + lane;
    f32x4 v[NR][8]; float r[NR];
#pragma unroll
    for (int q = 0; q < NR; ++q) { const f32x4* xr = (const f32x4*)xrow[q] + lane;
#pragma unroll
        for (int j = 0; j < 8; ++j) v[q][j] = xr[64 * j]; }
#pragma unroll
    for (int q = 0; q < NR; ++q) { float s = 0.f;
#pragma unroll
        for (int j = 0; j < 8; ++j) s += (v[q][j].x * v[q][j].x + v[q][j].y * v[q][j].y) + (v[q][j].z * v[q][j].z + v[q][j].w * v[q][j].w);
        r[q] = 1.0f / sqrtf(wave_sum(s) * (1.0f / DM) + RMS_EPS); }
#pragma unroll
    for (int j = 0; j < 8; ++j) { const f32x4 gg = gr[64 * j];
#pragma unroll
        for (int q = 0; q < NR; ++q) { const float y0 = v[q][j].x * r[q] * gg.x, y1 = v[q][j].y * r[q] * gg.y, y2 = v[q][j].z * r[q] * gg.z, y3 = v[q][j].w * r[q] * gg.w;
            u32x2 w; w.x = cvt_pk_bf16(y0, y1); w.y = cvt_pk_bf16(y2, y3); ((u32x2*)orow[q] + lane)[64 * j] = w;
            if (o8row[q]) { const float z0 = __builtin_fminf(__builtin_fmaxf(y0 * 8.0f, -448.0f), 448.0f), z1 = __builtin_fminf(__builtin_fmaxf(y1 * 8.0f, -448.0f), 448.0f), z2 = __builtin_fminf(__builtin_fmaxf(y2 * 8.0f, -448.0f), 448.0f), z3 = __builtin_fminf(__builtin_fmaxf(y3 * 8.0f, -448.0f), 448.0f);
                int p = __builtin_amdgcn_cvt_pk_fp8_f32(z0, z1, 0, false); p = __builtin_amdgcn_cvt_pk_fp8_f32(z2, z3, p, true); ((unsigned*)o8row[q])[lane + 64 * j] = (unsigned)p; } } }
}

struct CvtJob { const float *wg, *wu, *wd, *ks; bf16 *WGU, *WD; int first, count, slot, wave; LAS unsigned char* scr; };
constexpr int CVT_ITEMS = 3 * 2048;
__device__ __forceinline__ void cvt_decode(const CvtJob& J, int q, int wave, const float*& W, int& N, bf16*& WT, int& ldt, int& wrow0, int& k0, bool& scale) {
    const int seg = q >> 11, r = q & 2047, e = r >> 5;
    if (seg < 2) { const int kb = r & 31, n0 = 64 * wave; k0 = 64 * kb; N = 512; ldt = 2048; scale = true;
        W = (seg ? J.wu : J.wg) + (size_t)e * 2048 * 512 + n0; WT = (bf16*)((unsigned char*)J.WGU + (size_t)e * 1024 * 2048); wrow0 = 256 * (n0 >> 7) + (n0 & 127) + (seg ? 128 : 0); }
    else { const int nq = (r >> 3) & 3, kb = r & 7, n0 = 512 * nq + 64 * wave; k0 = 64 * kb; N = 2048; ldt = 512; scale = false;
        W = J.wd + (size_t)e * 512 * 2048 + n0; WT = (bf16*)((unsigned char*)J.WD + (size_t)e * 2048 * 512); wrow0 = n0; }
}
__device__ __forceinline__ void cvt_load(f32x4 (&v)[16], const float* W, int N, int k0, int lane) {
    const float* p = W + (size_t)(k0 + 8 * (lane >> 4)) * N + 4 * (lane & 15);
#pragma unroll
    for (int i = 0; i < 16; ++i) v[i] = __builtin_nontemporal_load((const f32x4*)(p + (size_t)(i + (i >> 3) * 24) * N));
}
__device__ __forceinline__ void cvt_store(const f32x4 (&v)[16], bf16* WT, int ldt, int wrow0, int k0, const float* ks, bool scale, LAS unsigned char* scr  , int lane) {
    const int nl = lane & 15, kg = lane >> 4, kq = k0 + 8 * kg;
    float s[16];
    if (scale) {
#pragma unroll
        for (int i = 0; i < 4; ++i) { const f32x4 t = *(const f32x4*)(ks + kq + 4 * (i & 1) + 32 * (i >> 1)); s[4 * i] = t.x; s[4 * i + 1] = t.y; s[4 * i + 2] = t.z; s[4 * i + 3] = t.w; }
    } else {
#pragma unroll
        for (int i = 0; i < 16; ++i) s[i] = 1.0f;
    }
    LAS unsigned char* wp0 = scr + 128 * nl + 16 * (kg ^ (nl & 7)); LAS unsigned char* wp1 = scr + 128 * nl + 16 * ((4 + kg) ^ (nl & 7));
    const int R = lane >> 3, p = lane & 7;
    LAS const unsigned char* rp = scr + 128 * R + 16 * (p ^ (R & 7));
#pragma unroll
    for (int j = 0; j < 4; ++j) {
        u32x4 o0, o1;
        o0.x = cvt_pk_bf16(v[0][j] * s[0], v[1][j] * s[1]); o0.y = cvt_pk_bf16(v[2][j] * s[2], v[3][j] * s[3]); o0.z = cvt_pk_bf16(v[4][j] * s[4], v[5][j] * s[5]); o0.w = cvt_pk_bf16(v[6][j] * s[6], v[7][j] * s[7]);
        o1.x = cvt_pk_bf16(v[8][j] * s[8], v[9][j] * s[9]); o1.y = cvt_pk_bf16(v[10][j] * s[10], v[11][j] * s[11]); o1.z = cvt_pk_bf16(v[12][j] * s[12], v[13][j] * s[13]); o1.w = cvt_pk_bf16(v[14][j] * s[14], v[15][j] * s[15]);
        *(LAS u32x4*)wp0 = o0; *(LAS u32x4*)wp1 = o1;
        LDS_WAIT();
        const u32x4 a = *(LAS const u32x4*)rp, b = *(LAS const u32x4*)(rp + 1024);
        LDS_WAIT();
        bf16* dst = WT + (size_t)(wrow0 + 4 * R + j) * ldt + k0 + 8 * p;
        __builtin_nontemporal_store(a, (u32x4*)dst); __builtin_nontemporal_store(b, (u32x4*)(dst + (size_t)32 * ldt));
    }
}
__device__ __forceinline__ void cvt_store8(const f32x4 (&v)[16], unsigned char* WT, int ldt, int wrow0, int k0, const float* ks  , float scl, LAS unsigned char* scr, int lane) {
    const int nl = lane & 15, kg = lane >> 4, R = lane >> 2, p = lane & 3, kq = k0 + 8 * kg;
    float s[16];
    if (ks) {
#pragma unroll
        for (int i = 0; i < 4; ++i) { const f32x4 t = *(const f32x4*)(ks + kq + 4 * (i & 1) + 32 * (i >> 1)); s[4 * i] = t.x * scl; s[4 * i + 1] = t.y * scl; s[4 * i + 2] = t.z * scl; s[4 * i + 3] = t.w * scl; }
    } else {
#pragma unroll
        for (int i = 0; i < 16; ++i) s[i] = scl;
    }
    LAS unsigned char* wp = scr + 80 * nl + 8 * kg; LAS const unsigned char* rp = scr + 80 * R + 16 * p;
#pragma unroll
    for (int j = 0; j < 4; ++j) {
        int a0 = __builtin_amdgcn_cvt_pk_fp8_f32(v[0][j] * s[0], v[1][j] * s[1], 0, false); a0 = __builtin_amdgcn_cvt_pk_fp8_f32(v[2][j] * s[2], v[3][j] * s[3], a0, true);
        int a1 = __builtin_amdgcn_cvt_pk_fp8_f32(v[4][j] * s[4], v[5][j] * s[5], 0, false); a1 = __builtin_amdgcn_cvt_pk_fp8_f32(v[6][j] * s[6], v[7][j] * s[7], a1, true);
        int b0 = __builtin_amdgcn_cvt_pk_fp8_f32(v[8][j] * s[8], v[9][j] * s[9], 0, false); b0 = __builtin_amdgcn_cvt_pk_fp8_f32(v[10][j] * s[10], v[11][j] * s[11], b0, true);
        int b1 = __builtin_amdgcn_cvt_pk_fp8_f32(v[12][j] * s[12], v[13][j] * s[13], 0, false); b1 = __builtin_amdgcn_cvt_pk_fp8_f32(v[14][j] * s[14], v[15][j] * s[15], b1, true);
        *(LAS u32x2*)wp = (u32x2){(unsigned)a0, (unsigned)a1}; *(LAS u32x2*)(wp + 32) = (u32x2){(unsigned)b0, (unsigned)b1};
        LDS_WAIT();
        const u32x4 o = *(LAS const u32x4*)rp;
        LDS_WAIT();
        __builtin_nontemporal_store(o, (u32x4*)(WT + (size_t)(wrow0 + 4 * R + j) * ldt + k0 + 16 * p));
    }
}
__device__ __forceinline__ void cvt_run(const CvtJob& J, int lane) {
    int q = J.first; const int qe = J.first + J.count;
    for (; q + 1 < qe; q += 2) {
        const float *W0, *W1; bf16 *T0, *T1; int N0, N1, l0, l1, r0, r1, k0, k1; bool s0, s1;
        cvt_decode(J, q, J.wave, W0, N0, T0, l0, r0, k0, s0); cvt_decode(J, q + 1, J.wave, W1, N1, T1, l1, r1, k1, s1);
        f32x4 va[16], vb[16]; cvt_load(va, W0, N0, k0, lane); cvt_load(vb, W1, N1, k1, lane);
        cvt_store8(va, (unsigned char*)T0, l0, r0, k0, s0 ? J.ks : nullptr, s0 ? 1024.0f : 512.0f, J.scr, lane); cvt_store8(vb, (unsigned char*)T1, l1, r1, k1, s1 ? J.ks : nullptr, s1 ? 1024.0f : 512.0f, J.scr, lane);
    }
    if (q < qe) { const float* W0; bf16* T0; int N0, l0, r0, k0; bool s0; cvt_decode(J, q, J.wave, W0, N0, T0, l0, r0, k0, s0);
        f32x4 va[16]; cvt_load(va, W0, N0, k0, lane); cvt_store8(va, (unsigned char*)T0, l0, r0, k0, s0 ? J.ks : nullptr, s0 ? 1024.0f : 512.0f, J.scr, lane); }
}

__device__ __forceinline__ void p0_prologue(Frame& F, const Args& A) {
    LAS unsigned char* scr = F.lds + F.wave * 2048;
    const int lane = lane_id();
    const int gw = F.vcu * NWAVES + F.wave, NGW = F.G * NWAVES;
    constexpr int J_IN = 32 * 100, J_AB = 16 * 32, J_PB = 16 * 32, J_WO = 32 * 32, NJ = J_IN + J_AB + J_PB + J_WO;
    for (int it = gw; it < NJ; it += NGW) { f32x4 v[16]; int r = it;
        if (r < J_IN) { const int kb = r / 100, nb = r % 100, k0 = 64 * kb, n0 = 64 * nb; cvt_load(v, A.in[I_WIN] + n0, INW, k0, lane);
            if (nb < 36) cvt_store(v, F.WIN(), 2048, n0, k0, nullptr, false, scr, lane);
            if (nb < 20) cvt_store8(v, F.WIN8(), 2048, n0, k0, nullptr, 1024.0f, scr, lane);
            if (nb >= 36) cvt_store8(v, F.WIN8(), 2048, 1280 + 64 * (nb - 36), k0, nullptr, 1024.0f, scr, lane);
            continue; } r -= J_IN;
        if (r < J_AB) { const int kb = r >> 5, nb = r & 31; cvt_load(v, A.in[I_WAB] + 64 * nb, 2048, 64 * kb, lane); cvt_store(v, F.WAB(), 2048, 64 * nb, 64 * kb, nullptr, false, scr, lane); continue; } r -= J_AB;
        if (r < J_PB) { const int kb = r >> 5, nb = r & 31; cvt_load(v, A.in[I_WPB] + 64 * nb, 2048, 64 * kb, lane); cvt_store(v, F.WPT(), 1024, 64 * nb, 64 * kb, nullptr, false, scr, lane); continue; } r -= J_PB;
        { const int kb = r >> 5, nb = r & 31; cvt_load(v, A.in[I_WOUT] + 64 * nb, 2048, 64 * kb, lane); cvt_store(v, F.WO(), 2048, 64 * nb, 64 * kb, nullptr, false, scr, lane); }
    }
    const int gt = F.vcu * (NWAVES * 64) + F.tid, NGT = F.G * NWAVES * 64;
    for (int i = gt; i < 4 * 256 * 256 / 2; i += NGT) { const int e = 2 * i, g = e >> 16, j = e & 255; const float s0 = A.in[I_PSCL][g * 256 + j], s1 = A.in[I_PSCL][g * 256 + j + 1];
        ((unsigned*)F.PMS())[i] = cvt_pk_bf16(A.in[I_PMIX][e] * s0, A.in[I_PMIX][e + 1] * s1); }
    for (int i = gt; i < 80 * 2048; i += NGT) { const int n = i >> 11, k = i & 2047; float v = 0.f;
        if (n < 8) v = A.in[I_WRG][k * 8 + n] * A.in[I_NFFN][k]; else if (n < 72) v = A.in[I_WRE][k * 64 + (n - 8)] * A.in[I_NFFN][k];
        F.WR()[i] = (bf16)(cvt_pk_bf16(v, 0.f) & 0xffffu); }
    for (int m = gw; m + 3 * NGW < M; m += 4 * NGW) {
        const float* const xr[4] = {A.in[I_X] + (size_t)m * DM, A.in[I_X] + (size_t)(m + NGW) * DM, A.in[I_X] + (size_t)(m + 2 * NGW) * DM, A.in[I_X] + (size_t)(m + 3 * NGW) * DM};
        bf16* const orw[4] = {F.HN() + (size_t)m * DM, F.HN() + (size_t)(m + NGW) * DM, F.HN() + (size_t)(m + 2 * NGW) * DM, F.HN() + (size_t)(m + 3 * NGW) * DM};
        unsigned char* const o8[4] = {F.HN8() + (size_t)m * DM, F.HN8() + (size_t)(m + NGW) * DM, F.HN8() + (size_t)(m + 2 * NGW) * DM, F.HN8() + (size_t)(m + 3 * NGW) * DM};
        rms_rows_to_bf16<4>(xr, A.in[I_NMIX], orw, o8, lane); }
    if (gw < NMETA) { const float* const xr[1] = {A.in[I_META] + (size_t)gw * DM}; bf16* const orw[1] = {F.HN() + (size_t)(M + gw) * DM}; unsigned char* const o8[1] = {nullptr}; rms_rows_to_bf16<1>(xr, A.in[I_NMIX], orw, o8, lane); }
}


using pg8::Unit;
struct DenseOrder {
    const char* A; const char* B; int nM, nN, nwg, G, c, lda, ldb;
    __device__ __forceinline__ bool next(int i, Unit& u) const {
        const long L = (long)i * G + c; if (L >= nwg) return false;
        int pm, pn; pg8::tile_of((int)L, nM, nN, pm, pn); u.pm = pm; u.pn = pn; u.x0 = 0; u.x1 = 0;
        u.a = A + (size_t)pm * 256 * lda * 2; u.b = B + (size_t)pn * 256 * ldb * 2; return true; }
};
struct EpiProj {
    static constexpr bool HAS_MID = false; static constexpr int MID_T = 0;
    static constexpr bool HAS_POST = true;
    bf16* O; CvtJob job; int lane, colbase;
    __device__ __forceinline__ void post(int ui) const { if (ui == job.slot) cvt_run(job, lane); }
    __device__ __forceinline__ void operator()(const f32x4 (&acc)[2][2][4][2], const Unit& u, int, int wr, int wc, int fr, int fq) const {
        const int row0 = u.pm * 256 + wr * 64 + fr, col0 = colbase + u.pn * 256 + wc * 32 + 8 * fq;
#pragma unroll
        for (int ai = 0; ai < 2; ++ai)
#pragma unroll
            for (int m = 0; m < 4; ++m) { bf16* rowp = O + (size_t)(row0 + ai * 128 + m * 16) * PW + col0;
#pragma unroll
                for (int bj = 0; bj < 2; ++bj) { const f32x4 v0 = acc[ai][bj][m][0], v1 = acc[ai][bj][m][1];
                    u32x4 w; w.x = cvt_pk_bf16(v0[0], v0[1]); w.y = cvt_pk_bf16(v0[2], v0[3]); w.z = cvt_pk_bf16(v1[0], v1[1]); w.w = cvt_pk_bf16(v1[2], v1[3]);
                    *(u32x4*)(rowp + bj * 128) = w; } }
    }
};
struct EpiGate {
    static constexpr bool HAS_MID = false; static constexpr int MID_T = 0;
    static constexpr bool HAS_POST = true;
    unsigned char* G; bf16* O; CvtJob job; int lane, n1;
    __device__ __forceinline__ void post(int ui) const { if (ui + n1 == job.slot) cvt_run(job, lane); }
    __device__ __forceinline__ void operator()(const f32x4 (&acc)[2][2][4][2], const Unit& u, int, int wr, int wc, int fr, int fq) const {
        const int row0 = u.pm * 256 + wr * 64 + fr; constexpr float S = 1.0f / 8192.0f;
        if (u.pn < 5) { const int col0 = u.pn * 256 + wc * 32 + 8 * fq;
#pragma unroll
            for (int ai = 0; ai < 2; ++ai)
#pragma unroll
                for (int m = 0; m < 4; ++m) { bf16* rowp = O + (size_t)(row0 + ai * 128 + m * 16) * PW + col0;
#pragma unroll
                    for (int bj = 0; bj < 2; ++bj) { const f32x4 v0 = acc[ai][bj][m][0] * S, v1 = acc[ai][bj][m][1] * S;
                        u32x4 w; w.x = cvt_pk_bf16(v0[0], v0[1]); w.y = cvt_pk_bf16(v0[2], v0[3]); w.z = cvt_pk_bf16(v1[0], v1[1]); w.w = cvt_pk_bf16(v1[2], v1[3]);
                        *(u32x4*)(rowp + bj * 128) = w; } }
        } else { const int col0 = (u.pn - 5) * 256 + wc * 32 + 8 * fq;
#pragma unroll
            for (int ai = 0; ai < 2; ++ai)
#pragma unroll
                for (int m = 0; m < 4; ++m) { unsigned char* rowp = G + (size_t)(row0 + ai * 128 + m * 16) * GW + col0;
#pragma unroll
                    for (int bj = 0; bj < 2; ++bj) { const f32x4 v0 = acc[ai][bj][m][0] * S, v1 = acc[ai][bj][m][1] * S; unsigned q[8];
#pragma unroll
                        for (int e = 0; e < 4; ++e) { q[e] = (unsigned)fminf(sigmoidf_(v0[e]) * 256.0f, 255.0f); q[4 + e] = (unsigned)fminf(sigmoidf_(v1[e]) * 256.0f, 255.0f); }
                        u32x2 w; w.x = q[0] | (q[1] << 8) | (q[2] << 16) | (q[3] << 24); w.y = q[4] | (q[5] << 8) | (q[6] << 16) | (q[7] << 24);
                        *(u32x2*)(rowp + bj * 128) = w; } }
        }
    }
};
struct FoldOrder {
    const char* WPT; const char* PMS; int idx;
    __device__ __forceinline__ bool next(int i, Unit& u) const {
        if (i > 0 || idx < 0) return false; u.pm = idx >> 2; u.pn = idx & 3; u.x0 = 0; u.x1 = 0;
        u.a = WPT + ((size_t)u.pm * 256 * 1024 + (size_t)u.pn * 256) * 2; u.b = PMS + (size_t)u.pn * 65536 * 2; return true; }
};
struct EpiFold {
    static constexpr bool HAS_MID = false; static constexpr int MID_T = 0;
    static constexpr bool HAS_POST = false;
    bf16* O;
    __device__ __forceinline__ void operator()(const f32x4 (&acc)[2][2][4][2], const Unit& u, int, int wr, int wc, int fr, int fq) const {
        const int row0 = u.pm * 256 + wr * 64 + fr, col0 = 1024 + u.pn * 256 + wc * 32 + 8 * fq;
#pragma unroll
        for (int ai = 0; ai < 2; ++ai)
#pragma unroll
            for (int m = 0; m < 4; ++m) { bf16* rowp = O + (size_t)(row0 + ai * 128 + m * 16) * 2048 + col0;
#pragma unroll
                for (int bj = 0; bj < 2; ++bj) { const f32x4 v0 = acc[ai][bj][m][0], v1 = acc[ai][bj][m][1];
                    u32x4 w; w.x = cvt_pk_bf16(v0[0], v0[1]); w.y = cvt_pk_bf16(v0[2], v0[3]); w.z = cvt_pk_bf16(v1[0], v1[1]); w.w = cvt_pk_bf16(v1[2], v1[3]);
                    *(u32x4*)(rowp + bj * 128) = w; } }
    }
};
struct EpiBranch {
    static constexpr bool HAS_MID = true; static constexpr int MID_T = 16;
    static constexpr bool HAS_POST = false;
    const unsigned char* GATE; bf16* MG;
    static __device__ __forceinline__ void dec8(const u32x2 g, float (&f)[8]) {
        constexpr float S = 1.0f / 256.0f, H = 0.5f / 256.0f;
        f[0] = (float)(g.x & 0xffu) * S + H; f[1] = (float)((g.x >> 8) & 0xffu) * S + H; f[2] = (float)((g.x >> 16) & 0xffu) * S + H; f[3] = (float)(g.x >> 24) * S + H;
        f[4] = (float)(g.y & 0xffu) * S + H; f[5] = (float)((g.y >> 8) & 0xffu) * S + H; f[6] = (float)((g.y >> 16) & 0xffu) * S + H; f[7] = (float)(g.y >> 24) * S + H;
    }
    __device__ __forceinline__ void mid(f32x4 (&acc)[2][2][4][2], const Unit& u, int wr, int wc, int fr, int fq) const {
        const unsigned off0 = (unsigned)(u.pm * 256 + wr * 64 + fr) * (unsigned)GW + (unsigned)(u.pn * 256 + wc * 32 + 8 * fq);
#pragma unroll
        for (int ai = 0; ai < 2; ++ai) {
            u32x2 ga[4][2], gb[4][2];
#pragma unroll
            for (int m = 0; m < 4; ++m) { const unsigned off = off0 + (unsigned)(ai * 128 + m * 16) * (unsigned)GW;
#pragma unroll
                for (int bj = 0; bj < 2; ++bj) { ga[m][bj] = *(const u32x2*)(GATE + off + bj * 128); gb[m][bj] = *(const u32x2*)(GATE + off + 2048 + bj * 128); } }
            asm volatile("" ::: "memory");
#pragma unroll
            for (int m = 0; m < 4; ++m)
#pragma unroll
                for (int bj = 0; bj < 2; ++bj) { float fa[8], fb[8]; dec8(ga[m][bj], fa); dec8(gb[m][bj], fb);
#pragma unroll
                    for (int e = 0; e < 4; ++e) { acc[ai][bj][m][0][e] *= fa[e] * __builtin_amdgcn_rcpf(fb[e]); acc[ai][bj][m][1][e] *= fa[4 + e] * __builtin_amdgcn_rcpf(fb[4 + e]); } }
            asm volatile("" ::: "memory");
        }
    }
    __device__ __forceinline__ void operator()(const f32x4 (&acc)[2][2][4][2], const Unit& u, int, int wr, int wc, int fr, int fq) const {
        const unsigned row0 = (unsigned)(u.pm * 256 + wr * 64 + fr), col0 = (unsigned)(u.pn * 256 + wc * 32 + 8 * fq);
        const unsigned goff0 = row0 * (unsigned)GW + 2048u + col0, moff0 = row0 * 2048u + col0;
        u32x2 gb[2][4][2];
#pragma unroll
        for (int ai = 0; ai < 2; ++ai)
#pragma unroll
            for (int m = 0; m < 4; ++m) { const unsigned goff = goff0 + (unsigned)(ai * 128 + m * 16) * (unsigned)GW;
#pragma unroll
                for (int bj = 0; bj < 2; ++bj) gb[ai][m][bj] = *(const u32x2*)(GATE + goff + bj * 128); }
        asm volatile("" ::: "memory");
#pragma unroll
        for (int ai = 0; ai < 2; ++ai)
#pragma unroll
            for (int m = 0; m < 4; ++m) { const unsigned moff = moff0 + (unsigned)(ai * 128 + m * 16) * 2048u;
#pragma unroll
                for (int bj = 0; bj < 2; ++bj) { float fb[8]; dec8(gb[ai][m][bj], fb);
                    const f32x4 v0 = acc[ai][bj][m][0], v1 = acc[ai][bj][m][1];
                    u32x4 w; w.x = cvt_pk_bf16(v0[0] * fb[0], v0[1] * fb[1]); w.y = cvt_pk_bf16(v0[2] * fb[2], v0[3] * fb[3]); w.z = cvt_pk_bf16(v1[0] * fb[4], v1[1] * fb[5]); w.w = cvt_pk_bf16(v1[2] * fb[6], v1[3] * fb[7]);
                    *(u32x4*)(MG + moff + bj * 128) = w; } }
    }
};
struct EpiOut {
    static constexpr bool HAS_MID = false; static constexpr int MID_T = 0;
    static constexpr bool HAS_POST = false;
    const float* X; bf16* H1B; float* SSQ; unsigned char* H8;
    __device__ __forceinline__ void operator()(const f32x4 (&acc)[2][2][4][2], const Unit& u, int, int wr, int wc, int fr, int fq) const {
        PT_MARK(70, 0);
        const int row0 = u.pm * 256 + wr * 64 + fr, col0 = u.pn * 256 + wc * 32 + 8 * fq;
#pragma unroll
        for (int ai = 0; ai < 2; ++ai) {
            f32x4 xr[4][2][2];
#pragma unroll
            for (int m = 0; m < 4; ++m) { const size_t off = (size_t)(row0 + ai * 128 + m * 16) * 2048 + col0;
#pragma unroll
                for (int bj = 0; bj < 2; ++bj) { xr[m][bj][0] = *(const f32x4*)(X + off + bj * 128); xr[m][bj][1] = *(const f32x4*)(X + off + bj * 128 + 4); } }
            asm volatile("" ::: "memory");
#pragma unroll
            for (int m = 0; m < 4; ++m) { const int row = row0 + ai * 128 + m * 16; const size_t off = (size_t)row * 2048 + col0; float ss = 0.f;
#pragma unroll
                for (int bj = 0; bj < 2; ++bj) { const f32x4 v0 = acc[ai][bj][m][0] + xr[m][bj][0], v1 = acc[ai][bj][m][1] + xr[m][bj][1];
                    ss += (v0[0] * v0[0] + v0[1] * v0[1]) + (v0[2] * v0[2] + v0[3] * v0[3]) + (v1[0] * v1[0] + v1[1] * v1[1]) + (v1[2] * v1[2] + v1[3] * v1[3]);
                    u32x4 w; w.x = cvt_pk_bf16(v0[0], v0[1]); w.y = cvt_pk_bf16(v0[2], v0[3]); w.z = cvt_pk_bf16(v1[0], v1[1]); w.w = cvt_pk_bf16(v1[2], v1[3]);
                    *(u32x4*)(H1B + off + bj * 128) = w;
                    f32x4 z0 = v0 * 8.0f, z1 = v1 * 8.0f;
#pragma unroll
                    for (int e = 0; e < 4; ++e) { z0[e] = __builtin_fminf(__builtin_fmaxf(z0[e], -448.0f), 448.0f); z1[e] = __builtin_fminf(__builtin_fmaxf(z1[e], -448.0f), 448.0f); }
                    int p0 = __builtin_amdgcn_cvt_pk_fp8_f32(z0[0], z0[1], 0, false); p0 = __builtin_amdgcn_cvt_pk_fp8_f32(z0[2], z0[3], p0, true);
                    int p1 = __builtin_amdgcn_cvt_pk_fp8_f32(z1[0], z1[1], 0, false); p1 = __builtin_amdgcn_cvt_pk_fp8_f32(z1[2], z1[3], p1, true);
                    *(u32x2*)(H8 + off + bj * 128) = (u32x2){(unsigned)p0, (unsigned)p1}; }
                ss += __shfl_xor(ss, 16); ss += __shfl_xor(ss, 32);
                if (fq == 0) SSQ[(size_t)(u.pn * 4 + wc) * M + row] = ss; }
            asm volatile("" ::: "memory");
        }
#if PROBE_TIME == 70
        asm volatile("s_waitcnt vmcnt(0)" ::: "memory");
#endif
        PT_MARK(70, 1);
    }
};
struct MoeOrder {
    LAS const int* ud; int nunits; const char* A; const char* B; size_t a_row_bytes  , b_exp_bytes, b_panel_bytes;
    __device__ __forceinline__ bool next(int i, Unit& u) const {
        if (i >= nunits) return false;
        const int e = __builtin_amdgcn_readfirstlane(ud[i * 8 + 0]), pn = __builtin_amdgcn_readfirstlane(ud[i * 8 + 1]), nv = __builtin_amdgcn_readfirstlane(ud[i * 8 + 2]), rs = __builtin_amdgcn_readfirstlane(ud[i * 8 + 3]);
        u.pm = e; u.pn = pn; u.x0 = nv; u.x1 = rs; u.a = A + (size_t)rs * a_row_bytes; u.b = B + (size_t)e * b_exp_bytes + (size_t)pn * b_panel_bytes; return true; }
};
struct EpiGU {
    static constexpr bool HAS_MID = false; static constexpr int MID_T = 0;
    static constexpr bool HAS_POST = false;
    bf16* HID; LAS const float* rtab;
    __device__ __forceinline__ void operator()(const f32x4 (&acc)[2][2][4][2], const Unit& u, int ui, int wr, int wc, int fr, int fq) const {
        const int col0 = u.pn * 128 + wc * 32 + 8 * fq; const int nv = u.x0, rs = u.x1;
#pragma unroll
        for (int ai = 0; ai < 2; ++ai)
#pragma unroll
            for (int m = 0; m < 4; ++m) { const int rr = ai * 128 + wr * 64 + m * 16 + fr; const float r = rtab[ui * 256 + rr] * (1.0f / 8192.0f);
                int pk[2];
#pragma unroll
                for (int n = 0; n < 2; ++n) { f32x4 g = acc[ai][0][m][n] * r; const f32x4 uu = acc[ai][1][m][n] * r;
#pragma unroll
                    for (int e = 0; e < 4; ++e) g[e] = __builtin_fminf(__builtin_fmaxf(g[e] * sigmoidf_(g[e]) * uu[e] * 8.0f, -448.0f), 448.0f);
                    int p = __builtin_amdgcn_cvt_pk_fp8_f32(g[0], g[1], 0, false); pk[n] = __builtin_amdgcn_cvt_pk_fp8_f32(g[2], g[3], p, true); }
                const int p0 = pk[0], p1 = pk[1];
                if (rr < nv) *(u32x2*)((unsigned char*)HID + (size_t)(rs + rr) * DEXP + col0) = (u32x2){(unsigned)p0, (unsigned)p1}; }
    }
};
struct EpiDown {
    static constexpr bool HAS_MID = false; static constexpr int MID_T = 0;
    static constexpr bool HAS_POST = false;
    bf16* Y; LAS const float* wtab;
    __device__ __forceinline__ void operator()(const f32x4 (&acc)[2][2][4][2], const Unit& u, int ui, int wr, int wc, int fr, int fq) const {
        const int col0 = u.pn * 256 + wc * 32 + 8 * fq; const int nv = u.x0, rs = u.x1;
#pragma unroll
        for (int ai = 0; ai < 2; ++ai)
#pragma unroll
            for (int m = 0; m < 4; ++m) { const int rr = ai * 128 + wr * 64 + m * 16 + fr; const float wt = wtab[ui * 256 + rr] * (1.0f / 4096.0f); bf16* rowp = Y + (size_t)(rs + rr) * 2048 + col0;
#pragma unroll
                for (int bj = 0; bj < 2; ++bj) { const f32x4 v0 = acc[ai][bj][m][0] * wt, v1 = acc[ai][bj][m][1] * wt;
                    u32x4 w; w.x = cvt_pk_bf16(v0[0], v0[1]); w.y = cvt_pk_bf16(v0[2], v0[3]); w.z = cvt_pk_bf16(v1[0], v1[1]); w.w = cvt_pk_bf16(v1[2], v1[3]);
                    if (rr < nv) *(u32x4*)(rowp + bj * 128) = w; } }
    }
};

__device__ __forceinline__ void meta_proj_task(Frame& F, int task) {
    const int lane = F.lane, n0 = KOFF + 16 * task;
    const bf16* ap = F.HN() + (size_t)(M + (lane & 15)) * DM + 8 * (lane >> 4);
    const bf16* bp = F.WIN() + (size_t)(n0 + (lane & 15)) * DM + 8 * (lane >> 4);
    f32x4 acc = (f32x4){0.f, 0.f, 0.f, 0.f};
#pragma unroll 8
    for (int ks = 0; ks < 64; ++ks) { const bf16x8 a = *(const bf16x8*)(ap + 32 * ks), b = *(const bf16x8*)(bp + 32 * ks); acc = __builtin_amdgcn_mfma_f32_16x16x32_bf16(a, b, acc, 0, 0, 0); }
#pragma unroll
    for (int r = 0; r < 4; ++r) F.PROJ()[(size_t)(M + 4 * (lane >> 4) + r) * PW + n0 + (lane & 15)] = (bf16)(cvt_pk_bf16(acc[r], 0.f) & 0xffffu);
}

__device__ __forceinline__ int t5_bucket(int d) {
    if (d < 16) return d;
    return 16 + (d >= 19) + (d >= 21) + (d >= 24) + (d >= 27) + (d >= 31) + (d >= 35) + (d >= 40) + (d >= 46) + (d >= 52) + (d >= 59) + (d >= 67) + (d >= 77) + (d >= 87) + (d >= 99) + (d >= 113);
}
constexpr int A_KL = 0, A_KROW = 144;
constexpr int A_VT = 288 * 144, A_VROW = 584;
constexpr int A_BT = A_VT + 64 * 584;
static_assert(A_BT + 4096 <= RING_BYTES, "attention LDS");

template <int T>
__device__ __forceinline__ void attn_qtile(LAS const unsigned char* lds, LAS const float* BT, const bf16* Qrow, bf16* Orow, float sink, int blk, int lane) {
    const int r32 = lane & 31, hi = lane >> 5, qi = 32 * T + r32;
    bf16x8 qf[4];
#pragma unroll
    for (int ds = 0; ds < 4; ++ds) qf[ds] = *(const bf16x8*)(Qrow + (size_t)r32 * PW + ds * 16 + hi * 8);
    f32x16 s[6];
#pragma unroll
    for (int ti = 0; ti < 6; ++ti) {
        const int kkb = (ti == 0) ? 0 : (ti <= 4 - T ? 32 + 32 * (T + ti - 1) : 160 + 32 * (ti - (5 - T)));
        f32x16 a = (f32x16){0.f, 0.f, 0.f, 0.f, 0.f, 0.f, 0.f, 0.f, 0.f, 0.f, 0.f, 0.f, 0.f, 0.f, 0.f, 0.f};
#pragma unroll
        for (int ds = 0; ds < 4; ++ds) { const bf16x8 kf = *(const LAS bf16x8*)(lds + A_KL + (kkb + r32) * A_KROW + ds * 32 + hi * 16); a = __builtin_amdgcn_mfma_f32_32x32x16_bf16(kf, qf[ds], a, 0, 0, 0); }
        s[ti] = a;
    }
    float mx = sink;
#pragma unroll
    for (int r = 0; r < 8; ++r) { const int i = (r & 3) + 8 * (r >> 2) + 4 * hi; int dist = 16 + 128 * blk + qi - i; dist = dist > 127 ? 127 : dist;
        const float x = s[0][r] * 0.125f + BT[dist]; s[0][r] = x; mx = fmaxf(mx, x); }
#pragma unroll
    for (int ti = 1; ti < 6; ++ti) {
        const bool prev = ti <= 4 - T; const int jt = prev ? (T + ti - 1) : (ti - (5 - T));
#pragma unroll
        for (int r = 0; r < 16; ++r) { const int i = (r & 3) + 8 * (r >> 2) + 4 * hi, j = 32 * jt + i;
            int dist; bool vis;
            if (prev) { dist = 128 + qi - j; vis = (blk > 0) && (jt > T || j > qi); } else { dist = qi - j; vis = (jt < T) || (j <= qi); }
            dist = dist < 0 ? 0 : (dist > 127 ? 127 : dist);
            const float x = vis ? s[ti][r] * 0.125f + BT[dist] : -1e30f; s[ti][r] = x; mx = fmaxf(mx, x); }
    }
    mx = fmaxf(mx, __shfl_xor(mx, 32));
    float l = 0.f;
#pragma unroll
    for (int r = 0; r < 8; ++r) { const float p = __expf(s[0][r] - mx); s[0][r] = p; l += p; }
#pragma unroll
    for (int ti = 1; ti < 6; ++ti)
#pragma unroll
        for (int r = 0; r < 16; ++r) { const float p = __expf(s[ti][r] - mx); s[ti][r] = p; l += p; }
    l += __shfl_xor(l, 32); l += __expf(sink - mx);
    f32x16 o[2];
    o[0] = (f32x16){0.f, 0.f, 0.f, 0.f, 0.f, 0.f, 0.f, 0.f, 0.f, 0.f, 0.f, 0.f, 0.f, 0.f, 0.f, 0.f}; o[1] = o[0];
#pragma unroll
    for (int ti = 0; ti < 6; ++ti) {
        const int kkb = (ti == 0) ? 0 : (ti <= 4 - T ? 32 + 32 * (T + ti - 1) : 160 + 32 * (ti - (5 - T)));
#pragma unroll
        for (int s2 = 0; s2 < 2; ++s2) {
            if (ti == 0 && s2 == 1) continue;
            u32x4 pw; pw.x = cvt_pk_bf16(s[ti][8 * s2 + 0], s[ti][8 * s2 + 1]); pw.y = cvt_pk_bf16(s[ti][8 * s2 + 2], s[ti][8 * s2 + 3]); pw.z = cvt_pk_bf16(s[ti][8 * s2 + 4], s[ti][8 * s2 + 5]); pw.w = cvt_pk_bf16(s[ti][8 * s2 + 6], s[ti][8 * s2 + 7]);
            const bf16x8 pf = __builtin_bit_cast(bf16x8, pw);
#pragma unroll
            for (int dt = 0; dt < 2; ++dt) { LAS const unsigned char* vp = lds + A_VT + (dt * 32 + r32) * A_VROW + (kkb + 16 * s2 + 4 * hi) * 2;
                const u32x2 lo = *(const LAS u32x2*)vp, hi2 = *(const LAS u32x2*)(vp + 16);
                const bf16x8 vf = __builtin_bit_cast(bf16x8, (u32x4){lo.x, lo.y, hi2.x, hi2.y});
                o[dt] = __builtin_amdgcn_mfma_f32_32x32x16_bf16(vf, pf, o[dt], 0, 0, 0); }
        }
    }
    const float inv = 1.0f / l;
#pragma unroll
    for (int dt = 0; dt < 2; ++dt)
#pragma unroll
        for (int g4 = 0; g4 < 4; ++g4) { u32x2 w; w.x = cvt_pk_bf16(o[dt][4 * g4 + 0] * inv, o[dt][4 * g4 + 1] * inv); w.y = cvt_pk_bf16(o[dt][4 * g4 + 2] * inv, o[dt][4 * g4 + 3] * inv);
            *(u32x2*)(Orow + (size_t)r32 * 2048 + dt * 32 + 8 * g4 + 4 * hi) = w; }
}

template <int W>
__device__ __forceinline__ void mixed_task(const bf16* ub  , bf16* ob  , int b, int s0) {
    constexpr int NR = 16 + W - 1;
    u32x4 u[NR];
#pragma unroll
    for (int i = 0; i < NR; ++i) { const int s = s0 - (W - 1) + i; const size_t row = s >= 0 ? (size_t)(b * SEQ + s) : (size_t)(M + 16 + s); u[i] = *(const u32x4*)(ub + row * PW); }
    constexpr float iw = 1.0f / (float)W;
#pragma unroll
    for (int t = 0; t < 16; ++t) {
        float a[8];
#pragma unroll
        for (int e = 0; e < 8; ++e) a[e] = 0.f;
#pragma unroll
        for (int j = 0; j < W; ++j) { const u32x4 v = u[t + j];
            a[0] += bf_lo(v.x); a[1] += bf_hi(v.x); a[2] += bf_lo(v.y); a[3] += bf_hi(v.y); a[4] += bf_lo(v.z); a[5] += bf_hi(v.z); a[6] += bf_lo(v.w); a[7] += bf_hi(v.w); }
        const u32x4 own = u[t + W - 1];
        u32x4 o; o.x = cvt_pk_bf16(a[0] * iw - bf_lo(own.x), a[1] * iw - bf_hi(own.x)); o.y = cvt_pk_bf16(a[2] * iw - bf_lo(own.y), a[3] * iw - bf_hi(own.y));
        o.z = cvt_pk_bf16(a[4] * iw - bf_lo(own.z), a[5] * iw - bf_hi(own.z)); o.w = cvt_pk_bf16(a[6] * iw - bf_lo(own.w), a[7] * iw - bf_hi(own.w));
        *(u32x4*)(ob + (size_t)t * 2048) = o;
    }
}

__device__ __forceinline__ void attn_unit(Frame& F, const Args& A, int b, int blk, int kvh) {
    LAS unsigned char* lds = F.lds; const int tid = F.tid; const int m0 = b * SEQ + blk * 128;
    PT_MARK(20, 0);
    for (int c = tid; c < 288 * 8; c += NWAVES * 64) { const int kk = c >> 3, ch = c & 7; int row = -1;
        if (kk < 16) row = M + kk; else if (kk >= 160) row = m0 + (kk - 160); else if (kk >= 32 && blk > 0) row = m0 - 128 + (kk - 32);
        u32x4 kv = (u32x4){0u, 0u, 0u, 0u}, vv = kv;
        if (row >= 0) { const bf16* p = F.PROJ() + (size_t)row * PW + kvh * 64 + ch * 8; kv = *(const u32x4*)(p + KOFF); vv = *(const u32x4*)(p + VOFF); }
        *(LAS u32x4*)(lds + A_KL + kk * A_KROW + ch * 16) = kv;
        if (kk < 16 || kk >= 32) { LAS bf16* vt = (LAS bf16*)(lds + A_VT) + (size_t)(ch * 8) * 292 + kk;
            vt[0 * 292] = (bf16)(vv.x & 0xffffu); vt[1 * 292] = (bf16)(vv.x >> 16); vt[2 * 292] = (bf16)(vv.y & 0xffffu); vt[3 * 292] = (bf16)(vv.y >> 16);
            vt[4 * 292] = (bf16)(vv.z & 0xffffu); vt[5 * 292] = (bf16)(vv.z >> 16); vt[6 * 292] = (bf16)(vv.w & 0xffffu); vt[7 * 292] = (bf16)(vv.w >> 16); }
    }
    LAS float* BTall = (LAS float*)(lds + A_BT);
    for (int t = tid; t < 8 * 128; t += NWAVES * 64) { const int g = t >> 7, d = t & 127; BTall[t] = A.in[I_RELB][t5_bucket(d) * 16 + kvh * 8 + g]; }
    __syncthreads();
    PT_MARK(20, 1); PT_MARK(21, 0);
    const int g = F.wave, hq = kvh * 8 + g; const float sink = A.in[I_SINK][hq];
    const bf16* Q = F.PROJ() + (size_t)m0 * PW + hq * 64; bf16* O = F.AP() + (size_t)m0 * 2048 + hq * 64;
    LAS const float* BT = BTall + g * 128;
    attn_qtile<0>(lds, BT, Q, O, sink, blk, F.lane);
    attn_qtile<1>(lds, BT, Q + (size_t)32 * PW, O + (size_t)32 * 2048, sink, blk, F.lane);
    attn_qtile<2>(lds, BT, Q + (size_t)64 * PW, O + (size_t)64 * 2048, sink, blk, F.lane);
    attn_qtile<3>(lds, BT, Q + (size_t)96 * PW, O + (size_t)96 * 2048, sink, blk, F.lane);
    PT_MARK(21, 1); PT_MARK(22, 0);
    { const int grp = 2 * kvh + (F.wave & 1), r0 = 16 * (2 * (F.wave >> 1) + (F.lane >> 5)), c8 = grp * 256 + (F.lane & 31) * 8;
      const bf16* ub = F.PROJ() + UOFF + c8; bf16* ob = F.AP() + (size_t)(m0 + r0) * 2048 + 1024 + c8; const int s0 = blk * 128 + r0;
      if (grp == 0) mixed_task<2>(ub, ob, b, s0); else if (grp == 1) mixed_task<4>(ub, ob, b, s0); else if (grp == 2) mixed_task<8>(ub, ob, b, s0); else mixed_task<16>(ub, ob, b, s0); }
    PT_MARK(22, 1);
    __syncthreads();
}

__device__ __forceinline__ void router_group(Frame& F, const Args& A, int tg, const int dummy = 0) {
    LAS unsigned char* lds = F.lds; const int lane = F.lane, w = F.wave, q = w & 3, kh = w >> 2;
    LAS float* part = (LAS float*)lds;
    LAS float* logit = (LAS float*)(lds + 20480);
    const int t0 = tg * 64 + q * 16;
    f32x4 acc[5];
#pragma unroll
    for (int n = 0; n < 5; ++n) acc[n] = (f32x4){0.f, 0.f, 0.f, 0.f};
    constexpr int RB_OFF = 40960, RB_ROW = 272, RB_BUF = 160 * RB_ROW;
    static_assert(RB_OFF + 2 * RB_BUF <= RING_BYTES, "router LDS");
    const int srow = F.tid >> 4, sl16 = F.tid & 15;
    u32x4 sb[5]; bf16x8 an[4], ac[4];
    const bf16* ap = F.H1B() + (size_t)(t0 + (lane & 15)) * DM + kh * 1024 + 8 * (lane >> 4);
#define RT_LOADB(cc) do { _Pragma("unroll") for (int p = 0; p < 5; ++p) { const int row = p * 32 + srow, h = row >= 80 ? 1 : 0, n = row - 80 * h; \
        sb[p] = *(const u32x4*)(F.WR() + (size_t)n * DM + 1024 * h + 128 * (cc) + 8 * sl16); } } while (0)
#define RT_STOREB(bufi) do { _Pragma("unroll") for (int p = 0; p < 5; ++p) *(LAS u32x4*)(lds + RB_OFF + (bufi) * RB_BUF + (p * 32 + srow) * RB_ROW + 16 * sl16) = sb[p]; } while (0)
#define RT_LOADA(dst, cc) do { _Pragma("unroll") for (int ks = 0; ks < 4; ++ks) dst[ks] = *(const bf16x8*)(ap + 128 * (cc) + 32 * ks); } while (0)
    PT_MARK(50, 0);
    float ss_row = 0.f;
    if (F.tid < 64) {
#pragma unroll
        for (int p = 0; p < 32; ++p) ss_row += F.SSQ()[(size_t)p * M + tg * 64 + F.tid]; }
    RT_LOADB(0); RT_LOADA(ac, 0); RT_STOREB(0);
    __syncthreads();
#pragma unroll
    for (int cc = 0; cc < 8; ++cc) {
        if (cc < 7) { RT_LOADB(cc + 1); RT_LOADA(an, cc + 1); }
        LAS const unsigned char* bb = lds + RB_OFF + (cc & 1) * RB_BUF + (kh * 80 + (lane & 15)) * RB_ROW + 16 * (lane >> 4);
#pragma unroll
        for (int ks = 0; ks < 4; ++ks)
#pragma unroll
            for (int n = 0; n < 5; ++n) { const bf16x8 b = *(const LAS bf16x8*)(bb + n * 16 * RB_ROW + 64 * ks); acc[n] = __builtin_amdgcn_mfma_f32_16x16x32_bf16(ac[ks], b, acc[n], 0, 0, 0); }
        if (cc < 7) { RT_STOREB((cc + 1) & 1);
#pragma unroll
            for (int ks = 0; ks < 4; ++ks) ac[ks] = an[ks]; }
        __syncthreads();
    }
#undef RT_LOADB
#undef RT_STOREB
#undef RT_LOADA
    PT_MARK(50, 1); PT_MARK(51, 0);
    if (kh == 1) {
#pragma unroll
        for (int n = 0; n < 5; ++n) *(LAS f32x4*)(part + ((q * 5 + n) * 64 + lane) * 4) = acc[n]; }
    __syncthreads();
    if (kh == 0) {
#pragma unroll
        for (int n = 0; n < 5; ++n) { const f32x4 p = *(LAS const f32x4*)(part + ((q * 5 + n) * 64 + lane) * 4); const f32x4 v = acc[n] + p;
#pragma unroll
            for (int r = 0; r < 4; ++r) logit[(q * 16 + 4 * (lane >> 4) + r) * 80 + n * 16 + (lane & 15)] = v[r]; } }
    __syncthreads();
    PT_MARK(51, 1); PT_MARK(52, 0);
    if (F.tid < 64) {
        const int tt = tg * 64 + F.tid; LAS const float* lg = logit + F.tid * 80;
        const float r = 1.0f / sqrtf(ss_row * (1.0f / DM) + RMS_EPS);
        float gl[8]; int grp = 0; float gmax = -3.0e38f;
#pragma unroll
        for (int j = 0; j < 8; ++j) { gl[j] = r * lg[j] + A.in[I_BRG][j]; if (gl[j] > gmax) { gmax = gl[j]; grp = j; } }
        float den = 0.f;
#pragma unroll
        for (int j = 0; j < 8; ++j) den += __expf(gl[j] - gmax);
        const float pg = 1.0f / den;
        float l1 = -3.0e38f, l2 = -3.0e38f; int i1 = 0, i2 = 0;
#pragma unroll
        for (int j = 0; j < 8; ++j) { const float v = r * lg[8 + grp * 8 + j] + A.in[I_BRE][grp * 8 + j];
            if (v > l1) { l2 = l1; i2 = i1; l1 = v; i1 = j; } else if (v > l2) { l2 = v; i2 = j; } }
        const float e1w = 1.0f / (1.0f + __expf(l2 - l1)); const float w1 = e1w * pg, w2 = (1.0f - e1w) * pg;
        const int e1 = grp * 8 + i1, e2 = grp * 8 + i2;
        const size_t dofs = dummy ? (size_t)(WS_END - WS_LTOK) / 4 : 0;
        const int p1 = (int)atomicAdd(F.ctl + CW_CNT + (dummy ? 2048 : 0) + 16 * e1, 1u), p2 = (int)atomicAdd(F.ctl + CW_CNT + (dummy ? 2048 : 0) + 16 * e2, 1u);
        F.LTOK()[dofs + e1 * CAP + p1] = tt; F.LR()[dofs + e1 * CAP + p1] = r; F.LW()[dofs + e1 * CAP + p1] = w1;
        F.LTOK()[dofs + e2 * CAP + p2] = tt; F.LR()[dofs + e2 * CAP + p2] = r; F.LW()[dofs + e2 * CAP + p2] = w2;
        ((i32x4*)((int*)F.TINFO() + dofs))[tt] = (i32x4){e1, p1, e2, p2};
    }
    PT_MARK(52, 1);
    __syncthreads();
}

template <int NPN, bool GU>
__device__ __forceinline__ int moe_setup(Frame& F) {
    LAS int* ud = (LAS int*)(F.lds + L_UD);
    if (F.wave == 0) { const int lane = lane_id();
        const int cnt = (int)__hip_atomic_load(F.ctl + CW_CNT + 16 * lane, __ATOMIC_RELAXED, __HIP_MEMORY_SCOPE_AGENT), nt = (cnt + 255) >> 8;
        int sc = cnt, st = nt;
#pragma unroll
        for (int o = 1; o < 64; o <<= 1) { const int a = __shfl_up(sc, o), b = __shfl_up(st, o); if (lane >= o) { sc += a; st += b; } }
        const int es_e = sc - cnt, ts_e = st - nt, ntiles = __shfl(st, 63);
#pragma unroll
        for (int i = 0; i < 8; ++i) { const long L = (long)i * F.G + F.vcu; const bool ok = L < (long)ntiles * NPN; const int rt = ok ? (int)(L / NPN) : 0, pn = (int)(L % NPN);
            const unsigned long long m = __ballot(ts_e <= rt && rt < ts_e + nt); const int e = m ? (int)__builtin_ctzll(m) : 0;
            const int tile = rt - __shfl(ts_e, e), ce = __shfl(cnt, e), rs = __shfl(es_e, e) + 256 * tile; int nv = ce - 256 * tile; nv = nv > 256 ? 256 : nv;
            if (lane == 0) { ud[i * 8 + 0] = e; ud[i * 8 + 1] = pn; ud[i * 8 + 2] = nv; ud[i * 8 + 3] = rs; ud[i * 8 + 4] = tile; ud[i * 8 + 5] = ok ? 1 : 0; } }
    }
    __syncthreads();
    int nunits = 0;
#pragma unroll
    for (int i = 0; i < 8; ++i) nunits += ud[i * 8 + 5];
    LAS unsigned* tab = (LAS unsigned*)(F.lds + L_TAB);
    for (int idx = F.tid; idx < nunits * 256; idx += NWAVES * 64) { const int i = idx >> 8, rr = idx & 255; const int e = ud[i * 8 + 0], nv = ud[i * 8 + 2], tile = ud[i * 8 + 4];
        const int pos = 256 * tile + (rr < nv ? rr : nv - 1);
        if (GU) { tab[idx] = (unsigned)F.LTOK()[e * CAP + pos] * (unsigned)DM;   ((LAS float*)tab)[1024 + idx] = F.LR()[e * CAP + pos]; }
        else ((LAS float*)tab)[idx] = rr < nv ? F.LW()[e * CAP + pos] : 0.f; }
    __syncthreads();
    return nunits;
}

__device__ __forceinline__ void final_row(Frame& F, const Args& A, int t, LAS const int* es, const int lane) {
    const i32x4 ti = F.TINFO()[t];
    const size_t s1 = (size_t)(es[ti.x] + ti.y), s2 = (size_t)(es[ti.z] + ti.w);
    const u32x2* hr = (const u32x2*)(F.H1B() + (size_t)t * DM) + lane; const u32x2* y1 = (const u32x2*)(F.Y() + s1 * DM) + lane; const u32x2* y2 = (const u32x2*)(F.Y() + s2 * DM) + lane;
    const f32x4* gr = (const f32x4*)A.in[I_NFIN] + lane;
    f32x4 v[8]; float s = 0.f;
#pragma unroll
    for (int j = 0; j < 8; ++j) { const u32x2 h = hr[64 * j]; const u32x2 a = y1[64 * j], b = y2[64 * j];
        v[j].x = bf_lo(h.x) + (bf_lo(a.x) + bf_lo(b.x)); v[j].y = bf_hi(h.x) + (bf_hi(a.x) + bf_hi(b.x)); v[j].z = bf_lo(h.y) + (bf_lo(a.y) + bf_lo(b.y)); v[j].w = bf_hi(h.y) + (bf_hi(a.y) + bf_hi(b.y));
        s += (v[j].x * v[j].x + v[j].y * v[j].y) + (v[j].z * v[j].z + v[j].w * v[j].w); }
    const float r = 1.0f / sqrtf(wave_sum(s) * (1.0f / DM) + RMS_EPS);
    f32x4* o = (f32x4*)(A.out + (size_t)t * DM) + lane;
#pragma unroll
    for (int j = 0; j < 8; ++j) { const f32x4 gg = gr[64 * j]; o[64 * j] = (f32x4){v[j].x * r * gg.x, v[j].y * r * gg.y, v[j].z * r * gg.z, v[j].w * r * gg.w}; }
}

__device__ __forceinline__ void p0_probe(Frame& F, const Args& A) {
#if PROBE_SUB > 0
    if (F.vcu < PROBE_SUB) { CvtJob job{A.in[I_WG], A.in[I_WU], A.in[I_WD], A.in[I_NFFN], F.WGU(), F.WD(), F.vcu * (CVT_ITEMS / PROBE_SUB), CVT_ITEMS / PROBE_SUB, 0, F.wave, F.lds + L_CVT + F.wave * 2048}; cvt_run(job, F.lane); }
#endif
}
__device__ __forceinline__ void p1_phase(Frame& F, const Args& A, int c) {
    if (c < 10) meta_proj_task(F, c * 8 + F.wave);
    if (c >= 10 && c < 42) {
        FoldOrder S{(const char*)F.WPT(), (const char*)F.PMS(), c - 10}; EpiFold E{F.WAB()};
        pg8::gemm_phase<EpiFold, FoldOrder, false>(F.lds + RING_OFF, 1024, 256, 256, S, E, nullptr);
    }
    CvtJob job{A.in[I_WG], A.in[I_WU], A.in[I_WD], A.in[I_NFFN], F.WGU(), F.WD(), 0, 0, 0, F.wave, F.lds + L_CVT + F.wave * 2048};
    if (c < 64) { job.first = c * 18; job.count = 18; job.slot = c % 7; } else { job.first = 1152 + (c - 64) * 26; job.count = 26; job.slot = (c - 64) % 6; }
#if PROBE_SUB > 0
    job.count = 0;
#endif
    PT_MARK(30, 0);
    { DenseOrder S{(const char*)F.HN(), (const char*)(F.WIN() + (size_t)UOFF * 2048), 64, 4, 256, F.G, c, 2048, 2048}; EpiProj E{F.PROJ(), job, F.lane, UOFF};
      pg8::gemm_phase<EpiProj, DenseOrder, false>(F.lds + RING_OFF, 2048, 2048, 2048, S, E, nullptr); }
    PT_MARK(30, 1); PT_MARK(31, 0);
    { DenseOrder S{(const char*)F.HN8(), (const char*)F.WIN8(), 64, 21, 1344, F.G, c, 1024, 1024}; EpiGate E{F.GATE(), F.PROJ(), job, F.lane, 1};
      pg8::gemm_phase<EpiGate, DenseOrder, false, false, true>(F.lds + RING_OFF, 1024, 1024, 1024, S, E, nullptr); PT_MARK(31, 1); }
}
__device__ __forceinline__ void p2_phase(Frame& F, const Args& A) { const int idx = F.vcu; if (idx < 256) attn_unit(F, A, idx >> 7, (idx >> 1) & 63, idx & 1); }
__device__ __forceinline__ void p3_phase(Frame& F, int c) {
    DenseOrder S{(const char*)F.AP(), (const char*)F.WAB(), 64, 8, 512, F.G, c, 2048, 2048}; EpiBranch E{F.GATE(), F.MERGED()};
    pg8::gemm_phase<EpiBranch, DenseOrder, false>(F.lds + RING_OFF, 2048, 2048, 2048, S, E, nullptr);
}
__device__ __forceinline__ void p4_phase(Frame& F, const Args& A, int c) {
    DenseOrder S{(const char*)F.MERGED(), (const char*)F.WO(), 64, 8, 512, F.G, c, 2048, 2048}; EpiOut E{A.in[I_X], F.H1B(), F.SSQ(), F.H8()};
    pg8::gemm_phase<EpiOut, DenseOrder, false>(F.lds + RING_OFF, 2048, 2048, 2048, S, E, nullptr);
}
__device__ __forceinline__ void p6_phase(Frame& F) {
    const int nu = moe_setup<4, true>(F);
    MoeOrder S{(LAS const int*)(F.lds + L_UD), nu, (const char*)F.H8(), (const char*)F.WGU(), 0, (size_t)1024 * 2048, (size_t)256 * 2048};
    EpiGU E{F.HID(), (LAS const float*)(F.lds + L_TAB) + 1024};
    pg8::gemm_phase<EpiGU, MoeOrder, true, false, true>(F.lds + RING_OFF, 1024, 1024, 1024, S, E, (LAS const unsigned*)(F.lds + L_TAB));
}
__device__ __forceinline__ void p7_phase(Frame& F) {
    const int nu = moe_setup<8, false>(F);
    MoeOrder S{(LAS const int*)(F.lds + L_UD), nu, (const char*)F.HID(), (const char*)F.WD(), (size_t)DEXP, (size_t)2048 * 512, (size_t)256 * 512};
    EpiDown E{F.Y(), (LAS const float*)(F.lds + L_TAB)};
    pg8::gemm_phase<EpiDown, MoeOrder, false, false, true>(F.lds + RING_OFF, 256, 256, 256, S, E, nullptr);
}
__device__ __forceinline__ void p8_phase(Frame& F, const Args& A) {
    LAS int* es = (LAS int*)(F.lds + L_ESTART);
    if (F.wave == 0) { const int ln = lane_id(); const int cnt = (int)__hip_atomic_load(F.ctl + CW_CNT + 16 * ln, __ATOMIC_RELAXED, __HIP_MEMORY_SCOPE_AGENT); int sc = cnt;
#pragma unroll
        for (int o = 1; o < 64; o <<= 1) { const int a = __shfl_up(sc, o); if (ln >= o) sc += a; }
        es[ln] = sc - cnt; }
    __syncthreads();
    const int lane = lane_id();
    for (int t = F.vcu * NWAVES + F.wave; t < M; t += F.G * NWAVES) final_row(F, A, t, es, lane);
}

__global__ void __launch_bounds__(NWAVES * 64, 2) mega_fwd(Args args) {
    extern __shared__ __attribute__((aligned(16))) unsigned char lds_raw[];
    Frame F;
    F.lds = (LAS unsigned char*)lds_raw;
    F.MISC = (volatile LAS unsigned*)(F.lds + L_MISC);
    F.tid = threadIdx.x; F.lane = F.tid & 63; F.wave = __builtin_amdgcn_readfirstlane(F.tid >> 6);
    F.G = gridDim.x; { const int bx = blockIdx.x; F.vcu = (F.G % 8 == 0) ? (bx % 8) * (F.G / 8) + bx / 8 : bx; }
    unsigned char* ws = args.ws;
    F.ctl = (unsigned*)(ws + WS_CTL);
    F.ws = ws;
    for (int u = F.tid; u < (LDS_BYTES - RING_BYTES) / 4; u += NWAVES * 64) ((LAS unsigned*)(F.lds + RING_BYTES))[u] = 0u;
    __syncthreads();
#if MK_LAUNCHES == 1
    XcdBarrier bar = xcd_barrier_post((unsigned*)(F.ctl + CW_BAR), F.MISC + 8);
#define GRID_BAR() xcd_barrier(bar)
#else
#define GRID_BAR() do { } while (0)
#endif
    const int lo = args.ph_lo, hi = args.ph_hi;
#define IN(k) (lo <= (k) && (k) < hi)
#define BOTH(k) (IN(k) && IN((k) + 1))
#define DUP(k) (PROBE_DUP == (k))
    const int c = (int)blockIdx.x;

    PT_MARK(0, 0);
    if (IN(0)) { p0_prologue(F, args); p0_probe(F, args); if (DUP(0)) { GRID_BAR(); p0_prologue(F, args); } if (BOTH(0)) GRID_BAR(); }
    PT_MARK(0, 1);
    PT_MARK(1, 0);
    if (IN(1)) { p1_phase(F, args, c); if (DUP(1)) { GRID_BAR(); p1_phase(F, args, c); } if (BOTH(1)) GRID_BAR(); }
    PT_MARK(1, 1);
    PT_MARK(2, 0);
    if (IN(2)) { p2_phase(F, args); if (DUP(2)) { GRID_BAR(); p2_phase(F, args); } if (BOTH(2)) GRID_BAR(); }
    PT_MARK(2, 1);
    PT_MARK(3, 0);
    if (IN(3)) { p3_phase(F, c); if (DUP(3)) { GRID_BAR(); p3_phase(F, c); } if (BOTH(3)) GRID_BAR(); }
    PT_MARK(3, 1);
    PT_MARK(4, 0);
    if (IN(4)) { p4_phase(F, args, c); if (DUP(4)) { GRID_BAR(); p4_phase(F, args, c); } if (BOTH(4)) GRID_BAR(); }
    PT_MARK(4, 1);
    PT_MARK(5, 0);
    if (IN(5)) { if (F.vcu < M / 64) router_group(F, args, F.vcu); if (DUP(5)) { GRID_BAR(); if (F.vcu < M / 64) router_group(F, args, F.vcu, 1); } if (BOTH(5)) GRID_BAR(); }
    PT_MARK(5, 1);
    PT_MARK(6, 0);
    if (IN(6)) { p6_phase(F); if (DUP(6)) { GRID_BAR(); p6_phase(F); } if (BOTH(6)) GRID_BAR(); }
    PT_MARK(6, 1);
    PT_MARK(7, 0);
    if (IN(7)) { p7_phase(F); if (DUP(7)) { GRID_BAR(); p7_phase(F); } if (BOTH(7)) GRID_BAR(); }
    PT_MARK(7, 1);
    PT_MARK(8, 0);
    if (IN(8)) { p8_phase(F, args); if (DUP(8)) { GRID_BAR(); p8_phase(F, args); } }
    PT_MARK(8, 1);
#if PROBE_TIME >= 0
    if (blockIdx.x == 0 && F.tid == 0) { const unsigned long long pt0 = ((unsigned long long)F.MISC[33] << 32) | F.MISC[32], pt1 = ((unsigned long long)F.MISC[35] << 32) | F.MISC[34];
        const unsigned long long te = __builtin_amdgcn_s_memrealtime(), d = 4ull * (pt1 - pt0); while (__builtin_amdgcn_s_memrealtime() - te < d) __builtin_amdgcn_s_sleep(8); }
#endif
#undef IN
#undef BOTH
#undef DUP
}

extern "C" void kernel_launch(void* const* d_in, const int* in_sizes, int n_in, void* d_out, int out_size, void* d_ws, size_t ws_size, hipStream_t stream) {
    static int grid = 0;
    if (grid == 0) {
        if (n_in != 20 || out_size != M * DM || ws_size < WS_END + (PROBE_DUP == 5 ? 16 * MiB : 0)) { fprintf(stderr, "kernel_launch: unexpected shapes (n_in %d, out %d, ws %zu); nothing launched\n", n_in, out_size, ws_size); grid = -1; return; }
        int dev = 0, cus = 0, per_cu = 0;
        if (hipGetDevice(&dev) != hipSuccess || hipDeviceGetAttribute(&cus, hipDeviceAttributeMultiprocessorCount, dev) != hipSuccess) { grid = -1; return; }
        if (hipFuncSetAttribute((const void*)mega_fwd, hipFuncAttributeMaxDynamicSharedMemorySize, LDS_BYTES) != hipSuccess) { fprintf(stderr, "kernel_launch: hipFuncSetAttribute failed\n"); grid = -1; return; }
        if (hipOccupancyMaxActiveBlocksPerMultiprocessor(&per_cu, (const void*)mega_fwd, NWAVES * 64, LDS_BYTES) != hipSuccess || per_cu < 1) { fprintf(stderr, "kernel_launch: occupancy query says %d\n", per_cu); }
        (void)hipGetLastError();
        grid = cus;
        if (grid != 256) { fprintf(stderr, "kernel_launch: built for 256 CUs, device has %d; nothing launched\n", grid); grid = -1; return; }
    }
    if (grid < 0) return;
    (void)hipMemsetAsync((char*)d_ws + WS_CTL, 0, CTL_ZERO_BYTES, stream);
    Args a{};
    for (int i = 0; i < 20; ++i) a.in[i] = (const float*)d_in[i];
    a.out = (float*)d_out; a.ws = (unsigned char*)d_ws;
#if MK_LAUNCHES == 1
    a.ph_lo = 0; a.ph_hi = NPHASE;
    hipLaunchKernelGGL(mega_fwd, dim3(grid), dim3(NWAVES * 64), LDS_BYTES, stream, a);
#else
    for (int p = 0; p < NPHASE; ++p) { a.ph_lo = p; a.ph_hi = p + 1; hipLaunchKernelGGL(mega_fwd, dim3(grid), dim3(NWAVES * 64), LDS_BYTES, stream, a); }
#endif
}
```

```cpp
#include <hip/hip_runtime.h>
#include <cstdio>
#include <cstdint>

#define GAS __attribute__((address_space(1)))
#define LAS __attribute__((address_space(3)))
typedef unsigned short bf16;
typedef short bf16x8 __attribute__((ext_vector_type(8)));
typedef float f32x2 __attribute__((ext_vector_type(2)));
typedef float f32x4 __attribute__((ext_vector_type(4)));
typedef float f32x16 __attribute__((ext_vector_type(16)));
typedef unsigned u32x2 __attribute__((ext_vector_type(2)));
typedef unsigned u32x4 __attribute__((ext_vector_type(4)));
typedef int i32x4 __attribute__((ext_vector_type(4)));

#ifndef MK_LAUNCHES
#define MK_LAUNCHES 1
#endif
#ifndef PROBE_DUP
#define PROBE_DUP -1
#endif
#ifndef PROBE_SUB
#define PROBE_SUB 0
#endif
#ifndef PROBE_TIME
#define PROBE_TIME -1
#endif
constexpr int NPHASE = 9;

constexpr int DM = 2048, SEQ = 8192, M = 16384;
constexpr int NMETA = 16, MROWS = M + 256;
constexpr int INW = 6400, KOFF = 1024, VOFF = 1152, UOFF = 1280, GAOFF = 2304, GPOFF = 4352;
constexpr int PW = 2304, GW = 4096;
constexpr int NEXP = 64, DEXP = 512, CAP = 16384;
constexpr float RMS_EPS = 1e-6f;

constexpr size_t MiB = 1u << 20;
constexpr size_t WS_CTL = 0, CTL_ZERO_BYTES = 1 * MiB;
constexpr size_t WS_WIN = 1 * MiB;
constexpr size_t WS_WAB = 26 * MiB;
constexpr size_t WS_WPT = 34 * MiB;
constexpr size_t WS_WO = 38 * MiB;
constexpr size_t WS_PMS = 46 * MiB;
constexpr size_t WS_WR = 46 * MiB + 512 * 1024;
constexpr size_t WS_SSQ = 47 * MiB;
constexpr size_t WS_LTOK = 49 * MiB, WS_LR = 53 * MiB, WS_LW = 57 * MiB;
constexpr size_t WS_TINFO = 61 * MiB;
constexpr size_t WS_WGU = 64 * MiB;
constexpr size_t WS_WIN8 = 13 * MiB;
constexpr size_t WS_HN8 = 416 * MiB;
constexpr size_t WS_H8 = 384 * MiB;
constexpr size_t WS_WD = 320 * MiB;
constexpr size_t WS_HN = 448 * MiB;
constexpr size_t WS_PROJ = 513 * MiB;
constexpr size_t WS_GATE = 593 * MiB;
constexpr size_t WS_AP = 717 * MiB;
constexpr size_t WS_H1 = 781 * MiB;
constexpr size_t WS_END = 909 * MiB;
constexpr int CW_TMO = 0, CW_CNT = 1024  , CW_BAR = 4096;

constexpr int RING_BYTES = 131072, RING_OFF = 512;
constexpr int L_MISC = RING_OFF + RING_BYTES;
constexpr int L_ESTART = L_MISC + 256;
constexpr int L_TSTART = L_ESTART + 320;
constexpr int L_UD = L_TSTART + 320;
constexpr int L_TAB = L_UD + 256;
constexpr int L_CVT = L_TAB + 8192;
constexpr int LDS_BYTES = 157696;
static_assert(L_CVT + 16384 <= LDS_BYTES && LDS_BYTES <= 163840, "LDS map");

#define LDS_WAIT() asm volatile("s_waitcnt lgkmcnt(0)" ::: "memory")
#define VM_WAIT() asm volatile("s_waitcnt vmcnt(0)" ::: "memory")
__device__ __forceinline__ unsigned cvt_pk_bf16(float lo, float hi) { unsigned r; asm volatile("v_cvt_pk_bf16_f32 %0, %1, %2" : "=v"(r) : "v"(lo), "v"(hi)); return r; }
__device__ __forceinline__ float bf_lo(unsigned w) { return __uint_as_float(w << 16); }
__device__ __forceinline__ float bf_hi(unsigned w) { return __uint_as_float(w & 0xffff0000u); }
__device__ __forceinline__ float sigmoidf_(float x) { return __builtin_amdgcn_rcpf(1.0f + __expf(-x)); }

namespace pg8 {
constexpr int BM = 256, BK = 64, HALF = 128, HTB = HALF * BK * 2, STAGE_BYTES = 8 * HTB, NXCD = 8, WGM = 8;
__host__ __device__ __forceinline__ int lds_byte(int r, int c) { const int st = (r >> 4) * 2 + (c >> 5), rr = r & 15, cc = c & 31, ob = rr * 64 + cc * 2; return st * 1024 + (ob ^ (((ob >> 9) & 1) << 5)); }
__host__ __device__ __forceinline__ void stage_rc(int b, int& R, int& C) { const int st = b / 1024, sb = b % 1024, swz = sb ^ (((sb >> 9) & 1) << 5); R = (st >> 1) * 16 + swz / 64; C = (st & 1) * 32 + (swz % 64) / 2; }
__host__ __device__ __forceinline__ int perm32(int rho) { const int n = rho >> 4, i = rho & 15; return 8 * (i >> 2) + 4 * n + (i & 3); }

struct Unit { const char* a; const char* b; int pm, pn, x0, x1; };

__device__ __forceinline__ void tile_of(int L, int nM, int nN, int& pm, int& pn) {
    const int nwg = nM * nN; int wgid = L;
    { const int q = nwg / NXCD, r = nwg % NXCD, xcd = wgid % NXCD, off = wgid / NXCD; wgid = (xcd < r ? xcd * (q + 1) : r * (q + 1) + (xcd - r) * q) + off; }
    const int nig = WGM * nN, gid = wgid / nig, fm = gid * WGM, gsz = (nM - fm) < WGM ? (nM - fm) : WGM;
    pm = fm + ((wgid % nig) % gsz); pn = (wgid % nig) / gsz;
}

typedef int i32x8 __attribute__((ext_vector_type(8)));
template <class Epi, class Sched, bool GATHER, bool HALFSKIP = false, bool FP8 = false>
__device__ __forceinline__ void gemm_phase(LAS unsigned char* lds, const int lda, const int ldb, const int K, const Sched& S, const Epi& E, LAS const unsigned* rowtab  ) {
    const int tid = threadIdx.x, wid = __builtin_amdgcn_readfirstlane(tid >> 6), lane = tid & 63, wr = wid >> 2, wc = wid & 3, fr = lane & 15, fq = lane >> 4;
    const int nt = K / BK;
    unsigned voffB[2], voffBh[2], cv0[2], cv1[2], nv0[2], nv1[2]; int Rr[2]; unsigned Cc[2];
#pragma unroll
    for (int i = 0; i < 2; ++i) { int R, C; stage_rc(tid * 16 + i * 8192, R, C); const int Rb = (R & ~31) + perm32(R & 31);
        voffB[i] = (unsigned)(Rb * ldb + C) * 2u; voffBh[i] = voffB[i] + (unsigned)(HALF * ldb) * 2u; Rr[i] = R; Cc[i] = (unsigned)C * 2u;
        cv0[i] = (unsigned)(R * lda + C) * 2u; cv1[i] = cv0[i] + (unsigned)(HALF * lda) * 2u; nv0[i] = cv0[i]; nv1[i] = cv1[i]; }
    const size_t kstep = (size_t)(BK * 2);
    const unsigned ldsw = (unsigned)wid * 1024u;
    const int aoff = lds_byte(wr * 64 + fr, fq * 8), boff = lds_byte(wc * 32 + fr, fq * 8);
#define PG8_SA(b, h) (((b) * 2 + (h)) * HTB)
#define PG8_SB(b, h) ((4 + (b) * 2 + (h)) * HTB)
#define PG8_STAGE2O(bufoff, gbase, v0, v1, OFF) do { \
        __builtin_amdgcn_global_load_lds((const unsigned*)((const char*)(gbase) + (v0)), (LAS unsigned*)(lds + ((bufoff) - (OFF)) + ldsw), 16, OFF, 0); \
        __builtin_amdgcn_global_load_lds((const unsigned*)((const char*)(gbase) + (v1)), (LAS unsigned*)(lds + ((bufoff) - (OFF)) + ldsw + 8192), 16, OFF, 0); } while (0)
#define PG8_STAGE2(bufoff, gbase, v0, v1) PG8_STAGE2O(bufoff, gbase, v0, v1, 0)
#define PG8_STAGEB(bufoff, gbase) PG8_STAGE2(bufoff, gbase, voffB[0], voffB[1])
#define PG8_STAGEBO(bufoff, gbase, OFF) PG8_STAGE2O(bufoff, gbase, voffB[0], voffB[1], OFF)
#define PG8_STAGEBH(bufoff, gbase, OFF) PG8_STAGE2O(bufoff, gbase, voffBh[0], voffBh[1], OFF)
#define PG8_LDA(dst, b, h) do { if constexpr (FP8) { _Pragma("unroll") for (int m = 0; m < 4; ++m) dst##8[m] = *(const LAS i32x8*)(lds + PG8_SA(b, h) + aoff8 + m * 2048); } \
        else { _Pragma("unroll") for (int m = 0; m < 4; ++m) _Pragma("unroll") for (int k = 0; k < 2; ++k) dst[m][k] = *(const LAS bf16x8*)(lds + PG8_SA(b, h) + aoff + m * 2048 + k * 1024); } } while (0)
#define PG8_LDB(dst, b, h) do { if constexpr (FP8) { _Pragma("unroll") for (int n = 0; n < 2; ++n) dst##8[n] = *(const LAS i32x8*)(lds + PG8_SB(b, h) + boff8 + n * 2048); } \
        else { _Pragma("unroll") for (int n = 0; n < 2; ++n) _Pragma("unroll") for (int k = 0; k < 2; ++k) dst[n][k] = *(const LAS bf16x8*)(lds + PG8_SB(b, h) + boff + n * 2048 + k * 1024); } } while (0)
#define PG8_MMA(ai, bj, At, Bt) do { __builtin_amdgcn_s_setprio(1); \
        if constexpr (FP8) { _Pragma("unroll") for (int m = 0; m < 4; ++m) _Pragma("unroll") for (int n = 0; n < 2; ++n) \
            asm volatile("v_mfma_scale_f32_16x16x128_f8f6f4 %0, %1, %2, %0, %3, %3 op_sel_hi:[0,0,0]" : "+v"(acc[ai][bj][m][n]) : "v"(Bt##8[n]), "v"(At##8[m]), "v"(mxscale)); } \
        else { _Pragma("unroll") for (int m = 0; m < 4; ++m) _Pragma("unroll") for (int n = 0; n < 2; ++n) _Pragma("unroll") for (int k = 0; k < 2; ++k) \
            acc[ai][bj][m][n] = __builtin_amdgcn_mfma_f32_16x16x32_bf16(Bt[n][k], At[m][k], acc[ai][bj][m][n], 0, 0, 0); } __builtin_amdgcn_s_setprio(0); } while (0)
#define PG8_WAIT_V(n) asm volatile("s_waitcnt vmcnt(" #n ")" ::: "memory")
#define PG8_WAIT_L(n) asm volatile("s_waitcnt lgkmcnt(" #n ")" ::: "memory")
#define PG8_BAR __builtin_amdgcn_s_barrier()
#define PG8_SCHED __builtin_amdgcn_sched_barrier(0)
    Unit cur, nxt; int ui = 0;
    if (!S.next(0, cur)) return;
    if constexpr (GATHER) {
#pragma unroll
        for (int i = 0; i < 2; ++i) { cv0[i] = rowtab[Rr[i]] + Cc[i]; cv1[i] = rowtab[HALF + Rr[i]] + Cc[i]; }
    }
    f32x4 acc[2][2][4][2];
#pragma unroll
    for (int a = 0; a < 2; ++a)
#pragma unroll
        for (int b = 0; b < 2; ++b)
#pragma unroll
            for (int m = 0; m < 4; ++m)
#pragma unroll
                for (int n = 0; n < 2; ++n) acc[a][b][m][n] = (f32x4){0.f, 0.f, 0.f, 0.f};
    bf16x8 At[4][2], B0[2][2], B1[2][2];
    i32x8 At8[4], B08[2], B18[2];
    const int mxscale = 0x7f7f7f7f;
    const int aoff8 = ((fq >> 1) * 1024) + (((wr * 64 + fr) & 15) * 64 + (fq & 1) * 32 ^ (((((wr * 64 + fr) & 15) * 64) >> 9) & 1) << 5) + (((wr * 64 + fr) >> 4) * 2048);
    const int boff8 = ((fq >> 1) * 1024) + (((wc * 32 + fr) & 15) * 64 + (fq & 1) * 32 ^ (((((wc * 32 + fr) & 15) * 64) >> 9) & 1) << 5) + (((wc * 32 + fr) >> 4) * 2048);
    const char* cA = cur.a; const char* cB = cur.b;
    PG8_STAGEBO(PG8_SB(0, 0), cB, 0); PG8_STAGEBH(PG8_SB(0, 1), cB, 0); PG8_STAGE2(PG8_SA(0, 0), cA, cv0[0], cv0[1]); PG8_STAGE2(PG8_SA(0, 1), cA, cv1[0], cv1[1]);
    if (wr == 1) PG8_BAR;
    PG8_WAIT_V(2); PG8_BAR;
    PG8_STAGEBO(PG8_SB(1, 0), cB, 128); PG8_STAGE2O(PG8_SA(1, 0), cA, cv0[0], cv0[1], 128); PG8_STAGEBH(PG8_SB(1, 1), cB, 128);
    PG8_WAIT_V(6); PG8_BAR;
    for (;;) {
        const bool has_next = S.next(ui + 1, nxt);
        const bool skip_hi = HALFSKIP && cur.x0 <= 128;
        const char* nA = has_next ? nxt.a : cA; const char* nB = has_next ? nxt.b : cB;
        if constexpr (GATHER) {
            if (has_next) {
#pragma unroll
                for (int i = 0; i < 2; ++i) { nv0[i] = rowtab[(ui + 1) * 256 + Rr[i]] + Cc[i]; nv1[i] = rowtab[(ui + 1) * 256 + HALF + Rr[i]] + Cc[i]; }
            } else {
#pragma unroll
                for (int i = 0; i < 2; ++i) { nv0[i] = cv0[i]; nv1[i] = cv1[i]; }
            }
        }
#pragma unroll 1
        for (int t = 0; t < nt; t += 2) {
            const bool last = (t == nt - 2);
            if constexpr (Epi::HAS_MID) { if (t == Epi::MID_T) E.mid(acc, cur, wr, wc, fr, fq); }
            const char* pA = cA + (size_t)t * kstep; const char* pB = cB + (size_t)t * kstep;
            const char* qA = last ? nA - 256 : pA; const char* qB = last ? nB - 256 : pB;
            unsigned x00, x01, x10, x11;
            if constexpr (GATHER) { x00 = last ? nv0[0] : cv0[0]; x01 = last ? nv0[1] : cv0[1]; x10 = last ? nv1[0] : cv1[0]; x11 = last ? nv1[1] : cv1[1]; }
            else { x00 = cv0[0]; x01 = cv0[1]; x10 = cv1[0]; x11 = cv1[1]; }
            PG8_LDB(B0, 0, 0); PG8_LDB(B1, 0, 1); PG8_SCHED; PG8_LDA(At, 0, 0); PG8_STAGE2O(PG8_SA(1, 1), pA, cv1[0], cv1[1], 128);
            PG8_WAIT_V(8); PG8_WAIT_L(0); PG8_BAR; PG8_MMA(0, 0, At, B0); PG8_MMA(0, 1, At, B1); PG8_BAR; PG8_SCHED;
            PG8_LDA(At, 0, 1); PG8_STAGEBO(PG8_SB(0, 0), qB, 256); PG8_STAGEBH(PG8_SB(0, 1), qB, 256); PG8_STAGE2O(PG8_SA(0, 0), qA, x00, x01, 256);
            PG8_WAIT_V(8); PG8_WAIT_L(0); PG8_BAR; if (!skip_hi) { PG8_MMA(1, 0, At, B0); PG8_MMA(1, 1, At, B1); } PG8_BAR; PG8_SCHED;
            PG8_LDB(B0, 1, 0); PG8_LDB(B1, 1, 1); PG8_SCHED; PG8_LDA(At, 1, 0); PG8_STAGE2O(PG8_SA(0, 1), qA, x10, x11, 256);
            PG8_WAIT_V(8); PG8_WAIT_L(0); PG8_BAR; PG8_MMA(0, 0, At, B0); PG8_MMA(0, 1, At, B1); PG8_BAR; PG8_SCHED;
            PG8_LDA(At, 1, 1); PG8_STAGEBO(PG8_SB(1, 0), qB, 384); PG8_STAGEBH(PG8_SB(1, 1), qB, 384); PG8_STAGE2O(PG8_SA(1, 0), qA, x00, x01, 384);
            PG8_WAIT_V(8); PG8_WAIT_L(0); PG8_BAR; if (!skip_hi) { PG8_MMA(1, 0, At, B0); PG8_MMA(1, 1, At, B1); } PG8_BAR; PG8_SCHED;
        }
        if (wr == 0) PG8_BAR;
        if constexpr (FP8) asm volatile("s_nop 15\n\ts_nop 15" ::: "memory");
        E(acc, cur, ui, wr, wc, fr, fq);
        if constexpr (Epi::HAS_POST) E.post(ui);
        if (!has_next) break;
#pragma unroll
        for (int a = 0; a < 2; ++a)
#pragma unroll
            for (int b = 0; b < 2; ++b)
#pragma unroll
                for (int m = 0; m < 4; ++m)
#pragma unroll
                    for (int n = 0; n < 2; ++n) acc[a][b][m][n] = (f32x4){0.f, 0.f, 0.f, 0.f};
        cur = nxt; cA = nA; cB = nB; ++ui;
        if constexpr (GATHER) {
#pragma unroll
            for (int i = 0; i < 2; ++i) { cv0[i] = nv0[i]; cv1[i] = nv1[i]; }
        }
        if (wr == 1) PG8_BAR;
    }
    PG8_WAIT_V(0);
    PG8_BAR;
#undef PG8_SA
#undef PG8_SB
#undef PG8_STAGE2
#undef PG8_STAGE2O
#undef PG8_STAGEB
#undef PG8_STAGEBO
#undef PG8_STAGEBH
#undef PG8_LDA
#undef PG8_LDB
#undef PG8_MMA
#undef PG8_WAIT_V
#undef PG8_WAIT_L
#undef PG8_BAR
#undef PG8_SCHED
}
}

#define XB_TMO      128
#define XB_XCNT(j)  (256  + 64 * (j))
#define XB_XSUB(j)  (1280 + 64 * (j))
#define XB_XGEN(j)  (2304 + 64 * (j))
#define XB_TOP      3328
#define XB_TOPGEN   3392
#define XCD_BAR_WORDS 3456
#define XB_SPIN_CAP (1u << 18)

__device__ __forceinline__ unsigned xb_ld(unsigned* p)              { return __hip_atomic_load(p, __ATOMIC_RELAXED, __HIP_MEMORY_SCOPE_AGENT); }
__device__ __forceinline__ unsigned xb_add(unsigned* p, unsigned v) { return __hip_atomic_fetch_add(p, v, __ATOMIC_RELAXED, __HIP_MEMORY_SCOPE_AGENT); }
__device__ __forceinline__ unsigned xb_xcc_id() { return (unsigned)__builtin_amdgcn_s_getreg((3 << 11) | 20) & 0xFu; }
#define XB_SPIN(cond, bar) do { unsigned _sp = 0; while (cond) { __builtin_amdgcn_s_sleep(1); \
    if ((++_sp & 255u) == 0u) { if (xb_ld(&(bar)[XB_TMO])) break; if (_sp > XB_SPIN_CAP) { atomicAdd(&(bar)[XB_TMO], 1u); break; } } } } while (0)

struct XcdBarrier {
    unsigned* bar; unsigned x;
    volatile LAS unsigned* st;
};

__device__ __forceinline__ XcdBarrier xcd_barrier_post(unsigned* bar, volatile LAS unsigned* st) {
    XcdBarrier b; b.bar = bar; b.x = xb_xcc_id(); b.st = st;
    if (threadIdx.x == 0) (void)xb_add(&bar[XB_XCNT(b.x)], 1u);
    return b;
}
__device__ __forceinline__ void xcd_barrier_complete(unsigned* bar, unsigned x, unsigned& nloc, unsigned& nx) {
    const unsigned G = gridDim.x * gridDim.y * gridDim.z;
    unsigned sum, cnt, mine, sp = 0u;
    for (;;) {
        sum = 0u; cnt = 0u; mine = 0u;
#pragma unroll
        for (unsigned j = 0; j < 16; ++j) { const unsigned c = xb_ld(&bar[XB_XCNT(j)]); sum += c; cnt += (c > 0u) ? 1u : 0u; mine = (j == x) ? c : mine; }
        if (sum == G) break;
        __builtin_amdgcn_s_sleep(1);
        if ((++sp & 255u) == 0u) { if (xb_ld(&bar[XB_TMO])) break; if (sp > XB_SPIN_CAP) { atomicAdd(&bar[XB_TMO], 1u); break; } }
    }
    nloc = mine > 0u ? mine : 1u; nx = cnt > 0u ? cnt : 1u;
}

__device__ __forceinline__ void xcd_barrier(const XcdBarrier& b) {
    asm volatile("s_waitcnt vmcnt(0)" ::: "memory");
    __syncthreads();
    if (threadIdx.x == 0) {
        unsigned* bar = b.bar;
        __builtin_amdgcn_s_waitcnt(0);
        unsigned nloc = b.st[0], nx = b.st[1];
        if (nloc == 0u) { xcd_barrier_complete(bar, b.x, nloc, nx); b.st[0] = nloc; b.st[1] = nx; }
        const unsigned old = xb_add(&bar[XB_XSUB(b.x)], 1u);
        const unsigned gen = old / nloc;
        if (old + 1u == (gen + 1u) * nloc) {
            __builtin_amdgcn_fence(__ATOMIC_RELEASE, "agent");
            asm volatile("s_waitcnt vmcnt(0)" ::: "memory");
            const unsigned og = xb_add(&bar[XB_TOP], 1u);
            const unsigned tg = og / nx;
            if (og + 1u == (tg + 1u) * nx) xb_add(&bar[XB_TOPGEN], 1u);
            else XB_SPIN(xb_ld(&bar[XB_TOPGEN]) == tg, bar);
            __builtin_amdgcn_fence(__ATOMIC_ACQUIRE, "agent");
            xb_add(&bar[XB_XGEN(b.x)], 1u);
            asm volatile("s_waitcnt vmcnt(0)" ::: "memory");
        } else {
            XB_SPIN(xb_ld(&bar[XB_XGEN(b.x)]) == gen, bar);
            __builtin_amdgcn_fence(__ATOMIC_ACQUIRE, "agent");
            asm volatile("s_waitcnt vmcnt(0)" ::: "memory");
        }
    }
    __syncthreads();
}

constexpr int NWAVES = 8;
#if PROBE_TIME >= 0
#define PT_MARK(k, e) do { if ((k) == PROBE_TIME && blockIdx.x == 0 && threadIdx.x == 0) { const unsigned long long t_ = __builtin_amdgcn_s_memrealtime(); volatile LAS unsigned* m_ = (volatile LAS unsigned*)(unsigned)L_MISC;        m_[32 + 2 * (e)] = (unsigned)t_; m_[33 + 2 * (e)] = (unsigned)(t_ >> 32); } } while (0)
#else
#define PT_MARK(k, e) do { } while (0)
#endif
struct Args { const float* in[20]; float* out; unsigned char* ws; int ph_lo, ph_hi; };
enum { I_X = 0, I_META, I_RELB, I_NMIX, I_WIN, I_SINK, I_PMIX, I_PSCL, I_WAB, I_WPB, I_WOUT, I_NFFN, I_WRG, I_BRG, I_WRE, I_BRE, I_WG, I_WU, I_WD, I_NFIN };
struct Frame {
    LAS unsigned char* lds;
    volatile LAS unsigned* MISC;
    unsigned* ctl;
    int tid, lane, wave, vcu, G;
    unsigned char* ws;
#define WSP(name, T, off) __device__ __forceinline__ T* name() const { return (T*)(ws + (off)); }
    WSP(WIN, bf16, WS_WIN) WSP(WAB, bf16, WS_WAB) WSP(WPT, bf16, WS_WPT) WSP(WO, bf16, WS_WO) WSP(PMS, bf16, WS_PMS) WSP(WR, bf16, WS_WR) WSP(WGU, bf16, WS_WGU) WSP(WD, bf16, WS_WD)
    WSP(HN, bf16, WS_HN) WSP(PROJ, bf16, WS_PROJ) WSP(AP, bf16, WS_AP) WSP(MERGED, bf16, WS_HN) WSP(H1B, bf16, WS_AP) WSP(HID, bf16, WS_HN) WSP(Y, bf16, WS_PROJ)
    WSP(SSQ, float, WS_SSQ) WSP(H1, float, WS_H1) WSP(LR, float, WS_LR) WSP(LW, float, WS_LW) WSP(LTOK, int, WS_LTOK) WSP(TINFO, i32x4, WS_TINFO) WSP(GATE, unsigned char, WS_GATE) WSP(H8, unsigned char, WS_H8) WSP(HN8, unsigned char, WS_HN8) WSP(WIN8, unsigned char, WS_WIN8)
#undef WSP
};

__device__ __forceinline__ int lane_id() { return (int)__builtin_amdgcn_mbcnt_hi(~0u, __builtin_amdgcn_mbcnt_lo(~0u, 0u)); }
__device__ __forceinline__ float wave_sum(float v) {
#pragma unroll
    for (int o = 1; o < 64; o <<= 1) v += __shfl_xor(v, o);
    return v;
}

template <bool SCALE>
__device__ __forceinline__ void p0_item(const float* W, int N, int k0, int n0, bf16* WT, int ldt, int wrow0, const float* ks, LAS float* scr, int lane) {
#pragma unroll 8
    for (int i = 0; i < 32; ++i) { const int kk = 2 * i + (lane >> 5); float v = W[(size_t)(k0 + kk) * N + n0 + (lane & 31)]; if constexpr (SCALE) v *= ks[k0 + kk]; scr[kk * 33 + (lane & 31)] = v; }
    LDS_WAIT(); asm volatile("" ::: "memory");
    const int c = lane & 7;
#pragma unroll
    for (int j = 0; j < 4; ++j) { const int n = (lane >> 3) + 8 * j; const LAS float* s = scr + (8 * c) * 33 + n;
        u32x4 o; o.x = cvt_pk_bf16(s[0 * 33], s[1 * 33]); o.y = cvt_pk_bf16(s[2 * 33], s[3 * 33]); o.z = cvt_pk_bf16(s[4 * 33], s[5 * 33]); o.w = cvt_pk_bf16(s[6 * 33], s[7 * 33]);
        *(u32x4*)(WT + (size_t)(wrow0 + n) * ldt + k0 + 8 * c) = o; }
    LDS_WAIT(); asm volatile("" ::: "memory");
}
__device__ __forceinline__ void p0_item8(const float* W, int N, int k0, int n0, unsigned char* WT, int ldt, int wrow0, float scl, LAS float* scr, int lane) {
#pragma unroll 8
    for (int i = 0; i < 32; ++i) { const int kk = 2 * i + (lane >> 5); scr[kk * 33 + (lane & 31)] = W[(size_t)(k0 + kk) * N + n0 + (lane & 31)] * scl; }
    LDS_WAIT(); asm volatile("" ::: "memory");
    const int c = lane & 7;
#pragma unroll
    for (int j = 0; j < 4; ++j) { const int n = (lane >> 3) + 8 * j; const LAS float* s = scr + (8 * c) * 33 + n;
        int p0 = __builtin_amdgcn_cvt_pk_fp8_f32(s[0 * 33], s[1 * 33], 0, false); p0 = __builtin_amdgcn_cvt_pk_fp8_f32(s[2 * 33], s[3 * 33], p0, true);
        int p1 = __builtin_amdgcn_cvt_pk_fp8_f32(s[4 * 33], s[5 * 33], 0, false); p1 = __builtin_amdgcn_cvt_pk_fp8_f32(s[6 * 33], s[7 * 33], p1, true);
        *(u32x2*)(WT + (size_t)(wrow0 + n) * ldt + k0 + 8 * c) = (u32x2){(unsigned)p0, (unsigned)p1}; }
    LDS_WAIT(); asm volatile("" ::: "memory");
}
template <int NR>
__device__ __forceinline__ void rms_rows_to_bf16(const float* const (&xrow)[NR], const float* g, bf16* const (&orow)[NR], unsigned char* const (&o8row)[NR], int lane) {
    const f32x4* gr = (const f32x4*)g + lane;
    f32x4 v[NR][8]; float r[NR];
#pragma unroll
    for (int q = 0; q < NR; ++q) { const f32x4* xr = (const f32x4*)xrow[q] + lane;
#pragma unroll
        for (int j = 0; j < 8; ++j) v[q][j] = xr[64 * j]; }
#pragma unroll
    for (int q = 0; q < NR; ++q) { float s = 0.f;
#pragma unroll
        for (int j = 0; j < 8; ++j) s += (v[q][j].x * v[q][j].x + v[q][j].y * v[q][j].y) + (v[q][j].z * v[q][j].z + v[q][j].w * v[q][j].w);
        r[q] = 1.0f / sqrtf(wave_sum(s) * (1.0f / DM) + RMS_EPS); }
#pragma unroll
    for (int j = 0; j < 8; ++j) { const f32x4 gg = gr[64 * j];
#pragma unroll
        for (int q = 0; q < NR; ++q) { const float y0 = v[q][j].x * r[q] * gg.x, y1 = v[q][j].y * r[q] * gg.y, y2 = v[q][j].z * r[q] * gg.z, y3 = v[q][j].w * r[q] * gg.w;
            u32x2 w; w.x = cvt_pk_bf16(y0, y1); w.y = cvt_pk_bf16(y2, y3); ((u32x2*)orow[q] + lane)[64 * j] = w;
            if (o8row[q]) { const float z0 = __builtin_fminf(__builtin_fmaxf(y0 * 8.0f, -448.0f), 448.0f), z1 = __builtin_fminf(__builtin_fmaxf(y1 * 8.0f, -448.0f), 448.0f), z2 = __builtin_fminf(__builtin_fmaxf(y2 * 8.0f, -448.0f), 448.0f), z3 = __builtin_fminf(__builtin_fmaxf(y3 * 8.0f, -448.0f), 448.0f);
                int p = __builtin_amdgcn_cvt_pk_fp8_f32(z0, z1, 0, false); p = __builtin_amdgcn_cvt_pk_fp8_f32(z2, z3, p, true); ((unsigned*)o8row[q])[lane + 64 * j] = (unsigned)p; } } }
}

struct CvtJob { const float *wg, *wu, *wd, *ks; bf16 *WGU, *WD; int first, count, slot, wave; LAS unsigned char* scr; };
constexpr int CVT_ITEMS = 3 * 2048;
__device__ __forceinline__ void cvt_decode(const CvtJob& J, int q, int wave, const float*& W, int& N, bf16*& WT, int& ldt, int& wrow0, int& k0, bool& scale) {
    const int seg = q >> 11, r = q & 2047, e = r >> 5;
    if (seg < 2) { const int kb = r & 31, n0 = 64 * wave; k0 = 64 * kb; N = 512; ldt = 2048; scale = true;
        W = (seg ? J.wu : J.wg) + (size_t)e * 2048 * 512 + n0; WT = (bf16*)((unsigned char*)J.WGU + (size_t)e * 1024 * 2048); wrow0 = 256 * (n0 >> 7) + (n0 & 127) + (seg ? 128 : 0); }
    else { const int nq = (r >> 3) & 3, kb = r & 7, n0 = 512 * nq + 64 * wave; k0 = 64 * kb; N = 2048; ldt = 512; scale = false;
        W = J.wd + (size_t)e * 512 * 2048 + n0; WT = (bf16*)((unsigned char*)J.WD + (size_t)e * 2048 * 512); wrow0 = n0; }
}
__device__ __forceinline__ void cvt_load(f32x4 (&v)[16], const float* W, int N, int k0, int lane) {
    const float* p = W + (size_t)(k0 + 8 * (lane >> 4)) * N + 4 * (lane & 15);
#pragma unroll
    for (int i = 0; i < 16; ++i) v[i] = __builtin_nontemporal_load((const f32x4*)(p + (size_t)(i + (i >> 3) * 24) * N));
}
__device__ __forceinline__ void cvt_store(const f32x4 (&v)[16], bf16* WT, int ldt, int wrow0, int k0, const float* ks, bool scale, LAS unsigned char* scr  , int lane) {
    const int nl = lane & 15, kg = lane >> 4, kq = k0 + 8 * kg;
    float s[16];
    if (scale) {
#pragma unroll
        for (int i = 0; i < 4; ++i) { const f32x4 t = *(const f32x4*)(ks + kq + 4 * (i & 1) + 32 * (i >> 1)); s[4 * i] = t.x; s[4 * i + 1] = t.y; s[4 * i + 2] = t.z; s[4 * i + 3] = t.w; }
    } else {
#pragma unroll
        for (int i = 0; i < 16; ++i) s[i] = 1.0f;
    }
    LAS unsigned char* wp0 = scr + 128 * nl + 16 * (kg ^ (nl & 7)); LAS unsigned char* wp1 = scr + 128 * nl + 16 * ((4 + kg) ^ (nl & 7));
    const int R = lane >> 3, p = lane & 7;
    LAS const unsigned char* rp = scr + 128 * R + 16 * (p ^ (R & 7));
#pragma unroll
    for (int j = 0; j < 4; ++j) {
        u32x4 o0, o1;
        o0.x = cvt_pk_bf16(v[0][j] * s[0], v[1][j] * s[1]); o0.y = cvt_pk_bf16(v[2][j] * s[2], v[3][j] * s[3]); o0.z = cvt_pk_bf16(v[4][j] * s[4], v[5][j] * s[5]); o0.w = cvt_pk_bf16(v[6][j] * s[6], v[7][j] * s[7]);
        o1.x = cvt_pk_bf16(v[8][j] * s[8], v[9][j] * s[9]); o1.y = cvt_pk_bf16(v[10][j] * s[10], v[11][j] * s[11]); o1.z = cvt_pk_bf16(v[12][j] * s[12], v[13][j] * s[13]); o1.w = cvt_pk_bf16(v[14][j] * s[14], v[15][j] * s[15]);
        *(LAS u32x4*)wp0 = o0; *(LAS u32x4*)wp1 = o1;
        LDS_WAIT();
        const u32x4 a = *(LAS const u32x4*)rp, b = *(LAS const u32x4*)(rp + 1024);
        LDS_WAIT();
        bf16* dst = WT + (size_t)(wrow0 + 4 * R + j) * ldt + k0 + 8 * p;
        __builtin_nontemporal_store(a, (u32x4*)dst); __builtin_nontemporal_store(b, (u32x4*)(dst + (size_t)32 * ldt));
    }
}
__device__ __forceinline__ void cvt_store8(const f32x4 (&v)[16], unsigned char* WT, int ldt, int wrow0, int k0, const float* ks  , float scl, LAS unsigned char* scr, int lane) {
    const int nl = lane & 15, kg = lane >> 4, R = lane >> 2, p = lane & 3, kq = k0 + 8 * kg;
    float s[16];
    if (ks) {
#pragma unroll
        for (int i = 0; i < 4; ++i) { const f32x4 t = *(const f32x4*)(ks + kq + 4 * (i & 1) + 32 * (i >> 1)); s[4 * i] = t.x * scl; s[4 * i + 1] = t.y * scl; s[4 * i + 2] = t.z * scl; s[4 * i + 3] = t.w * scl; }
    } else {
#pragma unroll
        for (int i = 0; i < 16; ++i) s[i] = scl;
    }
    LAS unsigned char* wp = scr + 80 * nl + 8 * kg; LAS const unsigned char* rp = scr + 80 * R + 16 * p;
#pragma unroll
    for (int j = 0; j < 4; ++j) {
        int a0 = __builtin_amdgcn_cvt_pk_fp8_f32(v[0][j] * s[0], v[1][j] * s[1], 0, false); a0 = __builtin_amdgcn_cvt_pk_fp8_f32(v[2][j] * s[2], v[3][j] * s[3], a0, true);
        int a1 = __builtin_amdgcn_cvt_pk_fp8_f32(v[4][j] * s[4], v[5][j] * s[5], 0, false); a1 = __builtin_amdgcn_cvt_pk_fp8_f32(v[6][j] * s[6], v[7][j] * s[7], a1, true);
        int b0 = __builtin_amdgcn_cvt_pk_fp8_f32(v[8][j] * s[8], v[9][j] * s[9], 0, false); b0 = __builtin_amdgcn_cvt_pk_fp8_f32(v[10][j] * s[10], v[11][j] * s[11], b0, true);
        int b1 = __builtin_amdgcn_cvt_pk_fp8_f32(v[12][j] * s[12], v[13][j] * s[13], 0, false); b1 = __builtin_amdgcn_cvt_pk_fp8_f32(v[14][j] * s[14], v[15][j] * s[15], b1, true);
        *(LAS u32x2*)wp = (u32x2){(unsigned)a0, (unsigned)a1}; *(LAS u32x2*)(wp + 32) = (u32x2){(unsigned)b0, (unsigned)b1};
        LDS_WAIT();
        const u32x4 o = *(LAS const u32x4*)rp;
        LDS_WAIT();
        __builtin_nontemporal_store(o, (u32x4*)(WT + (size_t)(wrow0 + 4 * R + j) * ldt + k0 + 16 * p));
    }
}
__device__ __forceinline__ void cvt_run(const CvtJob& J, int lane) {
    int q = J.first; const int qe = J.first + J.count;
    for (; q + 1 < qe; q += 2) {
        const float *W0, *W1; bf16 *T0, *T1; int N0, N1, l0, l1, r0, r1, k0, k1; bool s0, s1;
        cvt_decode(J, q, J.wave, W0, N0, T0, l0, r0, k0, s0); cvt_decode(J, q + 1, J.wave, W1, N1, T1, l1, r1, k1, s1);
        f32x4 va[16], vb[16]; cvt_load(va, W0, N0, k0, lane); cvt_load(vb, W1, N1, k1, lane);
        cvt_store8(va, (unsigned char*)T0, l0, r0, k0, s0 ? J.ks : nullptr, s0 ? 1024.0f : 512.0f, J.scr, lane); cvt_store8(vb, (unsigned char*)T1, l1, r1, k1, s1 ? J.ks : nullptr, s1 ? 1024.0f : 512.0f, J.scr, lane);
    }
    if (q < qe) { const float* W0; bf16* T0; int N0, l0, r0, k0; bool s0; cvt_decode(J, q, J.wave, W0, N0, T0, l0, r0, k0, s0);
        f32x4 va[16]; cvt_load(va, W0, N0, k0, lane); cvt_store8(va, (unsigned char*)T0, l0, r0, k0, s0 ? J.ks : nullptr, s0 ? 1024.0f : 512.0f, J.scr, lane); }
}

__device__ __forceinline__ void p0_prologue(Frame& F, const Args& A) {
    LAS unsigned char* scr = F.lds + F.wave * 2048;
    const int lane = lane_id();
    const int gw = F.vcu * NWAVES + F.wave, NGW = F.G * NWAVES;
    constexpr int J_IN = 32 * 100, J_AB = 16 * 32, J_PB = 16 * 32, J_WO = 32 * 32, NJ = J_IN + J_AB + J_PB + J_WO;
    for (int it = gw; it < NJ; it += NGW) { f32x4 v[16]; int r = it;
        if (r < J_IN) { const int kb = r / 100, nb = r % 100, k0 = 64 * kb, n0 = 64 * nb; cvt_load(v, A.in[I_WIN] + n0, INW, k0, lane);
            if (nb < 36) cvt_store(v, F.WIN(), 2048, n0, k0, nullptr, false, scr, lane);
            if (nb < 20) cvt_store8(v, F.WIN8(), 2048, n0, k0, nullptr, 1024.0f, scr, lane);
            if (nb >= 36) cvt_store8(v, F.WIN8(), 2048, 1280 + 64 * (nb - 36), k0, nullptr, 1024.0f, scr, lane);
            continue; } r -= J_IN;
        if (r < J_AB) { const int kb = r >> 5, nb = r & 31; cvt_load(v, A.in[I_WAB] + 64 * nb, 2048, 64 * kb, lane); cvt_store(v, F.WAB(), 2048, 64 * nb, 64 * kb, nullptr, false, scr, lane); continue; } r -= J_AB;
        if (r < J_PB) { const int kb = r >> 5, nb = r & 31; cvt_load(v, A.in[I_WPB] + 64 * nb, 2048, 64 * kb, lane); cvt_store(v, F.WPT(), 1024, 64 * nb, 64 * kb, nullptr, false, scr, lane); continue; } r -= J_PB;
        { const int kb = r >> 5, nb = r & 31; cvt_load(v, A.in[I_WOUT] + 64 * nb, 2048, 64 * kb, lane); cvt_store(v, F.WO(), 2048, 64 * nb, 64 * kb, nullptr, false, scr, lane); }
    }
    const int gt = F.vcu * (NWAVES * 64) + F.tid, NGT = F.G * NWAVES * 64;
    for (int i = gt; i < 4 * 256 * 256 / 2; i += NGT) { const int e = 2 * i, g = e >> 16, j = e & 255; const float s0 = A.in[I_PSCL][g * 256 + j], s1 = A.in[I_PSCL][g * 256 + j + 1];
        ((unsigned*)F.PMS())[i] = cvt_pk_bf16(A.in[I_PMIX][e] * s0, A.in[I_PMIX][e + 1] * s1); }
    for (int i = gt; i < 80 * 2048; i += NGT) { const int n = i >> 11, k = i & 2047; float v = 0.f;
        if (n < 8) v = A.in[I_WRG][k * 8 + n] * A.in[I_NFFN][k]; else if (n < 72) v = A.in[I_WRE][k * 64 + (n - 8)] * A.in[I_NFFN][k];
        F.WR()[i] = (bf16)(cvt_pk_bf16(v, 0.f) & 0xffffu); }
    for (int m = gw; m + 3 * NGW < M; m += 4 * NGW) {
        const float* const xr[4] = {A.in[I_X] + (size_t)m * DM, A.in[I_X] + (size_t)(m + NGW) * DM, A.in[I_X] + (size_t)(m + 2 * NGW) * DM, A.in[I_X] + (size_t)(m + 3 * NGW) * DM};
        bf16* const orw[4] = {F.HN() + (size_t)m * DM, F.HN() + (size_t)(m + NGW) * DM, F.HN() + (size_t)(m + 2 * NGW) * DM, F.HN() + (size_t)(m + 3 * NGW) * DM};
        unsigned char* const o8[4] = {F.HN8() + (size_t)m * DM, F.HN8() + (size_t)(m + NGW) * DM, F.HN8() + (size_t)(m + 2 * NGW) * DM, F.HN8() + (size_t)(m + 3 * NGW) * DM};
        rms_rows_to_bf16<4>(xr, A.in[I_NMIX], orw, o8, lane); }
    if (gw < NMETA) { const float* const xr[1] = {A.in[I_META] + (size_t)gw * DM}; bf16* const orw[1] = {F.HN() + (size_t)(M + gw) * DM}; unsigned char* const o8[1] = {nullptr}; rms_rows_to_bf16<1>(xr, A.in[I_NMIX], orw, o8, lane); }
}


using pg8::Unit;
struct DenseOrder {
    const char* A; const char* B; int nM, nN, nwg, G, c, lda, ldb;
    __device__ __forceinline__ bool next(int i, Unit& u) const {
        const long L = (long)i * G + c; if (L >= nwg) return false;
        int pm, pn; pg8::tile_of((int)L, nM, nN, pm, pn); u.pm = pm; u.pn = pn; u.x0 = 0; u.x1 = 0;
        u.a = A + (size_t)pm * 256 * lda * 2; u.b = B + (size_t)pn * 256 * ldb * 2; return true; }
};
struct EpiProj {
    static constexpr bool HAS_MID = false; static constexpr int MID_T = 0;
    static constexpr bool HAS_POST = true;
    bf16* O; CvtJob job; int lane, colbase;
    __device__ __forceinline__ void post(int ui) const { if (ui == job.slot) cvt_run(job, lane); }
    __device__ __forceinline__ void operator()(const f32x4 (&acc)[2][2][4][2], const Unit& u, int, int wr, int wc, int fr, int fq) const {
        const int row0 = u.pm * 256 + wr * 64 + fr, col0 = colbase + u.pn * 256 + wc * 32 + 8 * fq;
#pragma unroll
        for (int ai = 0; ai < 2; ++ai)
#pragma unroll
            for (int m = 0; m < 4; ++m) { bf16* rowp = O + (size_t)(row0 + ai * 128 + m * 16) * PW + col0;
#pragma unroll
                for (int bj = 0; bj < 2; ++bj) { const f32x4 v0 = acc[ai][bj][m][0], v1 = acc[ai][bj][m][1];
                    u32x4 w; w.x = cvt_pk_bf16(v0[0], v0[1]); w.y = cvt_pk_bf16(v0[2], v0[3]); w.z = cvt_pk_bf16(v1[0], v1[1]); w.w = cvt_pk_bf16(v1[2], v1[3]);
                    *(u32x4*)(rowp + bj * 128) = w; } }
    }
};
struct EpiGate {
    static constexpr bool HAS_MID = false; static constexpr int MID_T = 0;
    static constexpr bool HAS_POST = true;
    unsigned char* G; bf16* O; CvtJob job; int lane, n1;
    __device__ __forceinline__ void post(int ui) const { if (ui + n1 == job.slot) cvt_run(job, lane); }
    __device__ __forceinline__ void operator()(const f32x4 (&acc)[2][2][4][2], const Unit& u, int, int wr, int wc, int fr, int fq) const {
        const int row0 = u.pm * 256 + wr * 64 + fr; constexpr float S = 1.0f / 8192.0f;
        if (u.pn < 5) { const int col0 = u.pn * 256 + wc * 32 + 8 * fq;
#pragma unroll
            for (int ai = 0; ai < 2; ++ai)
#pragma unroll
                for (int m = 0; m < 4; ++m) { bf16* rowp = O + (size_t)(row0 + ai * 128 + m * 16) * PW + col0;
#pragma unroll
                    for (int bj = 0; bj < 2; ++bj) { const f32x4 v0 = acc[ai][bj][m][0] * S, v1 = acc[ai][bj][m][1] * S;
                        u32x4 w; w.x = cvt_pk_bf16(v0[0], v0[1]); w.y = cvt_pk_bf16(v0[2], v0[3]); w.z = cvt_pk_bf16(v1[0], v1[1]); w.w = cvt_pk_bf16(v1[2], v1[3]);
                        *(u32x4*)(rowp + bj * 128) = w; } }
        } else { const int col0 = (u.pn - 5) * 256 + wc * 32 + 8 * fq;
#pragma unroll
            for (int ai = 0; ai < 2; ++ai)
#pragma unroll
                for (int m = 0; m < 4; ++m) { unsigned char* rowp = G + (size_t)(row0 + ai * 128 + m * 16) * GW + col0;
#pragma unroll
                    for (int bj = 0; bj < 2; ++bj) { const f32x4 v0 = acc[ai][bj][m][0] * S, v1 = acc[ai][bj][m][1] * S; unsigned q[8];
#pragma unroll
                        for (int e = 0; e < 4; ++e) { q[e] = (unsigned)fminf(sigmoidf_(v0[e]) * 256.0f, 255.0f); q[4 + e] = (unsigned)fminf(sigmoidf_(v1[e]) * 256.0f, 255.0f); }
                        u32x2 w; w.x = q[0] | (q[1] << 8) | (q[2] << 16) | (q[3] << 24); w.y = q[4] | (q[5] << 8) | (q[6] << 16) | (q[7] << 24);
                        *(u32x2*)(rowp + bj * 128) = w; } }
        }
    }
};
struct FoldOrder {
    const char* WPT; const char* PMS; int idx;
    __device__ __forceinline__ bool next(int i, Unit& u) const {
        if (i > 0 || idx < 0) return false; u.pm = idx >> 2; u.pn = idx & 3; u.x0 = 0; u.x1 = 0;
        u.a = WPT + ((size_t)u.pm * 256 * 1024 + (size_t)u.pn * 256) * 2; u.b = PMS + (size_t)u.pn * 65536 * 2; return true; }
};
struct EpiFold {
    static constexpr bool HAS_MID = false; static constexpr int MID_T = 0;
    static constexpr bool HAS_POST = false;
    bf16* O;
    __device__ __forceinline__ void operator()(const f32x4 (&acc)[2][2][4][2], const Unit& u, int, int wr, int wc, int fr, int fq) const {
        const int row0 = u.pm * 256 + wr * 64 + fr, col0 = 1024 + u.pn * 256 + wc * 32 + 8 * fq;
#pragma unroll
        for (int ai = 0; ai < 2; ++ai)
#pragma unroll
            for (int m = 0; m < 4; ++m) { bf16* rowp = O + (size_t)(row0 + ai * 128 + m * 16) * 2048 + col0;
#pragma unroll
                for (int bj = 0; bj < 2; ++bj) { const f32x4 v0 = acc[ai][bj][m][0], v1 = acc[ai][bj][m][1];
                    u32x4 w; w.x = cvt_pk_bf16(v0[0], v0[1]); w.y = cvt_pk_bf16(v0[2], v0[3]); w.z = cvt_pk_bf16(v1[0], v1[1]); w.w = cvt_pk_bf16(v1[2], v1[3]);
                    *(u32x4*)(rowp + bj * 128) = w; } }
    }
};
struct EpiBranch {
    static constexpr bool HAS_MID = true; static constexpr int MID_T = 16;
    static constexpr bool HAS_POST = false;
    const unsigned char* GATE; bf16* MG;
    static __device__ __forceinline__ void dec8(const u32x2 g, float (&f)[8]) {
        constexpr float S = 1.0f / 256.0f, H = 0.5f / 256.0f;
        f[0] = (float)(g.x & 0xffu) * S + H; f[1] = (float)((g.x >> 8) & 0xffu) * S + H; f[2] = (float)((g.x >> 16) & 0xffu) * S + H; f[3] = (float)(g.x >> 24) * S + H;
        f[4] = (float)(g.y & 0xffu) * S + H; f[5] = (float)((g.y >> 8) & 0xffu) * S + H; f[6] = (float)((g.y >> 16) & 0xffu) * S + H; f[7] = (float)(g.y >> 24) * S + H;
    }
    __device__ __forceinline__ void mid(f32x4 (&acc)[2][2][4][2], const Unit& u, int wr, int wc, int fr, int fq) const {
        const unsigned off0 = (unsigned)(u.pm * 256 + wr * 64 + fr) * (unsigned)GW + (unsigned)(u.pn * 256 + wc * 32 + 8 * fq);
#pragma unroll
        for (int ai = 0; ai < 2; ++ai) {
            u32x2 ga[4][2], gb[4][2];
#pragma unroll
            for (int m = 0; m < 4; ++m) { const unsigned off = off0 + (unsigned)(ai * 128 + m * 16) * (unsigned)GW;
#pragma unroll
                for (int bj = 0; bj < 2; ++bj) { ga[m][bj] = *(const u32x2*)(GATE + off + bj * 128); gb[m][bj] = *(const u32x2*)(GATE + off + 2048 + bj * 128); } }
            asm volatile("" ::: "memory");
#pragma unroll
            for (int m = 0; m < 4; ++m)
#pragma unroll
                for (int bj = 0; bj < 2; ++bj) { float fa[8], fb[8]; dec8(ga[m][bj], fa); dec8(gb[m][bj], fb);
#pragma unroll
                    for (int e = 0; e < 4; ++e) { acc[ai][bj][m][0][e] *= fa[e] * __builtin_amdgcn_rcpf(fb[e]); acc[ai][bj][m][1][e] *= fa[4 + e] * __builtin_amdgcn_rcpf(fb[4 + e]); } }
            asm volatile("" ::: "memory");
        }
    }
    __device__ __forceinline__ void operator()(const f32x4 (&acc)[2][2][4][2], const Unit& u, int, int wr, int wc, int fr, int fq) const {
        const unsigned row0 = (unsigned)(u.pm * 256 + wr * 64 + fr), col0 = (unsigned)(u.pn * 256 + wc * 32 + 8 * fq);
        const unsigned goff0 = row0 * (unsigned)GW + 2048u + col0, moff0 = row0 * 2048u + col0;
        u32x2 gb[2][4][2];
#pragma unroll
        for (int ai = 0; ai < 2; ++ai)
#pragma unroll
            for (int m = 0; m < 4; ++m) { const unsigned goff = goff0 + (unsigned)(ai * 128 + m * 16) * (unsigned)GW;
#pragma unroll
                for (int bj = 0; bj < 2; ++bj) gb[ai][m][bj] = *(const u32x2*)(GATE + goff + bj * 128); }
        asm volatile("" ::: "memory");
#pragma unroll
        for (int ai = 0; ai < 2; ++ai)
#pragma unroll
            for (int m = 0; m < 4; ++m) { const unsigned moff = moff0 + (unsigned)(ai * 128 + m * 16) * 2048u;
#pragma unroll
                for (int bj = 0; bj < 2; ++bj) { float fb[8]; dec8(gb[ai][m][bj], fb);
                    const f32x4 v0 = acc[ai][bj][m][0], v1 = acc[ai][bj][m][1];
                    u32x4 w; w.x = cvt_pk_bf16(v0[0] * fb[0], v0[1] * fb[1]); w.y = cvt_pk_bf16(v0[2] * fb[2], v0[3] * fb[3]); w.z = cvt_pk_bf16(v1[0] * fb[4], v1[1] * fb[5]); w.w = cvt_pk_bf16(v1[2] * fb[6], v1[3] * fb[7]);
                    *(u32x4*)(MG + moff + bj * 128) = w; } }
    }
};
struct EpiOut {
    static constexpr bool HAS_MID = false; static constexpr int MID_T = 0;
    static constexpr bool HAS_POST = false;
    const float* X; bf16* H1B; float* SSQ; unsigned char* H8;
    __device__ __forceinline__ void operator()(const f32x4 (&acc)[2][2][4][2], const Unit& u, int, int wr, int wc, int fr, int fq) const {
        PT_MARK(70, 0);
        const int row0 = u.pm * 256 + wr * 64 + fr, col0 = u.pn * 256 + wc * 32 + 8 * fq;
#pragma unroll
        for (int ai = 0; ai < 2; ++ai) {
            f32x4 xr[4][2][2];
#pragma unroll
            for (int m = 0; m < 4; ++m) { const size_t off = (size_t)(row0 + ai * 128 + m * 16) * 2048 + col0;
#pragma unroll
                for (int bj = 0; bj < 2; ++bj) { xr[m][bj][0] = *(const f32x4*)(X + off + bj * 128); xr[m][bj][1] = *(const f32x4*)(X + off + bj * 128 + 4); } }
            asm volatile("" ::: "memory");
#pragma unroll
            for (int m = 0; m < 4; ++m) { const int row = row0 + ai * 128 + m * 16; const size_t off = (size_t)row * 2048 + col0; float ss = 0.f;
#pragma unroll
                for (int bj = 0; bj < 2; ++bj) { const f32x4 v0 = acc[ai][bj][m][0] + xr[m][bj][0], v1 = acc[ai][bj][m][1] + xr[m][bj][1];
                    ss += (v0[0] * v0[0] + v0[1] * v0[1]) + (v0[2] * v0[2] + v0[3] * v0[3]) + (v1[0] * v1[0] + v1[1] * v1[1]) + (v1[2] * v1[2] + v1[3] * v1[3]);
                    u32x4 w; w.x = cvt_pk_bf16(v0[0], v0[1]); w.y = cvt_pk_bf16(v0[2], v0[3]); w.z = cvt_pk_bf16(v1[0], v1[1]); w.w = cvt_pk_bf16(v1[2], v1[3]);
                    *(u32x4*)(H1B + off + bj * 128) = w;
                    f32x4 z0 = v0 * 8.0f, z1 = v1 * 8.0f;
#pragma unroll
                    for (int e = 0; e < 4; ++e) { z0[e] = __builtin_fminf(__builtin_fmaxf(z0[e], -448.0f), 448.0f); z1[e] = __builtin_fminf(__builtin_fmaxf(z1[e], -448.0f), 448.0f); }
                    int p0 = __builtin_amdgcn_cvt_pk_fp8_f32(z0[0], z0[1], 0, false); p0 = __builtin_amdgcn_cvt_pk_fp8_f32(z0[2], z0[3], p0, true);
                    int p1 = __builtin_amdgcn_cvt_pk_fp8_f32(z1[0], z1[1], 0, false); p1 = __builtin_amdgcn_cvt_pk_fp8_f32(z1[2], z1[3], p1, true);
                    *(u32x2*)(H8 + off + bj * 128) = (u32x2){(unsigned)p0, (unsigned)p1}; }
                ss += __shfl_xor(ss, 16); ss += __shfl_xor(ss, 32);
                if (fq == 0) SSQ[(size_t)(u.pn * 4 + wc) * M + row] = ss; }
            asm volatile("" ::: "memory");
        }
#if PROBE_TIME == 70
        asm volatile("s_waitcnt vmcnt(0)" ::: "memory");
#endif
        PT_MARK(70, 1);
    }
};
struct MoeOrder {
    LAS const int* ud; int nunits; const char* A; const char* B; size_t a_row_bytes  , b_exp_bytes, b_panel_bytes;
    __device__ __forceinline__ bool next(int i, Unit& u) const {
        if (i >= nunits) return false;
        const int e = __builtin_amdgcn_readfirstlane(ud[i * 8 + 0]), pn = __builtin_amdgcn_readfirstlane(ud[i * 8 + 1]), nv = __builtin_amdgcn_readfirstlane(ud[i * 8 + 2]), rs = __builtin_amdgcn_readfirstlane(ud[i * 8 + 3]);
        u.pm = e; u.pn = pn; u.x0 = nv; u.x1 = rs; u.a = A + (size_t)rs * a_row_bytes; u.b = B + (size_t)e * b_exp_bytes + (size_t)pn * b_panel_bytes; return true; }
};
struct EpiGU {
    static constexpr bool HAS_MID = false; static constexpr int MID_T = 0;
    static constexpr bool HAS_POST = false;
    bf16* HID; LAS const float* rtab;
    __device__ __forceinline__ void operator()(const f32x4 (&acc)[2][2][4][2], const Unit& u, int ui, int wr, int wc, int fr, int fq) const {
        const int col0 = u.pn * 128 + wc * 32 + 8 * fq; const int nv = u.x0, rs = u.x1;
#pragma unroll
        for (int ai = 0; ai < 2; ++ai)
#pragma unroll
            for (int m = 0; m < 4; ++m) { const int rr = ai * 128 + wr * 64 + m * 16 + fr; const float r = rtab[ui * 256 + rr] * (1.0f / 8192.0f);
                int pk[2];
#pragma unroll
                for (int n = 0; n < 2; ++n) { f32x4 g = acc[ai][0][m][n] * r; const f32x4 uu = acc[ai][1][m][n] * r;
#pragma unroll
                    for (int e = 0; e < 4; ++e) g[e] = __builtin_fminf(__builtin_fmaxf(g[e] * sigmoidf_(g[e]) * uu[e] * 8.0f, -448.0f), 448.0f);
                    int p = __builtin_amdgcn_cvt_pk_fp8_f32(g[0], g[1], 0, false); pk[n] = __builtin_amdgcn_cvt_pk_fp8_f32(g[2], g[3], p, true); }
                const int p0 = pk[0], p1 = pk[1];
                if (rr < nv) *(u32x2*)((unsigned char*)HID + (size_t)(rs + rr) * DEXP + col0) = (u32x2){(unsigned)p0, (unsigned)p1}; }
    }
};
struct EpiDown {
    static constexpr bool HAS_MID = false; static constexpr int MID_T = 0;
    static constexpr bool HAS_POST = false;
    bf16* Y; LAS const float* wtab;
    __device__ __forceinline__ void operator()(const f32x4 (&acc)[2][2][4][2], const Unit& u, int ui, int wr, int wc, int fr, int fq) const {
        const int col0 = u.pn * 256 + wc * 32 + 8 * fq; const int nv = u.x0, rs = u.x1;
#pragma unroll
        for (int ai = 0; ai < 2; ++ai)
#pragma unroll
            for (int m = 0; m < 4; ++m) { const int rr = ai * 128 + wr * 64 + m * 16 + fr; const float wt = wtab[ui * 256 + rr] * (1.0f / 4096.0f); bf16* rowp = Y + (size_t)(rs + rr) * 2048 + col0;
#pragma unroll
                for (int bj = 0; bj < 2; ++bj) { const f32x4 v0 = acc[ai][bj][m][0] * wt, v1 = acc[ai][bj][m][1] * wt;
                    u32x4 w; w.x = cvt_pk_bf16(v0[0], v0[1]); w.y = cvt_pk_bf16(v0[2], v0[3]); w.z = cvt_pk_bf16(v1[0], v1[1]); w.w = cvt_pk_bf16(v1[2], v1[3]);
                    if (rr < nv) *(u32x4*)(rowp + bj * 128) = w; } }
    }
};

__device__ __forceinline__ void meta_proj_task(Frame& F, int task) {
    const int lane = F.lane, n0 = KOFF + 16 * task;
    const bf16* ap = F.HN() + (size_t)(M + (lane & 15)) * DM + 8 * (lane >> 4);
    const bf16* bp = F.WIN() + (size_t)(n0 + (lane & 15)) * DM + 8 * (lane >> 4);
    f32x4 acc = (f32x4){0.f, 0.f, 0.f, 0.f};
#pragma unroll 8
    for (int ks = 0; ks < 64; ++ks) { const bf16x8 a = *(const bf16x8*)(ap + 32 * ks), b = *(const bf16x8*)(bp + 32 * ks); acc = __builtin_amdgcn_mfma_f32_16x16x32_bf16(a, b, acc, 0, 0, 0); }
#pragma unroll
    for (int r = 0; r < 4; ++r) F.PROJ()[(size_t)(M + 4 * (lane >> 4) + r) * PW + n0 + (lane & 15)] = (bf16)(cvt_pk_bf16(acc[r], 0.f) & 0xffffu);
}

__device__ __forceinline__ int t5_bucket(int d) {
    if (d < 16) return d;
    return 16 + (d >= 19) + (d >= 21) + (d >= 24) + (d >= 27) + (d >= 31) + (d >= 35) + (d >= 40) + (d >= 46) + (d >= 52) + (d >= 59) + (d >= 67) + (d >= 77) + (d >= 87) + (d >= 99) + (d >= 113);
}
constexpr int A_KL = 0, A_KROW = 144;
constexpr int A_VT = 288 * 144, A_VROW = 584;
constexpr int A_BT = A_VT + 64 * 584;
static_assert(A_BT + 4096 <= RING_BYTES, "attention LDS");

template <int T>
__device__ __forceinline__ void attn_qtile(LAS const unsigned char* lds, LAS const float* BT, const bf16x8 (&qf)[4], bf16x8 (&qn)[4], const bf16* Qrow, bf16* Orow, float sink, int blk, int lane) {
    const int r32 = lane & 31, hi = lane >> 5, qi = 32 * T + r32;
    if constexpr (T < 3) {
#pragma unroll
        for (int ds = 0; ds < 4; ++ds) qn[ds] = *(const bf16x8*)(Qrow + (size_t)(32 + r32) * PW + ds * 16 + hi * 8); }
    f32x16 s[6];
#pragma unroll
    for (int ti = 0; ti < 6; ++ti) {
        const int kkb = (ti == 0) ? 0 : (ti <= 4 - T ? 32 + 32 * (T + ti - 1) : 160 + 32 * (ti - (5 - T)));
        f32x16 a = (f32x16){0.f, 0.f, 0.f, 0.f, 0.f, 0.f, 0.f, 0.f, 0.f, 0.f, 0.f, 0.f, 0.f, 0.f, 0.f, 0.f};
#pragma unroll
        for (int ds = 0; ds < 4; ++ds) { const bf16x8 kf = *(const LAS bf16x8*)(lds + A_KL + (kkb + r32) * A_KROW + ds * 32 + hi * 16); a = __builtin_amdgcn_mfma_f32_32x32x16_bf16(kf, qf[ds], a, 0, 0, 0); }
        s[ti] = a;
    }
    float mx = sink;
#pragma unroll
    for (int r = 0; r < 8; ++r) { const int i = (r & 3) + 8 * (r >> 2) + 4 * hi; int dist = 16 + 128 * blk + qi - i; dist = dist > 127 ? 127 : dist;
        const float x = s[0][r] * 0.125f + BT[dist]; s[0][r] = x; mx = fmaxf(mx, x); }
#pragma unroll
    for (int ti = 1; ti < 6; ++ti) {
        const bool prev = ti <= 4 - T; const int jt = prev ? (T + ti - 1) : (ti - (5 - T));
#pragma unroll
        for (int r = 0; r < 16; ++r) { const int i = (r & 3) + 8 * (r >> 2) + 4 * hi, j = 32 * jt + i;
            int dist; bool vis;
            if (prev) { dist = 128 + qi - j; vis = (blk > 0) && (jt > T || j > qi); } else { dist = qi - j; vis = (jt < T) || (j <= qi); }
            dist = dist < 0 ? 0 : (dist > 127 ? 127 : dist);
            const float x = vis ? s[ti][r] * 0.125f + BT[dist] : -1e30f; s[ti][r] = x; mx = fmaxf(mx, x); }
    }
    mx = fmaxf(mx, __shfl_xor(mx, 32));
    float l = 0.f;
#pragma unroll
    for (int r = 0; r < 8; ++r) { const float p = __expf(s[0][r] - mx); s[0][r] = p; l += p; }
#pragma unroll
    for (int ti = 1; ti < 6; ++ti)
#pragma unroll
        for (int r = 0; r < 16; ++r) { const float p = __expf(s[ti][r] - mx); s[ti][r] = p; l += p; }
    l += __shfl_xor(l, 32); l += __expf(sink - mx);
    f32x16 o[2];
    o[0] = (f32x16){0.f, 0.f, 0.f, 0.f, 0.f, 0.f, 0.f, 0.f, 0.f, 0.f, 0.f, 0.f, 0.f, 0.f, 0.f, 0.f}; o[1] = o[0];
#pragma unroll
    for (int ti = 0; ti < 6; ++ti) {
        const int kkb = (ti == 0) ? 0 : (ti <= 4 - T ? 32 + 32 * (T + ti - 1) : 160 + 32 * (ti - (5 - T)));
#pragma unroll
        for (int s2 = 0; s2 < 2; ++s2) {
            if (ti == 0 && s2 == 1) continue;
            u32x4 pw; pw.x = cvt_pk_bf16(s[ti][8 * s2 + 0], s[ti][8 * s2 + 1]); pw.y = cvt_pk_bf16(s[ti][8 * s2 + 2], s[ti][8 * s2 + 3]); pw.z = cvt_pk_bf16(s[ti][8 * s2 + 4], s[ti][8 * s2 + 5]); pw.w = cvt_pk_bf16(s[ti][8 * s2 + 6], s[ti][8 * s2 + 7]);
            const bf16x8 pf = __builtin_bit_cast(bf16x8, pw);
#pragma unroll
            for (int dt = 0; dt < 2; ++dt) { LAS const unsigned char* vp = lds + A_VT + (dt * 32 + r32) * A_VROW + (kkb + 16 * s2 + 4 * hi) * 2;
                const u32x2 lo = *(const LAS u32x2*)vp, hi2 = *(const LAS u32x2*)(vp + 16);
                const bf16x8 vf = __builtin_bit_cast(bf16x8, (u32x4){lo.x, lo.y, hi2.x, hi2.y});
                o[dt] = __builtin_amdgcn_mfma_f32_32x32x16_bf16(vf, pf, o[dt], 0, 0, 0); }
        }
    }
    const float inv = 1.0f / l;
#pragma unroll
    for (int dt = 0; dt < 2; ++dt)
#pragma unroll
        for (int g4 = 0; g4 < 4; ++g4) { u32x2 w; w.x = cvt_pk_bf16(o[dt][4 * g4 + 0] * inv, o[dt][4 * g4 + 1] * inv); w.y = cvt_pk_bf16(o[dt][4 * g4 + 2] * inv, o[dt][4 * g4 + 3] * inv);
            *(u32x2*)(Orow + (size_t)r32 * 2048 + dt * 32 + 8 * g4 + 4 * hi) = w; }
}

template <int W>
__device__ __forceinline__ void mixed_task(const bf16* ub  , bf16* ob  , int b, int s0) {
    constexpr int NR = 16 + W - 1;
    u32x4 u[NR];
#pragma unroll
    for (int i = 0; i < NR; ++i) { const int s = s0 - (W - 1) + i; const size_t row = s >= 0 ? (size_t)(b * SEQ + s) : (size_t)(M + 16 + s); u[i] = *(const u32x4*)(ub + row * PW); }
    constexpr float iw = 1.0f / (float)W;
#pragma unroll
    for (int t = 0; t < 16; ++t) {
        float a[8];
#pragma unroll
        for (int e = 0; e < 8; ++e) a[e] = 0.f;
#pragma unroll
        for (int j = 0; j < W; ++j) { const u32x4 v = u[t + j];
            a[0] += bf_lo(v.x); a[1] += bf_hi(v.x); a[2] += bf_lo(v.y); a[3] += bf_hi(v.y); a[4] += bf_lo(v.z); a[5] += bf_hi(v.z); a[6] += bf_lo(v.w); a[7] += bf_hi(v.w); }
        const u32x4 own = u[t + W - 1];
        u32x4 o; o.x = cvt_pk_bf16(a[0] * iw - bf_lo(own.x), a[1] * iw - bf_hi(own.x)); o.y = cvt_pk_bf16(a[2] * iw - bf_lo(own.y), a[3] * iw - bf_hi(own.y));
        o.z = cvt_pk_bf16(a[4] * iw - bf_lo(own.z), a[5] * iw - bf_hi(own.z)); o.w = cvt_pk_bf16(a[6] * iw - bf_lo(own.w), a[7] * iw - bf_hi(own.w));
        *(u32x4*)(ob + (size_t)t * 2048) = o;
    }
}

__device__ __forceinline__ void attn_unit(Frame& F, const Args& A, int b, int blk, int kvh) {
    LAS unsigned char* lds = F.lds; const int tid = F.tid; const int m0 = b * SEQ + blk * 128;
    PT_MARK(20, 0);
    for (int c = tid; c < 288 * 8; c += NWAVES * 64) { const int kk = c >> 3, ch = c & 7; int row = -1;
        if (kk < 16) row = M + kk; else if (kk >= 160) row = m0 + (kk - 160); else if (kk >= 32 && blk > 0) row = m0 - 128 + (kk - 32);
        u32x4 kv = (u32x4){0u, 0u, 0u, 0u}, vv = kv;
        if (row >= 0) { const bf16* p = F.PROJ() + (size_t)row * PW + kvh * 64 + ch * 8; kv = *(const u32x4*)(p + KOFF); vv = *(const u32x4*)(p + VOFF); }
        *(LAS u32x4*)(lds + A_KL + kk * A_KROW + ch * 16) = kv;
        if (kk < 16 || kk >= 32) { LAS bf16* vt = (LAS bf16*)(lds + A_VT) + (size_t)(ch * 8) * 292 + kk;
            vt[0 * 292] = (bf16)(vv.x & 0xffffu); vt[1 * 292] = (bf16)(vv.x >> 16); vt[2 * 292] = (bf16)(vv.y & 0xffffu); vt[3 * 292] = (bf16)(vv.y >> 16);
            vt[4 * 292] = (bf16)(vv.z & 0xffffu); vt[5 * 292] = (bf16)(vv.z >> 16); vt[6 * 292] = (bf16)(vv.w & 0xffffu); vt[7 * 292] = (bf16)(vv.w >> 16); }
    }
    LAS float* BTall = (LAS float*)(lds + A_BT);
    for (int t = tid; t < 8 * 128; t += NWAVES * 64) { const int g = t >> 7, d = t & 127; BTall[t] = A.in[I_RELB][t5_bucket(d) * 16 + kvh * 8 + g]; }
    __syncthreads();
    PT_MARK(20, 1); PT_MARK(21, 0);
    const int g = F.wave, hq = kvh * 8 + g; const float sink = A.in[I_SINK][hq];
    const bf16* Q = F.PROJ() + (size_t)m0 * PW + hq * 64; bf16* O = F.AP() + (size_t)m0 * 2048 + hq * 64;
    LAS const float* BT = BTall + g * 128;
    bf16x8 qa[4], qb[4];
    { const int r32 = F.lane & 31, hi = F.lane >> 5;
#pragma unroll
      for (int ds = 0; ds < 4; ++ds) qa[ds] = *(const bf16x8*)(Q + (size_t)r32 * PW + ds * 16 + hi * 8); }
    attn_qtile<0>(lds, BT, qa, qb, Q, O, sink, blk, F.lane);
    attn_qtile<1>(lds, BT, qb, qa, Q + (size_t)32 * PW, O + (size_t)32 * 2048, sink, blk, F.lane);
    attn_qtile<2>(lds, BT, qa, qb, Q + (size_t)64 * PW, O + (size_t)64 * 2048, sink, blk, F.lane);
    attn_qtile<3>(lds, BT, qb, qa, Q + (size_t)96 * PW, O + (size_t)96 * 2048, sink, blk, F.lane);
    PT_MARK(21, 1); PT_MARK(22, 0);
    { const int grp = 2 * kvh + (F.wave & 1), r0 = 16 * (2 * (F.wave >> 1) + (F.lane >> 5)), c8 = grp * 256 + (F.lane & 31) * 8;
      const bf16* ub = F.PROJ() + UOFF + c8; bf16* ob = F.AP() + (size_t)(m0 + r0) * 2048 + 1024 + c8; const int s0 = blk * 128 + r0;
      if (grp == 0) mixed_task<2>(ub, ob, b, s0); else if (grp == 1) mixed_task<4>(ub, ob, b, s0); else if (grp == 2) mixed_task<8>(ub, ob, b, s0); else mixed_task<16>(ub, ob, b, s0); }
    PT_MARK(22, 1);
    __syncthreads();
}

__device__ __forceinline__ void router_group(Frame& F, const Args& A, int tg, const int dummy = 0) {
    LAS unsigned char* lds = F.lds; const int lane = F.lane, w = F.wave, q = w & 3, kh = w >> 2;
    LAS float* part = (LAS float*)lds;
    LAS float* logit = (LAS float*)(lds + 20480);
    const int t0 = tg * 64 + q * 16;
    f32x4 acc[5];
#pragma unroll
    for (int n = 0; n < 5; ++n) acc[n] = (f32x4){0.f, 0.f, 0.f, 0.f};
    constexpr int RB_OFF = 40960, RB_ROW = 272, RB_BUF = 160 * RB_ROW;
    static_assert(RB_OFF + 2 * RB_BUF <= RING_BYTES, "router LDS");
    const int srow = F.tid >> 4, sl16 = F.tid & 15;
    u32x4 sb[5]; bf16x8 an[4], ac[4];
    const bf16* ap = F.H1B() + (size_t)(t0 + (lane & 15)) * DM + kh * 1024 + 8 * (lane >> 4);
#define RT_LOADB(cc) do { _Pragma("unroll") for (int p = 0; p < 5; ++p) { const int row = p * 32 + srow, h = row >= 80 ? 1 : 0, n = row - 80 * h; \
        sb[p] = *(const u32x4*)(F.WR() + (size_t)n * DM + 1024 * h + 128 * (cc) + 8 * sl16); } } while (0)
#define RT_STOREB(bufi) do { _Pragma("unroll") for (int p = 0; p < 5; ++p) *(LAS u32x4*)(lds + RB_OFF + (bufi) * RB_BUF + (p * 32 + srow) * RB_ROW + 16 * sl16) = sb[p]; } while (0)
#define RT_LOADA(dst, cc) do { _Pragma("unroll") for (int ks = 0; ks < 4; ++ks) dst[ks] = *(const bf16x8*)(ap + 128 * (cc) + 32 * ks); } while (0)
    PT_MARK(50, 0);
    float ss_row = 0.f;
    if (F.tid < 64) {
#pragma unroll
        for (int p = 0; p < 32; ++p) ss_row += F.SSQ()[(size_t)p * M + tg * 64 + F.tid]; }
    RT_LOADB(0); RT_LOADA(ac, 0); RT_STOREB(0);
    __syncthreads();
#pragma unroll
    for (int cc = 0; cc < 8; ++cc) {
        if (cc < 7) { RT_LOADB(cc + 1); RT_LOADA(an, cc + 1); }
        LAS const unsigned char* bb = lds + RB_OFF + (cc & 1) * RB_BUF + (kh * 80 + (lane & 15)) * RB_ROW + 16 * (lane >> 4);
#pragma unroll
        for (int ks = 0; ks < 4; ++ks)
#pragma unroll
            for (int n = 0; n < 5; ++n) { const bf16x8 b = *(const LAS bf16x8*)(bb + n * 16 * RB_ROW + 64 * ks); acc[n] = __builtin_amdgcn_mfma_f32_16x16x32_bf16(ac[ks], b, acc[n], 0, 0, 0); }
        if (cc < 7) { RT_STOREB((cc + 1) & 1);
#pragma unroll
            for (int ks = 0; ks < 4; ++ks) ac[ks] = an[ks]; }
        __syncthreads();
    }
#undef RT_LOADB
#undef RT_STOREB
#undef RT_LOADA
    PT_MARK(50, 1); PT_MARK(51, 0);
    if (kh == 1) {
#pragma unroll
        for (int n = 0; n < 5; ++n) *(LAS f32x4*)(part + ((q * 5 + n) * 64 + lane) * 4) = acc[n]; }
    __syncthreads();
    if (kh == 0) {
#pragma unroll
        for (int n = 0; n < 5; ++n) { const f32x4 p = *(LAS const f32x4*)(part + ((q * 5 + n) * 64 + lane) * 4); const f32x4 v = acc[n] + p;
#pragma unroll
            for (int r = 0; r < 4; ++r) logit[(q * 16 + 4 * (lane >> 4) + r) * 80 + n * 16 + (lane & 15)] = v[r]; } }
    __syncthreads();
    PT_MARK(51, 1); PT_MARK(52, 0);
    if (F.tid < 64) {
        const int tt = tg * 64 + F.tid; LAS const float* lg = logit + F.tid * 80;
        const float r = 1.0f / sqrtf(ss_row * (1.0f / DM) + RMS_EPS);
        float gl[8]; int grp = 0; float gmax = -3.0e38f;
#pragma unroll
        for (int j = 0; j < 8; ++j) { gl[j] = r * lg[j] + A.in[I_BRG][j]; if (gl[j] > gmax) { gmax = gl[j]; grp = j; } }
        float den = 0.f;
#pragma unroll
        for (int j = 0; j < 8; ++j) den += __expf(gl[j] - gmax);
        const float pg = 1.0f / den;
        float l1 = -3.0e38f, l2 = -3.0e38f; int i1 = 0, i2 = 0;
#pragma unroll
        for (int j = 0; j < 8; ++j) { const float v = r * lg[8 + grp * 8 + j] + A.in[I_BRE][grp * 8 + j];
            if (v > l1) { l2 = l1; i2 = i1; l1 = v; i1 = j; } else if (v > l2) { l2 = v; i2 = j; } }
        const float e1w = 1.0f / (1.0f + __expf(l2 - l1)); const float w1 = e1w * pg, w2 = (1.0f - e1w) * pg;
        const int e1 = grp * 8 + i1, e2 = grp * 8 + i2;
        const size_t dofs = dummy ? (size_t)(WS_END - WS_LTOK) / 4 : 0;
        const int p1 = (int)atomicAdd(F.ctl + CW_CNT + (dummy ? 2048 : 0) + 16 * e1, 1u), p2 = (int)atomicAdd(F.ctl + CW_CNT + (dummy ? 2048 : 0) + 16 * e2, 1u);
        F.LTOK()[dofs + e1 * CAP + p1] = tt; F.LR()[dofs + e1 * CAP + p1] = r; F.LW()[dofs + e1 * CAP + p1] = w1;
        F.LTOK()[dofs + e2 * CAP + p2] = tt; F.LR()[dofs + e2 * CAP + p2] = r; F.LW()[dofs + e2 * CAP + p2] = w2;
        ((i32x4*)((int*)F.TINFO() + dofs))[tt] = (i32x4){e1, p1, e2, p2};
    }
    PT_MARK(52, 1);
    __syncthreads();
}

template <int NPN, bool GU>
__device__ __forceinline__ int moe_setup(Frame& F) {
    LAS int* ud = (LAS int*)(F.lds + L_UD);
    if (F.wave == 0) { const int lane = lane_id();
        const int cnt = (int)__hip_atomic_load(F.ctl + CW_CNT + 16 * lane, __ATOMIC_RELAXED, __HIP_MEMORY_SCOPE_AGENT), nt = (cnt + 255) >> 8;
        int sc = cnt, st = nt;
#pragma unroll
        for (int o = 1; o < 64; o <<= 1) { const int a = __shfl_up(sc, o), b = __shfl_up(st, o); if (lane >= o) { sc += a; st += b; } }
        const int es_e = sc - cnt, ts_e = st - nt, ntiles = __shfl(st, 63);
#pragma unroll
        for (int i = 0; i < 8; ++i) { const long L = (long)i * F.G + F.vcu; const bool ok = L < (long)ntiles * NPN; const int rt = ok ? (int)(L / NPN) : 0, pn = (int)(L % NPN);
            const unsigned long long m = __ballot(ts_e <= rt && rt < ts_e + nt); const int e = m ? (int)__builtin_ctzll(m) : 0;
            const int tile = rt - __shfl(ts_e, e), ce = __shfl(cnt, e), rs = __shfl(es_e, e) + 256 * tile; int nv = ce - 256 * tile; nv = nv > 256 ? 256 : nv;
            if (lane == 0) { ud[i * 8 + 0] = e; ud[i * 8 + 1] = pn; ud[i * 8 + 2] = nv; ud[i * 8 + 3] = rs; ud[i * 8 + 4] = tile; ud[i * 8 + 5] = ok ? 1 : 0; } }
    }
    __syncthreads();
    int nunits = 0;
#pragma unroll
    for (int i = 0; i < 8; ++i) nunits += ud[i * 8 + 5];
    LAS unsigned* tab = (LAS unsigned*)(F.lds + L_TAB);
    for (int idx = F.tid; idx < nunits * 256; idx += NWAVES * 64) { const int i = idx >> 8, rr = idx & 255; const int e = ud[i * 8 + 0], nv = ud[i * 8 + 2], tile = ud[i * 8 + 4];
        const int pos = 256 * tile + (rr < nv ? rr : nv - 1);
        if (GU) { tab[idx] = (unsigned)F.LTOK()[e * CAP + pos] * (unsigned)DM;   ((LAS float*)tab)[1024 + idx] = F.LR()[e * CAP + pos]; }
        else ((LAS float*)tab)[idx] = rr < nv ? F.LW()[e * CAP + pos] : 0.f; }
    __syncthreads();
    return nunits;
}

__device__ __forceinline__ void final_row(Frame& F, const Args& A, int t, LAS const int* es, const int lane) {
    const i32x4 ti = F.TINFO()[t];
    const size_t s1 = (size_t)(es[ti.x] + ti.y), s2 = (size_t)(es[ti.z] + ti.w);
    const u32x2* hr = (const u32x2*)(F.H1B() + (size_t)t * DM) + lane; const u32x2* y1 = (const u32x2*)(F.Y() + s1 * DM) + lane; const u32x2* y2 = (const u32x2*)(F.Y() + s2 * DM) + lane;
    const f32x4* gr = (const f32x4*)A.in[I_NFIN] + lane;
    f32x4 v[8]; float s = 0.f;
#pragma unroll
    for (int j = 0; j < 8; ++j) { const u32x2 h = hr[64 * j]; const u32x2 a = y1[64 * j], b = y2[64 * j];
        v[j].x = bf_lo(h.x) + (bf_lo(a.x) + bf_lo(b.x)); v[j].y = bf_hi(h.x) + (bf_hi(a.x) + bf_hi(b.x)); v[j].z = bf_lo(h.y) + (bf_lo(a.y) + bf_lo(b.y)); v[j].w = bf_hi(h.y) + (bf_hi(a.y) + bf_hi(b.y));
        s += (v[j].x * v[j].x + v[j].y * v[j].y) + (v[j].z * v[j].z + v[j].w * v[j].w); }
    const float r = 1.0f / sqrtf(wave_sum(s) * (1.0f / DM) + RMS_EPS);
    f32x4* o = (f32x4*)(A.out + (size_t)t * DM) + lane;
#pragma unroll
    for (int j = 0; j < 8; ++j) { const f32x4 gg = gr[64 * j]; o[64 * j] = (f32x4){v[j].x * r * gg.x, v[j].y * r * gg.y, v[j].z * r * gg.z, v[j].w * r * gg.w}; }
}

__device__ __forceinline__ void p0_probe(Frame& F, const Args& A) {
#if PROBE_SUB > 0
    if (F.vcu < PROBE_SUB) { CvtJob job{A.in[I_WG], A.in[I_WU], A.in[I_WD], A.in[I_NFFN], F.WGU(), F.WD(), F.vcu * (CVT_ITEMS / PROBE_SUB), CVT_ITEMS / PROBE_SUB, 0, F.wave, F.lds + L_CVT + F.wave * 2048}; cvt_run(job, F.lane); }
#endif
}
__device__ __forceinline__ void p1_phase(Frame& F, const Args& A, int c) {
    if (c < 10) meta_proj_task(F, c * 8 + F.wave);
    if (c >= 10 && c < 42) {
        FoldOrder S{(const char*)F.WPT(), (const char*)F.PMS(), c - 10}; EpiFold E{F.WAB()};
        pg8::gemm_phase<EpiFold, FoldOrder, false>(F.lds + RING_OFF, 1024, 256, 256, S, E, nullptr);
    }
    CvtJob job{A.in[I_WG], A.in[I_WU], A.in[I_WD], A.in[I_NFFN], F.WGU(), F.WD(), 0, 0, 0, F.wave, F.lds + L_CVT + F.wave * 2048};
    if (c < 64) { job.first = c * 18; job.count = 18; job.slot = c % 7; } else { job.first = 1152 + (c - 64) * 26; job.count = 26; job.slot = (c - 64) % 6; }
#if PROBE_SUB > 0
    job.count = 0;
#endif
    PT_MARK(30, 0);
    { DenseOrder S{(const char*)F.HN(), (const char*)(F.WIN() + (size_t)UOFF * 2048), 64, 4, 256, F.G, c, 2048, 2048}; EpiProj E{F.PROJ(), job, F.lane, UOFF};
      pg8::gemm_phase<EpiProj, DenseOrder, false>(F.lds + RING_OFF, 2048, 2048, 2048, S, E, nullptr); }
    PT_MARK(30, 1); PT_MARK(31, 0);
    { DenseOrder S{(const char*)F.HN8(), (const char*)F.WIN8(), 64, 21, 1344, F.G, c, 1024, 1024}; EpiGate E{F.GATE(), F.PROJ(), job, F.lane, 1};
      pg8::gemm_phase<EpiGate, DenseOrder, false, false, true>(F.lds + RING_OFF, 1024, 1024, 1024, S, E, nullptr); PT_MARK(31, 1); }
}
__device__ __forceinline__ void p2_phase(Frame& F, const Args& A) { const int idx = F.vcu; if (idx < 256) attn_unit(F, A, idx >> 7, (idx >> 1) & 63, idx & 1); }
__device__ __forceinline__ void p3_phase(Frame& F, int c) {
    DenseOrder S{(const char*)F.AP(), (const char*)F.WAB(), 64, 8, 512, F.G, c, 2048, 2048}; EpiBranch E{F.GATE(), F.MERGED()};
    pg8::gemm_phase<EpiBranch, DenseOrder, false>(F.lds + RING_OFF, 2048, 2048, 2048, S, E, nullptr);
}
__device__ __forceinline__ void p4_phase(Frame& F, const Args& A, int c) {
    DenseOrder S{(const char*)F.MERGED(), (const char*)F.WO(), 64, 8, 512, F.G, c, 2048, 2048}; EpiOut E{A.in[I_X], F.H1B(), F.SSQ(), F.H8()};
    pg8::gemm_phase<EpiOut, DenseOrder, false>(F.lds + RING_OFF, 2048, 2048, 2048, S, E, nullptr);
}
__device__ __forceinline__ void p6_phase(Frame& F) {
    const int nu = moe_setup<4, true>(F);
    MoeOrder S{(LAS const int*)(F.lds + L_UD), nu, (const char*)F.H8(), (const char*)F.WGU(), 0, (size_t)1024 * 2048, (size_t)256 * 2048};
    EpiGU E{F.HID(), (LAS const float*)(F.lds + L_TAB) + 1024};
    pg8::gemm_phase<EpiGU, MoeOrder, true, false, true>(F.lds + RING_OFF, 1024, 1024, 1024, S, E, (LAS const unsigned*)(F.lds + L_TAB));
}
__device__ __forceinline__ void p7_phase(Frame& F) {
    const int nu = moe_setup<8, false>(F);
    MoeOrder S{(LAS const int*)(F.lds + L_UD), nu, (const char*)F.HID(), (const char*)F.WD(), (size_t)DEXP, (size_t)2048 * 512, (size_t)256 * 512};
    EpiDown E{F.Y(), (LAS const float*)(F.lds + L_TAB)};
    pg8::gemm_phase<EpiDown, MoeOrder, false, false, true>(F.lds + RING_OFF, 256, 256, 256, S, E, nullptr);
}
__device__ __forceinline__ void p8_phase(Frame& F, const Args& A) {
    LAS int* es = (LAS int*)(F.lds + L_ESTART);
    if (F.wave == 0) { const int ln = lane_id(); const int cnt = (int)__hip_atomic_load(F.ctl + CW_CNT + 16 * ln, __ATOMIC_RELAXED, __HIP_MEMORY_SCOPE_AGENT); int sc = cnt;
#pragma unroll
        for (int o = 1; o < 64; o <<= 1) { const int a = __shfl_up(sc, o); if (ln >= o) sc += a; }
        es[ln] = sc - cnt; }
    __syncthreads();
    const int lane = lane_id();
    for (int t = F.vcu * NWAVES + F.wave; t < M; t += F.G * NWAVES) final_row(F, A, t, es, lane);
}

__global__ void __launch_bounds__(NWAVES * 64, 2) mega_fwd(Args args) {
    extern __shared__ __attribute__((aligned(16))) unsigned char lds_raw[];
    Frame F;
    F.lds = (LAS unsigned char*)lds_raw;
    F.MISC = (volatile LAS unsigned*)(F.lds + L_MISC);
    F.tid = threadIdx.x; F.lane = F.tid & 63; F.wave = __builtin_amdgcn_readfirstlane(F.tid >> 6);
    F.G = gridDim.x; { const int bx = blockIdx.x; F.vcu = (F.G % 8 == 0) ? (bx % 8) * (F.G / 8) + bx / 8 : bx; }
    unsigned char* ws = args.ws;
    F.ctl = (unsigned*)(ws + WS_CTL);
    F.ws = ws;
    for (int u = F.tid; u < (LDS_BYTES - RING_BYTES) / 4; u += NWAVES * 64) ((LAS unsigned*)(F.lds + RING_BYTES))[u] = 0u;
    __syncthreads();
#if MK_LAUNCHES == 1
    XcdBarrier bar = xcd_barrier_post((unsigned*)(F.ctl + CW_BAR), F.MISC + 8);
#define GRID_BAR() xcd_barrier(bar)
#else
#define GRID_BAR() do { } while (0)
#endif
    const int lo = args.ph_lo, hi = args.ph_hi;
#define IN(k) (lo <= (k) && (k) < hi)
#define BOTH(k) (IN(k) && IN((k) + 1))
#define DUP(k) (PROBE_DUP == (k))
    const int c = (int)blockIdx.x;

    PT_MARK(0, 0);
    if (IN(0)) { p0_prologue(F, args); p0_probe(F, args); if (DUP(0)) { GRID_BAR(); p0_prologue(F, args); } if (BOTH(0)) GRID_BAR(); }
    PT_MARK(0, 1);
    PT_MARK(1, 0);
    if (IN(1)) { p1_phase(F, args, c); if (DUP(1)) { GRID_BAR(); p1_phase(F, args, c); } if (BOTH(1)) GRID_BAR(); }
    PT_MARK(1, 1);
    PT_MARK(2, 0);
    if (IN(2)) { p2_phase(F, args); if (DUP(2)) { GRID_BAR(); p2_phase(F, args); } if (BOTH(2)) GRID_BAR(); }
    PT_MARK(2, 1);
    PT_MARK(3, 0);
    if (IN(3)) { p3_phase(F, c); if (DUP(3)) { GRID_BAR(); p3_phase(F, c); } if (BOTH(3)) GRID_BAR(); }
    PT_MARK(3, 1);
    PT_MARK(4, 0);
    if (IN(4)) { p4_phase(F, args, c); if (DUP(4)) { GRID_BAR(); p4_phase(F, args, c); } if (BOTH(4)) GRID_BAR(); }
    PT_MARK(4, 1);
    PT_MARK(5, 0);
    if (IN(5)) { if (F.vcu < M / 64) router_group(F, args, F.vcu); if (DUP(5)) { GRID_BAR(); if (F.vcu < M / 64) router_group(F, args, F.vcu, 1); } if (BOTH(5)) GRID_BAR(); }
    PT_MARK(5, 1);
    PT_MARK(6, 0);
    if (IN(6)) { p6_phase(F); if (DUP(6)) { GRID_BAR(); p6_phase(F); } if (BOTH(6)) GRID_BAR(); }
    PT_MARK(6, 1);
    PT_MARK(7, 0);
    if (IN(7)) { p7_phase(F); if (DUP(7)) { GRID_BAR(); p7_phase(F); } if (BOTH(7)) GRID_BAR(); }
    PT_MARK(7, 1);
    PT_MARK(8, 0);
    if (IN(8)) { p8_phase(F, args); if (DUP(8)) { GRID_BAR(); p8_phase(F, args); } }
    PT_MARK(8, 1);
#if PROBE_TIME >= 0
    if (blockIdx.x == 0 && F.tid == 0) { const unsigned long long pt0 = ((unsigned long long)F.MISC[33] << 32) | F.MISC[32], pt1 = ((unsigned long long)F.MISC[35] << 32) | F.MISC[34];
        const unsigned long long te = __builtin_amdgcn_s_memrealtime(), d = 4ull * (pt1 - pt0); while (__builtin_amdgcn_s_memrealtime() - te < d) __builtin_amdgcn_s_sleep(8); }
#endif
#undef IN
#undef BOTH
#undef DUP
}

extern "C" void kernel_launch(void* const* d_in, const int* in_sizes, int n_in, void* d_out, int out_size, void* d_ws, size_t ws_size, hipStream_t stream) {
    static int grid = 0;
    if (grid == 0) {
        if (n_in != 20 || out_size != M * DM || ws_size < WS_END + (PROBE_DUP == 5 ? 16 * MiB : 0)) { fprintf(stderr, "kernel_launch: unexpected shapes (n_in %d, out %d, ws %zu); nothing launched\n", n_in, out_size, ws_size); grid = -1; return; }
        int dev = 0, cus = 0, per_cu = 0;
        if (hipGetDevice(&dev) != hipSuccess || hipDeviceGetAttribute(&cus, hipDeviceAttributeMultiprocessorCount, dev) != hipSuccess) { grid = -1; return; }
        if (hipFuncSetAttribute((const void*)mega_fwd, hipFuncAttributeMaxDynamicSharedMemorySize, LDS_BYTES) != hipSuccess) { fprintf(stderr, "kernel_launch: hipFuncSetAttribute failed\n"); grid = -1; return; }
        if (hipOccupancyMaxActiveBlocksPerMultiprocessor(&per_cu, (const void*)mega_fwd, NWAVES * 64, LDS_BYTES) != hipSuccess || per_cu < 1) { fprintf(stderr, "kernel_launch: occupancy query says %d\n", per_cu); }
        (void)hipGetLastError();
        grid = cus;
        if (grid != 256) { fprintf(stderr, "kernel_launch: built for 256 CUs, device has %d; nothing launched\n", grid); grid = -1; return; }
    }
    if (grid < 0) return;
    (void)hipMemsetAsync((char*)d_ws + WS_CTL, 0, CTL_ZERO_BYTES, stream);
    Args a{};
    for (int i = 0; i < 20; ++i) a.in[i] = (const float*)d_in[i];
    a.out = (float*)d_out; a.ws = (unsigned char*)d_ws;
#if MK_LAUNCHES == 1
    a.ph_lo = 0; a.ph_hi = NPHASE;
    hipLaunchKernelGGL(mega_fwd, dim3(grid), dim3(NWAVES * 64), LDS_BYTES, stream, a);
#else
    for (int p = 0; p < NPHASE; ++p) { a.ph_lo = p; a.ph_hi = p + 1; hipLaunchKernelGGL(mega_fwd, dim3(grid), dim3(NWAVES * 64), LDS_BYTES, stream, a); }
#endif
}
```

```cpp
#include <hip/hip_runtime.h>
#include <cstdio>
#include <cstdint>

#define GAS __attribute__((address_space(1)))
#define LAS __attribute__((address_space(3)))
typedef unsigned short bf16;
typedef short bf16x8 __attribute__((ext_vector_type(8)));
typedef float f32x2 __attribute__((ext_vector_type(2)));
typedef float f32x4 __attribute__((ext_vector_type(4)));
typedef float f32x16 __attribute__((ext_vector_type(16)));
typedef unsigned u32x2 __attribute__((ext_vector_type(2)));
typedef unsigned u32x4 __attribute__((ext_vector_type(4)));
typedef int i32x4 __attribute__((ext_vector_type(4)));

#ifndef MK_LAUNCHES
#define MK_LAUNCHES 1
#endif
#ifndef PROBE_DUP
#define PROBE_DUP -1
#endif
#ifndef PROBE_SUB
#define PROBE_SUB 0
#endif
#define PROBE_SET(b) ((b) >= 0 && (b) < 1)
#ifndef PROBE_TIME
#define PROBE_TIME -1
#endif
constexpr int NPHASE = 9;

constexpr int DM = 2048, SEQ = 8192, M = 16384;
constexpr int NMETA = 16, MROWS = M + 256;
constexpr int INW = 6400, KOFF = 1024, VOFF = 1152, UOFF = 1280, GAOFF = 2304, GPOFF = 4352;
constexpr int PW = 2304, GW = 4096;
constexpr int NEXP = 64, DEXP = 512, CAP = 16384;
constexpr float RMS_EPS = 1e-6f;

constexpr size_t MiB = 1u << 20;
constexpr size_t WS_CTL = 0, CTL_ZERO_BYTES = 1 * MiB;
constexpr size_t WS_WIN = 1 * MiB;
constexpr size_t WS_WAB = 26 * MiB;
constexpr size_t WS_WPT = 34 * MiB;
constexpr size_t WS_WO = 38 * MiB;
constexpr size_t WS_PMS = 46 * MiB;
constexpr size_t WS_WR = 46 * MiB + 512 * 1024;
constexpr size_t WS_SSQ = 47 * MiB;
constexpr size_t WS_LTOK = 49 * MiB, WS_LR = 53 * MiB, WS_LW = 57 * MiB;
constexpr size_t WS_TINFO = 61 * MiB;
constexpr size_t WS_WGU = 64 * MiB;
constexpr size_t WS_WIN8 = 13 * MiB;
constexpr size_t WS_HN8 = 416 * MiB;
constexpr size_t WS_H8 = 384 * MiB;
constexpr size_t WS_WD = 320 * MiB;
constexpr size_t WS_HN = 448 * MiB;
constexpr size_t WS_PROJ = 513 * MiB;
constexpr size_t WS_GATE = 593 * MiB;
constexpr size_t WS_AP = 717 * MiB;
constexpr size_t WS_H1 = 781 * MiB;
constexpr size_t WS_END = 909 * MiB;
constexpr int CW_TMO = 0, CW_CNT = 1024  , CW_BAR = 4096;

constexpr int RING_BYTES = 131072, RING_OFF = 512;
constexpr int L_MISC = RING_OFF + RING_BYTES;
constexpr int L_ESTART = L_MISC + 256;
constexpr int L_TSTART = L_ESTART + 320;
constexpr int L_UD = L_TSTART + 320;
constexpr int L_TAB = L_UD + 256;
constexpr int L_CVT = L_TAB + 8192;
constexpr int LDS_BYTES = 157696;
static_assert(L_CVT + 16384 <= LDS_BYTES && LDS_BYTES <= 163840, "LDS map");

#define LDS_WAIT() asm volatile("s_waitcnt lgkmcnt(0)" ::: "memory")
#define VM_WAIT() asm volatile("s_waitcnt vmcnt(0)" ::: "memory")
__device__ __forceinline__ unsigned cvt_pk_bf16(float lo, float hi) { unsigned r; asm volatile("v_cvt_pk_bf16_f32 %0, %1, %2" : "=v"(r) : "v"(lo), "v"(hi)); return r; }
__device__ __forceinline__ float bf_lo(unsigned w) { return __uint_as_float(w << 16); }
__device__ __forceinline__ float bf_hi(unsigned w) { return __uint_as_float(w & 0xffff0000u); }
__device__ __forceinline__ float sigmoidf_(float x) { return __builtin_amdgcn_rcpf(1.0f + __expf(-x)); }

namespace pg8 {
constexpr int BM = 256, BK = 64, HALF = 128, HTB = HALF * BK * 2, STAGE_BYTES = 8 * HTB, NXCD = 8, WGM = 8;
__host__ __device__ __forceinline__ int lds_byte(int r, int c) { const int st = (r >> 4) * 2 + (c >> 5), rr = r & 15, cc = c & 31, ob = rr * 64 + cc * 2; return st * 1024 + (ob ^ (((ob >> 9) & 1) << 5)); }
__host__ __device__ __forceinline__ void stage_rc(int b, int& R, int& C) { const int st = b / 1024, sb = b % 1024, swz = sb ^ (((sb >> 9) & 1) << 5); R = (st >> 1) * 16 + swz / 64; C = (st & 1) * 32 + (swz % 64) / 2; }
__host__ __device__ __forceinline__ int perm32(int rho) { const int n = rho >> 4, i = rho & 15; return 8 * (i >> 2) + 4 * n + (i & 3); }

struct Unit { const char* a; const char* b; int pm, pn, x0, x1; };

__device__ __forceinline__ void tile_of(int L, int nM, int nN, int& pm, int& pn) {
    const int nwg = nM * nN; int wgid = L;
    { const int q = nwg / NXCD, r = nwg % NXCD, xcd = wgid % NXCD, off = wgid / NXCD; wgid = (xcd < r ? xcd * (q + 1) : r * (q + 1) + (xcd - r) * q) + off; }
    const int nig = WGM * nN, gid = wgid / nig, fm = gid * WGM, gsz = (nM - fm) < WGM ? (nM - fm) : WGM;
    pm = fm + ((wgid % nig) % gsz); pn = (wgid % nig) / gsz;
}

typedef int i32x8 __attribute__((ext_vector_type(8)));
template <class Epi, class Sched, bool GATHER, bool HALFSKIP = false, bool FP8 = false>
__device__ __forceinline__ void gemm_phase(const int wid  , LAS unsigned char* lds, const int lda, const int ldb, const int K, const Sched& S, const Epi& E, LAS const unsigned* rowtab  ) {
    int lane = (int)__builtin_amdgcn_mbcnt_hi(~0u, __builtin_amdgcn_mbcnt_lo(~0u, 0u)); asm volatile("" : "+v"(lane));
    const int tid = wid * 64 + lane, wr = wid >> 2, wc = wid & 3, fr = lane & 15, fq = lane >> 4;
    const int nt = K / BK;
    unsigned voffB[2], voffBh[2], cv0[2], cv1[2], nv0[2], nv1[2]; int Rr[2]; unsigned Cc[2];
#pragma unroll
    for (int i = 0; i < 2; ++i) { int R, C; stage_rc(tid * 16 + i * 8192, R, C); const int Rb = (R & ~31) + perm32(R & 31);
        voffB[i] = (unsigned)(Rb * ldb + C) * 2u; voffBh[i] = voffB[i] + (unsigned)(HALF * ldb) * 2u; Rr[i] = R; Cc[i] = (unsigned)C * 2u;
        cv0[i] = (unsigned)(R * lda + C) * 2u; cv1[i] = cv0[i] + (unsigned)(HALF * lda) * 2u; nv0[i] = cv0[i]; nv1[i] = cv1[i]; }
    const size_t kstep = (size_t)(BK * 2);
    const unsigned ldsw = (unsigned)wid * 1024u;
    const int aoff = lds_byte(wr * 64 + fr, fq * 8), boff = lds_byte(wc * 32 + fr, fq * 8);
#define PG8_SA(b, h) (((b) * 2 + (h)) * HTB)
#define PG8_SB(b, h) ((4 + (b) * 2 + (h)) * HTB)
#define PG8_STAGE2O(bufoff, gbase, v0, v1, OFF) do { \
        __builtin_amdgcn_global_load_lds((const unsigned*)((const char*)(gbase) + (v0)), (LAS unsigned*)(lds + ((bufoff) - (OFF)) + ldsw), 16, OFF, 0); \
        __builtin_amdgcn_global_load_lds((const unsigned*)((const char*)(gbase) + (v1)), (LAS unsigned*)(lds + ((bufoff) - (OFF)) + ldsw + 8192), 16, OFF, 0); } while (0)
#define PG8_STAGE2(bufoff, gbase, v0, v1) PG8_STAGE2O(bufoff, gbase, v0, v1, 0)
#define PG8_STAGEB(bufoff, gbase) PG8_STAGE2(bufoff, gbase, voffB[0], voffB[1])
#define PG8_STAGEBO(bufoff, gbase, OFF) PG8_STAGE2O(bufoff, gbase, voffB[0], voffB[1], OFF)
#define PG8_STAGEBH(bufoff, gbase, OFF) PG8_STAGE2O(bufoff, gbase, voffBh[0], voffBh[1], OFF)
#define PG8_LDA(dst, b, h) do { if constexpr (FP8) { _Pragma("unroll") for (int m = 0; m < 4; ++m) dst##8[m] = *(const LAS i32x8*)(lds + PG8_SA(b, h) + aoff8 + m * 2048); } \
        else { _Pragma("unroll") for (int m = 0; m < 4; ++m) _Pragma("unroll") for (int k = 0; k < 2; ++k) dst[m][k] = *(const LAS bf16x8*)(lds + PG8_SA(b, h) + aoff + m * 2048 + k * 1024); } } while (0)
#define PG8_LDB(dst, b, h) do { if constexpr (FP8) { _Pragma("unroll") for (int n = 0; n < 2; ++n) dst##8[n] = *(const LAS i32x8*)(lds + PG8_SB(b, h) + boff8 + n * 2048); } \
        else { _Pragma("unroll") for (int n = 0; n < 2; ++n) _Pragma("unroll") for (int k = 0; k < 2; ++k) dst[n][k] = *(const LAS bf16x8*)(lds + PG8_SB(b, h) + boff + n * 2048 + k * 1024); } } while (0)
#define PG8_MMA(ai, bj, At, Bt) do { __builtin_amdgcn_s_setprio(1); \
        if constexpr (FP8) { _Pragma("unroll") for (int m = 0; m < 4; ++m) _Pragma("unroll") for (int n = 0; n < 2; ++n) \
            asm volatile("v_mfma_scale_f32_16x16x128_f8f6f4 %0, %1, %2, %0, %3, %3 op_sel_hi:[0,0,0]" : "+v"(acc[ai][bj][m][n]) : "v"(Bt##8[n]), "v"(At##8[m]), "v"(mxscale)); } \
        else { _Pragma("unroll") for (int m = 0; m < 4; ++m) _Pragma("unroll") for (int n = 0; n < 2; ++n) _Pragma("unroll") for (int k = 0; k < 2; ++k) \
            acc[ai][bj][m][n] = __builtin_amdgcn_mfma_f32_16x16x32_bf16(Bt[n][k], At[m][k], acc[ai][bj][m][n], 0, 0, 0); } __builtin_amdgcn_s_setprio(0); } while (0)
#define PG8_WAIT_V(n) asm volatile("s_waitcnt vmcnt(" #n ")" ::: "memory")
#define PG8_WAIT_L(n) asm volatile("s_waitcnt lgkmcnt(" #n ")" ::: "memory")
#define PG8_BAR __builtin_amdgcn_s_barrier()
#define PG8_SCHED __builtin_amdgcn_sched_barrier(0)
    Unit cur, nxt; int ui = 0;
    if (!S.next(0, cur)) return;
    if constexpr (GATHER) {
#pragma unroll
        for (int i = 0; i < 2; ++i) { cv0[i] = rowtab[Rr[i]] + Cc[i]; cv1[i] = rowtab[HALF + Rr[i]] + Cc[i]; }
    }
    f32x4 acc[2][2][4][2];
#pragma unroll
    for (int a = 0; a < 2; ++a)
#pragma unroll
        for (int b = 0; b < 2; ++b)
#pragma unroll
            for (int m = 0; m < 4; ++m)
#pragma unroll
                for (int n = 0; n < 2; ++n) acc[a][b][m][n] = (f32x4){0.f, 0.f, 0.f, 0.f};
    bf16x8 At[4][2], B0[2][2], B1[2][2];
    i32x8 At8[4], B08[2], B18[2];
    const int mxscale = 0x7f7f7f7f;
    const int aoff8 = ((fq >> 1) * 1024) + (((wr * 64 + fr) & 15) * 64 + (fq & 1) * 32 ^ (((((wr * 64 + fr) & 15) * 64) >> 9) & 1) << 5) + (((wr * 64 + fr) >> 4) * 2048);
    const int boff8 = ((fq >> 1) * 1024) + (((wc * 32 + fr) & 15) * 64 + (fq & 1) * 32 ^ (((((wc * 32 + fr) & 15) * 64) >> 9) & 1) << 5) + (((wc * 32 + fr) >> 4) * 2048);
    const char* cA = cur.a; const char* cB = cur.b;
    PG8_STAGEBO(PG8_SB(0, 0), cB, 0); PG8_STAGEBH(PG8_SB(0, 1), cB, 0); PG8_STAGE2(PG8_SA(0, 0), cA, cv0[0], cv0[1]); PG8_STAGE2(PG8_SA(0, 1), cA, cv1[0], cv1[1]);
    if (wr == 1) PG8_BAR;
    PG8_WAIT_V(2); PG8_BAR;
    PG8_STAGEBO(PG8_SB(1, 0), cB, 128); PG8_STAGE2O(PG8_SA(1, 0), cA, cv0[0], cv0[1], 128); PG8_STAGEBH(PG8_SB(1, 1), cB, 128);
    PG8_WAIT_V(6); PG8_BAR;
    for (;;) {
        const bool has_next = S.next(ui + 1, nxt);
        const bool skip_hi = HALFSKIP && cur.x0 <= 128;
        const char* nA = has_next ? nxt.a : cA; const char* nB = has_next ? nxt.b : cB;
        if constexpr (GATHER) {
            if (has_next) {
#pragma unroll
                for (int i = 0; i < 2; ++i) { nv0[i] = rowtab[(ui + 1) * 256 + Rr[i]] + Cc[i]; nv1[i] = rowtab[(ui + 1) * 256 + HALF + Rr[i]] + Cc[i]; }
            } else {
#pragma unroll
                for (int i = 0; i < 2; ++i) { nv0[i] = cv0[i]; nv1[i] = cv1[i]; }
            }
        }
#pragma unroll 1
        for (int t = 0; t < nt; t += 2) {
            const bool last = (t == nt - 2);
            if constexpr (Epi::HAS_MID) { if (t == Epi::MID_T) E.mid(acc, cur, wr, wc, fr, fq); }
            const char* pA = cA + (size_t)t * kstep; const char* pB = cB + (size_t)t * kstep;
            const char* qA = last ? nA - 256 : pA; const char* qB = last ? nB - 256 : pB;
            unsigned x00, x01, x10, x11;
            if constexpr (GATHER) { x00 = last ? nv0[0] : cv0[0]; x01 = last ? nv0[1] : cv0[1]; x10 = last ? nv1[0] : cv1[0]; x11 = last ? nv1[1] : cv1[1]; }
            else { x00 = cv0[0]; x01 = cv0[1]; x10 = cv1[0]; x11 = cv1[1]; }
            PG8_LDB(B0, 0, 0); PG8_LDB(B1, 0, 1); PG8_SCHED; PG8_LDA(At, 0, 0); PG8_STAGE2O(PG8_SA(1, 1), pA, cv1[0], cv1[1], 128);
            PG8_WAIT_V(8); PG8_WAIT_L(0); PG8_BAR; PG8_MMA(0, 0, At, B0); PG8_MMA(0, 1, At, B1); PG8_BAR; PG8_SCHED;
            PG8_LDA(At, 0, 1); PG8_STAGEBO(PG8_SB(0, 0), qB, 256); PG8_STAGEBH(PG8_SB(0, 1), qB, 256); PG8_STAGE2O(PG8_SA(0, 0), qA, x00, x01, 256);
            PG8_WAIT_V(8); PG8_WAIT_L(0); PG8_BAR; if (!skip_hi) { PG8_MMA(1, 0, At, B0); PG8_MMA(1, 1, At, B1); } PG8_BAR; PG8_SCHED;
            PG8_LDB(B0, 1, 0); PG8_LDB(B1, 1, 1); PG8_SCHED; PG8_LDA(At, 1, 0); PG8_STAGE2O(PG8_SA(0, 1), qA, x10, x11, 256);
            PG8_WAIT_V(8); PG8_WAIT_L(0); PG8_BAR; PG8_MMA(0, 0, At, B0); PG8_MMA(0, 1, At, B1); PG8_BAR; PG8_SCHED;
            PG8_LDA(At, 1, 1); PG8_STAGEBO(PG8_SB(1, 0), qB, 384); PG8_STAGEBH(PG8_SB(1, 1), qB, 384); PG8_STAGE2O(PG8_SA(1, 0), qA, x00, x01, 384);
            PG8_WAIT_V(8); PG8_WAIT_L(0); PG8_BAR; if (!skip_hi) { PG8_MMA(1, 0, At, B0); PG8_MMA(1, 1, At, B1); } PG8_BAR; PG8_SCHED;
        }
        if (wr == 0) PG8_BAR;
        if constexpr (FP8) asm volatile("s_nop 15\n\ts_nop 15" ::: "memory");
        E(acc, cur, ui, wr, wc, fr, fq);
        if constexpr (Epi::HAS_POST) E.post(ui);
        if (!has_next) break;
#pragma unroll
        for (int a = 0; a < 2; ++a)
#pragma unroll
            for (int b = 0; b < 2; ++b)
#pragma unroll
                for (int m = 0; m < 4; ++m)
#pragma unroll
                    for (int n = 0; n < 2; ++n) acc[a][b][m][n] = (f32x4){0.f, 0.f, 0.f, 0.f};
        cur = nxt; cA = nA; cB = nB; ++ui;
        if constexpr (GATHER) {
#pragma unroll
            for (int i = 0; i < 2; ++i) { cv0[i] = nv0[i]; cv1[i] = nv1[i]; }
        }
        if (wr == 1) PG8_BAR;
    }
    PG8_WAIT_V(0);
    PG8_BAR;
#undef PG8_SA
#undef PG8_SB
#undef PG8_STAGE2
#undef PG8_STAGE2O
#undef PG8_STAGEB
#undef PG8_STAGEBO
#undef PG8_STAGEBH
#undef PG8_LDA
#undef PG8_LDB
#undef PG8_MMA
#undef PG8_WAIT_V
#undef PG8_WAIT_L
#undef PG8_BAR
#undef PG8_SCHED
}
}

#define XB_TMO      128
#define XB_XCNT(j)  (256  + 64 * (j))
#define XB_XSUB(j)  (1280 + 64 * (j))
#define XB_XGEN(j)  (2304 + 64 * (j))
#define XB_TOP      3328
#define XB_TOPGEN   3392
#define XCD_BAR_WORDS 3456
#define XB_SPIN_CAP (1u << 18)

__device__ __forceinline__ unsigned xb_ld(unsigned* p)              { return __hip_atomic_load(p, __ATOMIC_RELAXED, __HIP_MEMORY_SCOPE_AGENT); }
__device__ __forceinline__ unsigned xb_add(unsigned* p, unsigned v) { return __hip_atomic_fetch_add(p, v, __ATOMIC_RELAXED, __HIP_MEMORY_SCOPE_AGENT); }
__device__ __forceinline__ unsigned xb_xcc_id() { return (unsigned)__builtin_amdgcn_s_getreg((3 << 11) | 20) & 0xFu; }
#define XB_SPIN(cond, bar) do { unsigned _sp = 0; while (cond) { __builtin_amdgcn_s_sleep(1); \
    if ((++_sp & 255u) == 0u) { if (xb_ld(&(bar)[XB_TMO])) break; if (_sp > XB_SPIN_CAP) { atomicAdd(&(bar)[XB_TMO], 1u); break; } } } } while (0)

struct XcdBarrier {
    unsigned* bar; unsigned x; unsigned w;
    volatile LAS unsigned* st;
};

__device__ __forceinline__ XcdBarrier xcd_barrier_post(unsigned* bar, volatile LAS unsigned* st) {
    XcdBarrier b; b.bar = bar; b.x = xb_xcc_id(); b.st = st; b.w = (unsigned)__builtin_amdgcn_readfirstlane((int)(threadIdx.x >> 6));
    if (threadIdx.x == 0) (void)xb_add(&bar[XB_XCNT(b.x)], 1u);
    return b;
}
__device__ __forceinline__ void xcd_barrier_complete(unsigned* bar, unsigned x, unsigned& nloc, unsigned& nx) {
    const unsigned G = gridDim.x * gridDim.y * gridDim.z;
    unsigned sum, cnt, mine, sp = 0u;
    for (;;) {
        sum = 0u; cnt = 0u; mine = 0u;
#pragma unroll
        for (unsigned j = 0; j < 16; ++j) { const unsigned c = xb_ld(&bar[XB_XCNT(j)]); sum += c; cnt += (c > 0u) ? 1u : 0u; mine = (j == x) ? c : mine; }
        if (sum == G) break;
        __builtin_amdgcn_s_sleep(1);
        if ((++sp & 255u) == 0u) { if (xb_ld(&bar[XB_TMO])) break; if (sp > XB_SPIN_CAP) { atomicAdd(&bar[XB_TMO], 1u); break; } }
    }
    nloc = mine > 0u ? mine : 1u; nx = cnt > 0u ? cnt : 1u;
}

__device__ __forceinline__ void xcd_barrier(const XcdBarrier& b) {
    asm volatile("s_waitcnt vmcnt(0)" ::: "memory");
    __syncthreads();
    if (b.w == 0u && __builtin_amdgcn_mbcnt_hi(~0u, __builtin_amdgcn_mbcnt_lo(~0u, 0u)) == 0u) {
        unsigned* bar = b.bar;
        __builtin_amdgcn_s_waitcnt(0);
        unsigned nloc = b.st[0], nx = b.st[1];
        if (nloc == 0u) { xcd_barrier_complete(bar, b.x, nloc, nx); b.st[0] = nloc; b.st[1] = nx; }
        const unsigned old = xb_add(&bar[XB_XSUB(b.x)], 1u);
        const unsigned gen = old / nloc;
        if (old + 1u == (gen + 1u) * nloc) {
            __builtin_amdgcn_fence(__ATOMIC_RELEASE, "agent");
            asm volatile("s_waitcnt vmcnt(0)" ::: "memory");
            const unsigned og = xb_add(&bar[XB_TOP], 1u);
            const unsigned tg = og / nx;
            if (og + 1u == (tg + 1u) * nx) xb_add(&bar[XB_TOPGEN], 1u);
            else XB_SPIN(xb_ld(&bar[XB_TOPGEN]) == tg, bar);
            __builtin_amdgcn_fence(__ATOMIC_ACQUIRE, "agent");
            xb_add(&bar[XB_XGEN(b.x)], 1u);
            asm volatile("s_waitcnt vmcnt(0)" ::: "memory");
        } else {
            XB_SPIN(xb_ld(&bar[XB_XGEN(b.x)]) == gen, bar);
            __builtin_amdgcn_fence(__ATOMIC_ACQUIRE, "agent");
            asm volatile("s_waitcnt vmcnt(0)" ::: "memory");
        }
    }
    __syncthreads();
}

constexpr int NWAVES = 8;
#if PROBE_TIME >= 0
#define PT_MARK(k, e) do { if ((k) == PROBE_TIME && PROBE_SET((int)blockIdx.x) && threadIdx.x == 0) { const unsigned long long t_ = __builtin_amdgcn_s_memrealtime(); volatile LAS unsigned* m_ = (volatile LAS unsigned*)(unsigned)L_MISC;        m_[32 + 2 * (e)] = (unsigned)t_; m_[33 + 2 * (e)] = (unsigned)(t_ >> 32); } } while (0)
#else
#define PT_MARK(k, e) do { } while (0)
#endif
struct Args { const float* in[20]; float* out; unsigned char* ws; int ph_lo, ph_hi; };
enum { I_X = 0, I_META, I_RELB, I_NMIX, I_WIN, I_SINK, I_PMIX, I_PSCL, I_WAB, I_WPB, I_WOUT, I_NFFN, I_WRG, I_BRG, I_WRE, I_BRE, I_WG, I_WU, I_WD, I_NFIN };
struct Frame {
    LAS unsigned char* lds;
    volatile LAS unsigned* MISC;
    unsigned* ctl;
    int wave, vcu, G;
    __device__ __forceinline__ int lane() const { int t = (int)__builtin_amdgcn_mbcnt_hi(~0u, __builtin_amdgcn_mbcnt_lo(~0u, 0u)); asm volatile("" : "+v"(t)); return t; }
    __device__ __forceinline__ int tid() const { return wave * 64 + lane(); }
    unsigned char* ws;
#define WSP(name, T, off) __device__ __forceinline__ T* name() const { return (T*)(ws + (off)); }
    WSP(WIN, bf16, WS_WIN) WSP(WAB, bf16, WS_WAB) WSP(WPT, bf16, WS_WPT) WSP(WO, bf16, WS_WO) WSP(PMS, bf16, WS_PMS) WSP(WR, bf16, WS_WR) WSP(WGU, bf16, WS_WGU) WSP(WD, bf16, WS_WD)
    WSP(HN, bf16, WS_HN) WSP(PROJ, bf16, WS_PROJ) WSP(AP, bf16, WS_AP) WSP(MERGED, bf16, WS_HN) WSP(H1B, bf16, WS_AP) WSP(HID, bf16, WS_HN) WSP(Y, bf16, WS_PROJ)
    WSP(SSQ, float, WS_SSQ) WSP(H1, float, WS_H1) WSP(LR, float, WS_LR) WSP(LW, float, WS_LW) WSP(LTOK, int, WS_LTOK) WSP(TINFO, i32x4, WS_TINFO) WSP(GATE, unsigned char, WS_GATE) WSP(H8, unsigned char, WS_H8) WSP(HN8, unsigned char, WS_HN8) WSP(WIN8, unsigned char, WS_WIN8)
#undef WSP
};

__device__ __forceinline__ int lane_id() { return (int)__builtin_amdgcn_mbcnt_hi(~0u, __builtin_amdgcn_mbcnt_lo(~0u, 0u)); }
__device__ __forceinline__ float wave_sum(float v) {
#pragma unroll
    for (int o = 1; o < 64; o <<= 1) v += __shfl_xor(v, o);
    return v;
}

template <bool SCALE>
__device__ __forceinline__ void p0_item(const float* W, int N, int k0, int n0, bf16* WT, int ldt, int wrow0, const float* ks, LAS float* scr, int lane) {
#pragma unroll 8
    for (int i = 0; i < 32; ++i) { const int kk = 2 * i + (lane >> 5); float v = W[(size_t)(k0 + kk) * N + n0 + (lane & 31)]; if constexpr (SCALE) v *= ks[k0 + kk]; scr[kk * 33 + (lane & 31)] = v; }
    LDS_WAIT(); asm volatile("" ::: "memory");
    const int c = lane & 7;
#pragma unroll
    for (int j = 0; j < 4; ++j) { const int n = (lane >> 3) + 8 * j; const LAS float* s = scr + (8 * c) * 33 + n;
        u32x4 o; o.x = cvt_pk_bf16(s[0 * 33], s[1 * 33]); o.y = cvt_pk_bf16(s[2 * 33], s[3 * 33]); o.z = cvt_pk_bf16(s[4 * 33], s[5 * 33]); o.w = cvt_pk_bf16(s[6 * 33], s[7 * 33]);
        *(u32x4*)(WT + (size_t)(wrow0 + n) * ldt + k0 + 8 * c) = o; }
    LDS_WAIT(); asm volatile("" ::: "memory");
}
__device__ __forceinline__ void p0_item8(const float* W, int N, int k0, int n0, unsigned char* WT, int ldt, int wrow0, float scl, LAS float* scr, int lane) {
#pragma unroll 8
    for (int i = 0; i < 32; ++i) { const int kk = 2 * i + (lane >> 5); scr[kk * 33 + (lane & 31)] = W[(size_t)(k0 + kk) * N + n0 + (lane & 31)] * scl; }
    LDS_WAIT(); asm volatile("" ::: "memory");
    const int c = lane & 7;
#pragma unroll
    for (int j = 0; j < 4; ++j) { const int n = (lane >> 3) + 8 * j; const LAS float* s = scr + (8 * c) * 33 + n;
        int p0 = __builtin_amdgcn_cvt_pk_fp8_f32(s[0 * 33], s[1 * 33], 0, false); p0 = __builtin_amdgcn_cvt_pk_fp8_f32(s[2 * 33], s[3 * 33], p0, true);
        int p1 = __builtin_amdgcn_cvt_pk_fp8_f32(s[4 * 33], s[5 * 33], 0, false); p1 = __builtin_amdgcn_cvt_pk_fp8_f32(s[6 * 33], s[7 * 33], p1, true);
        *(u32x2*)(WT + (size_t)(wrow0 + n) * ldt + k0 + 8 * c) = (u32x2){(unsigned)p0, (unsigned)p1}; }
    LDS_WAIT(); asm volatile("" ::: "memory");
}
template <int NR>
__device__ __forceinline__ void rms_rows_to_bf16(const float* const (&xrow)[NR], const float* g, bf16* const (&orow)[NR], unsigned char* const (&o8row)[NR], int lane) {
    const f32x4* gr = (const f32x4*)g + lane;
    f32x4 v[NR][8]; float r[NR];
#pragma unroll
    for (int q = 0; q < NR; ++q) { const f32x4* xr = (const f32x4*)xrow[q] + lane;
#pragma unroll
        for (int j = 0; j < 8; ++j) v[q][j] = xr[64 * j]; }
#pragma unroll
    for (int q = 0; q < NR; ++q) { float s = 0.f;
#pragma unroll
        for (int j = 0; j < 8; ++j) s += (v[q][j].x * v[q][j].x + v[q][j].y * v[q][j].y) + (v[q][j].z * v[q][j].z + v[q][j].w * v[q][j].w);
        r[q] = 1.0f / sqrtf(wave_sum(s) * (1.0f / DM) + RMS_EPS); }
#pragma unroll
    for (int j = 0; j < 8; ++j) { const f32x4 gg = gr[64 * j];
#pragma unroll
        for (int q = 0; q < NR; ++q) { const float y0 = v[q][j].x * r[q] * gg.x, y1 = v[q][j].y * r[q] * gg.y, y2 = v[q][j].z * r[q] * gg.z, y3 = v[q][j].w * r[q] * gg.w;
            u32x2 w; w.x = cvt_pk_bf16(y0, y1); w.y = cvt_pk_bf16(y2, y3); ((u32x2*)orow[q] + lane)[64 * j] = w;
            if (o8row[q]) { const float z0 = __builtin_fminf(__builtin_fmaxf(y0 * 8.0f, -448.0f), 448.0f), z1 = __builtin_fminf(__builtin_fmaxf(y1 * 8.0f, -448.0f), 448.0f), z2 = __builtin_fminf(__builtin_fmaxf(y2 * 8.0f, -448.0f), 448.0f), z3 = __builtin_fminf(__builtin_fmaxf(y3 * 8.0f, -448.0f), 448.0f);
                int p = __builtin_amdgcn_cvt_pk_fp8_f32(z0, z1, 0, false); p = __builtin_amdgcn_cvt_pk_fp8_f32(z2, z3, p, true); ((unsigned*)o8row[q])[lane + 64 * j] = (unsigned)p; } } }
}

struct CvtJob { const float *wg, *wu, *wd, *ks; bf16 *WGU, *WD; int first, count, slot, wave; LAS unsigned char* scr; };
constexpr int CVT_ITEMS = 3 * 2048;
__device__ __forceinline__ void cvt_decode(const CvtJob& J, int q, int wave, const float*& W, int& N, bf16*& WT, int& ldt, int& wrow0, int& k0, bool& scale) {
    const int seg = q >> 11, r = q & 2047, e = r >> 5;
    if (seg < 2) { const int kb = r & 31, n0 = 64 * wave; k0 = 64 * kb; N = 512; ldt = 2048; scale = true;
        W = (seg ? J.wu : J.wg) + (size_t)e * 2048 * 512 + n0; WT = (bf16*)((unsigned char*)J.WGU + (size_t)e * 1024 * 2048); wrow0 = 256 * (n0 >> 7) + (n0 & 127) + (seg ? 128 : 0); }
    else { const int nq = (r >> 3) & 3, kb = r & 7, n0 = 512 * nq + 64 * wave; k0 = 64 * kb; N = 2048; ldt = 512; scale = false;
        W = J.wd + (size_t)e * 512 * 2048 + n0; WT = (bf16*)((unsigned char*)J.WD + (size_t)e * 2048 * 512); wrow0 = n0; }
}
__device__ __forceinline__ void cvt_load(f32x4 (&v)[16], const float* W, int N, int k0, int lane) {
    const float* p = W + (size_t)(k0 + 8 * (lane >> 4)) * N + 4 * (lane & 15);
#pragma unroll
    for (int i = 0; i < 16; ++i) v[i] = __builtin_nontemporal_load((const f32x4*)(p + (size_t)(i + (i >> 3) * 24) * N));
}
__device__ __forceinline__ void cvt_store(const f32x4 (&v)[16], bf16* WT, int ldt, int wrow0, int k0, const float* ks, bool scale, LAS unsigned char* scr  , int lane) {
    const int nl = lane & 15, kg = lane >> 4, kq = k0 + 8 * kg;
    float s[16];
    if (scale) {
#pragma unroll
        for (int i = 0; i < 4; ++i) { const f32x4 t = *(const f32x4*)(ks + kq + 4 * (i & 1) + 32 * (i >> 1)); s[4 * i] = t.x; s[4 * i + 1] = t.y; s[4 * i + 2] = t.z; s[4 * i + 3] = t.w; }
    } else {
#pragma unroll
        for (int i = 0; i < 16; ++i) s[i] = 1.0f;
    }
    LAS unsigned char* wp0 = scr + 128 * nl + 16 * (kg ^ (nl & 7)); LAS unsigned char* wp1 = scr + 128 * nl + 16 * ((4 + kg) ^ (nl & 7));
    const int R = lane >> 3, p = lane & 7;
    LAS const unsigned char* rp = scr + 128 * R + 16 * (p ^ (R & 7));
#pragma unroll
    for (int j = 0; j < 4; ++j) {
        u32x4 o0, o1;
        o0.x = cvt_pk_bf16(v[0][j] * s[0], v[1][j] * s[1]); o0.y = cvt_pk_bf16(v[2][j] * s[2], v[3][j] * s[3]); o0.z = cvt_pk_bf16(v[4][j] * s[4], v[5][j] * s[5]); o0.w = cvt_pk_bf16(v[6][j] * s[6], v[7][j] * s[7]);
        o1.x = cvt_pk_bf16(v[8][j] * s[8], v[9][j] * s[9]); o1.y = cvt_pk_bf16(v[10][j] * s[10], v[11][j] * s[11]); o1.z = cvt_pk_bf16(v[12][j] * s[12], v[13][j] * s[13]); o1.w = cvt_pk_bf16(v[14][j] * s[14], v[15][j] * s[15]);
        *(LAS u32x4*)wp0 = o0; *(LAS u32x4*)wp1 = o1;
        LDS_WAIT();
        const u32x4 a = *(LAS const u32x4*)rp, b = *(LAS const u32x4*)(rp + 1024);
        LDS_WAIT();
        bf16* dst = WT + (size_t)(wrow0 + 4 * R + j) * ldt + k0 + 8 * p;
        __builtin_nontemporal_store(a, (u32x4*)dst); __builtin_nontemporal_store(b, (u32x4*)(dst + (size_t)32 * ldt));
    }
}
__device__ __forceinline__ void cvt_store8(const f32x4 (&v)[16], unsigned char* WT, int ldt, int wrow0, int k0, const float* ks  , float scl, LAS unsigned char* scr, int lane) {
    const int nl = lane & 15, kg = lane >> 4, R = lane >> 2, p = lane & 3, kq = k0 + 8 * kg;
    float s[16];
    if (ks) {
#pragma unroll
        for (int i = 0; i < 4; ++i) { const f32x4 t = *(const f32x4*)(ks + kq + 4 * (i & 1) + 32 * (i >> 1)); s[4 * i] = t.x * scl; s[4 * i + 1] = t.y * scl; s[4 * i + 2] = t.z * scl; s[4 * i + 3] = t.w * scl; }
    } else {
#pragma unroll
        for (int i = 0; i < 16; ++i) s[i] = scl;
    }
    LAS unsigned char* wp = scr + 80 * nl + 8 * kg; LAS const unsigned char* rp = scr + 80 * R + 16 * p;
#pragma unroll
    for (int j = 0; j < 4; ++j) {
        int a0 = __builtin_amdgcn_cvt_pk_fp8_f32(v[0][j] * s[0], v[1][j] * s[1], 0, false); a0 = __builtin_amdgcn_cvt_pk_fp8_f32(v[2][j] * s[2], v[3][j] * s[3], a0, true);
        int a1 = __builtin_amdgcn_cvt_pk_fp8_f32(v[4][j] * s[4], v[5][j] * s[5], 0, false); a1 = __builtin_amdgcn_cvt_pk_fp8_f32(v[6][j] * s[6], v[7][j] * s[7], a1, true);
        int b0 = __builtin_amdgcn_cvt_pk_fp8_f32(v[8][j] * s[8], v[9][j] * s[9], 0, false); b0 = __builtin_amdgcn_cvt_pk_fp8_f32(v[10][j] * s[10], v[11][j] * s[11], b0, true);
        int b1 = __builtin_amdgcn_cvt_pk_fp8_f32(v[12][j] * s[12], v[13][j] * s[13], 0, false); b1 = __builtin_amdgcn_cvt_pk_fp8_f32(v[14][j] * s[14], v[15][j] * s[15], b1, true);
        *(LAS u32x2*)wp = (u32x2){(unsigned)a0, (unsigned)a1}; *(LAS u32x2*)(wp + 32) = (u32x2){(unsigned)b0, (unsigned)b1};
        LDS_WAIT();
        const u32x4 o = *(LAS const u32x4*)rp;
        LDS_WAIT();
        __builtin_nontemporal_store(o, (u32x4*)(WT + (size_t)(wrow0 + 4 * R + j) * ldt + k0 + 16 * p));
    }
}
__device__ __forceinline__ void cvt_run_job(const CvtJob& J, int lane) {
    int q = J.first; const int qe = J.first + J.count;
    for (; q + 1 < qe; q += 2) {
        const float *W0, *W1; bf16 *T0, *T1; int N0, N1, l0, l1, r0, r1, k0, k1; bool s0, s1;
        cvt_decode(J, q, J.wave, W0, N0, T0, l0, r0, k0, s0); cvt_decode(J, q + 1, J.wave, W1, N1, T1, l1, r1, k1, s1);
        f32x4 va[16], vb[16]; cvt_load(va, W0, N0, k0, lane); cvt_load(vb, W1, N1, k1, lane);
        cvt_store8(va, (unsigned char*)T0, l0, r0, k0, s0 ? J.ks : nullptr, s0 ? 1024.0f : 512.0f, J.scr, lane); cvt_store8(vb, (unsigned char*)T1, l1, r1, k1, s1 ? J.ks : nullptr, s1 ? 1024.0f : 512.0f, J.scr, lane);
    }
    if (q < qe) { const float* W0; bf16* T0; int N0, l0, r0, k0; bool s0; cvt_decode(J, q, J.wave, W0, N0, T0, l0, r0, k0, s0);
        f32x4 va[16]; cvt_load(va, W0, N0, k0, lane); cvt_store8(va, (unsigned char*)T0, l0, r0, k0, s0 ? J.ks : nullptr, s0 ? 1024.0f : 512.0f, J.scr, lane); }
}

__device__ __forceinline__ void p0_prologue(Frame& F, const Args& A) {
    LAS unsigned char* scr = F.lds + F.wave * 2048;
    const int lane = lane_id();
    const int gw = F.vcu * NWAVES + F.wave, NGW = F.G * NWAVES;
    constexpr int J_IN = 32 * 100, J_AB = 16 * 32, J_PB = 16 * 32, J_WO = 32 * 32, NJ = J_IN + J_AB + J_PB + J_WO;
    for (int it = gw; it < NJ; it += NGW) { f32x4 v[16]; int r = it;
        if (r < J_IN) { const int kb = r / 100, nb = r % 100, k0 = 64 * kb, n0 = 64 * nb; cvt_load(v, A.in[I_WIN] + n0, INW, k0, lane);
            if (nb < 36) cvt_store(v, F.WIN(), 2048, n0, k0, nullptr, false, scr, lane);
            if (nb < 20) cvt_store8(v, F.WIN8(), 2048, n0, k0, nullptr, 1024.0f, scr, lane);
            if (nb >= 36) cvt_store8(v, F.WIN8(), 2048, 1280 + 64 * (nb - 36), k0, nullptr, 1024.0f, scr, lane);
            continue; } r -= J_IN;
        if (r < J_AB) { const int kb = r >> 5, nb = r & 31; cvt_load(v, A.in[I_WAB] + 64 * nb, 2048, 64 * kb, lane); cvt_store(v, F.WAB(), 2048, 64 * nb, 64 * kb, nullptr, false, scr, lane); continue; } r -= J_AB;
        if (r < J_PB) { const int kb = r >> 5, nb = r & 31; cvt_load(v, A.in[I_WPB] + 64 * nb, 2048, 64 * kb, lane); cvt_store(v, F.WPT(), 1024, 64 * nb, 64 * kb, nullptr, false, scr, lane); continue; } r -= J_PB;
        { const int kb = r >> 5, nb = r & 31; cvt_load(v, A.in[I_WOUT] + 64 * nb, 2048, 64 * kb, lane); cvt_store(v, F.WO(), 2048, 64 * nb, 64 * kb, nullptr, false, scr, lane); }
    }
    const int gt = F.vcu * (NWAVES * 64) + F.tid(), NGT = F.G * NWAVES * 64;
    for (int i = gt; i < 4 * 256 * 256 / 2; i += NGT) { const int e = 2 * i, g = e >> 16, j = e & 255; const float s0 = A.in[I_PSCL][g * 256 + j], s1 = A.in[I_PSCL][g * 256 + j + 1];
        ((unsigned*)F.PMS())[i] = cvt_pk_bf16(A.in[I_PMIX][e] * s0, A.in[I_PMIX][e + 1] * s1); }
    for (int i = gt; i < 80 * 2048; i += NGT) { const int n = i >> 11, k = i & 2047; float v = 0.f;
        if (n < 8) v = A.in[I_WRG][k * 8 + n] * A.in[I_NFFN][k]; else if (n < 72) v = A.in[I_WRE][k * 64 + (n - 8)] * A.in[I_NFFN][k];
        F.WR()[i] = (bf16)(cvt_pk_bf16(v, 0.f) & 0xffffu); }
    for (int m = gw; m + 3 * NGW < M; m += 4 * NGW) {
        const float* const xr[4] = {A.in[I_X] + (size_t)m * DM, A.in[I_X] + (size_t)(m + NGW) * DM, A.in[I_X] + (size_t)(m + 2 * NGW) * DM, A.in[I_X] + (size_t)(m + 3 * NGW) * DM};
        bf16* const orw[4] = {F.HN() + (size_t)m * DM, F.HN() + (size_t)(m + NGW) * DM, F.HN() + (size_t)(m + 2 * NGW) * DM, F.HN() + (size_t)(m + 3 * NGW) * DM};
        unsigned char* const o8[4] = {F.HN8() + (size_t)m * DM, F.HN8() + (size_t)(m + NGW) * DM, F.HN8() + (size_t)(m + 2 * NGW) * DM, F.HN8() + (size_t)(m + 3 * NGW) * DM};
        rms_rows_to_bf16<4>(xr, A.in[I_NMIX], orw, o8, lane); }
    if (gw < NMETA) { const float* const xr[1] = {A.in[I_META] + (size_t)gw * DM}; bf16* const orw[1] = {F.HN() + (size_t)(M + gw) * DM}; unsigned char* const o8[1] = {nullptr}; rms_rows_to_bf16<1>(xr, A.in[I_NMIX], orw, o8, lane); }
}


using pg8::Unit;
struct CvtSlot { int first, count, slot; };
__device__ __forceinline__ unsigned long long misc_u64(int word) { const LAS unsigned* m = (const LAS unsigned*)(unsigned)L_MISC; const unsigned lo = m[word], hi = m[word + 1];
    return ((unsigned long long)(unsigned)__builtin_amdgcn_readfirstlane((int)hi) << 32) | (unsigned)__builtin_amdgcn_readfirstlane((int)lo); }
__device__ __forceinline__ void cvt_run(const CvtSlot& S, const int wave) {
    const int lane = lane_id(); unsigned char* ws = (unsigned char*)misc_u64(48);
    CvtJob J{(const float*)misc_u64(40), (const float*)misc_u64(42), (const float*)misc_u64(44), (const float*)misc_u64(46), (bf16*)(ws + WS_WGU), (bf16*)(ws + WS_WD), S.first, S.count, S.slot, wave, (LAS unsigned char*)(unsigned)(L_CVT + wave * 2048)};
    cvt_run_job(J, lane);
}

struct DenseOrder {
    const char* A; const char* B; int nM, nN, nwg, G, c, lda, ldb;
    __device__ __forceinline__ bool next(int i, Unit& u) const {
        const long L = (long)i * G + c; if (L >= nwg) return false;
        int pm, pn; pg8::tile_of((int)L, nM, nN, pm, pn); u.pm = pm; u.pn = pn; u.x0 = 0; u.x1 = 0;
        u.a = A + (size_t)pm * 256 * lda * 2; u.b = B + (size_t)pn * 256 * ldb * 2; return true; }
};
struct EpiProj {
    static constexpr bool HAS_MID = false; static constexpr int MID_T = 0;
    static constexpr bool HAS_POST = true;
    bf16* O; CvtSlot job; int wave, colbase;
    __device__ __forceinline__ void post(int ui) const { if (ui == job.slot) cvt_run(job, wave); }
    __device__ __forceinline__ void operator()(const f32x4 (&acc)[2][2][4][2], const Unit& u, int, int wr, int wc, int fr, int fq) const {
        const int row0 = u.pm * 256 + wr * 64 + fr, col0 = colbase + u.pn * 256 + wc * 32 + 8 * fq;
#pragma unroll
        for (int ai = 0; ai < 2; ++ai)
#pragma unroll
            for (int m = 0; m < 4; ++m) { bf16* rowp = O + (size_t)(row0 + ai * 128 + m * 16) * PW + col0;
#pragma unroll
                for (int bj = 0; bj < 2; ++bj) { const f32x4 v0 = acc[ai][bj][m][0], v1 = acc[ai][bj][m][1];
                    u32x4 w; w.x = cvt_pk_bf16(v0[0], v0[1]); w.y = cvt_pk_bf16(v0[2], v0[3]); w.z = cvt_pk_bf16(v1[0], v1[1]); w.w = cvt_pk_bf16(v1[2], v1[3]);
                    *(u32x4*)(rowp + bj * 128) = w; } }
    }
};
struct EpiGate {
    static constexpr bool HAS_MID = false; static constexpr int MID_T = 0;
    static constexpr bool HAS_POST = true;
    unsigned char* G; bf16* O; CvtSlot job; int wave, n1;
    __device__ __forceinline__ void post(int ui) const { if (ui + n1 == job.slot) cvt_run(job, wave); }
    __device__ __forceinline__ void operator()(const f32x4 (&acc)[2][2][4][2], const Unit& u, int, int wr, int wc, int fr, int fq) const {
        const int row0 = u.pm * 256 + wr * 64 + fr; constexpr float S = 1.0f / 8192.0f;
        if (u.pn < 5) { const int col0 = u.pn * 256 + wc * 32 + 8 * fq;
#pragma unroll
            for (int ai = 0; ai < 2; ++ai)
#pragma unroll
                for (int m = 0; m < 4; ++m) { bf16* rowp = O + (size_t)(row0 + ai * 128 + m * 16) * PW + col0;
#pragma unroll
                    for (int bj = 0; bj < 2; ++bj) { const f32x4 v0 = acc[ai][bj][m][0] * S, v1 = acc[ai][bj][m][1] * S;
                        u32x4 w; w.x = cvt_pk_bf16(v0[0], v0[1]); w.y = cvt_pk_bf16(v0[2], v0[3]); w.z = cvt_pk_bf16(v1[0], v1[1]); w.w = cvt_pk_bf16(v1[2], v1[3]);
                        *(u32x4*)(rowp + bj * 128) = w; } }
        } else { const int col0 = (u.pn - 5) * 256 + wc * 32 + 8 * fq;
#pragma unroll
            for (int ai = 0; ai < 2; ++ai)
#pragma unroll
                for (int m = 0; m < 4; ++m) { unsigned char* rowp = G + (size_t)(row0 + ai * 128 + m * 16) * GW + col0;
#pragma unroll
                    for (int bj = 0; bj < 2; ++bj) { const f32x4 v0 = acc[ai][bj][m][0] * S, v1 = acc[ai][bj][m][1] * S; unsigned q[8];
#pragma unroll
                        for (int e = 0; e < 4; ++e) { q[e] = (unsigned)fminf(sigmoidf_(v0[e]) * 256.0f, 255.0f); q[4 + e] = (unsigned)fminf(sigmoidf_(v1[e]) * 256.0f, 255.0f); }
                        u32x2 w; w.x = q[0] | (q[1] << 8) | (q[2] << 16) | (q[3] << 24); w.y = q[4] | (q[5] << 8) | (q[6] << 16) | (q[7] << 24);
                        *(u32x2*)(rowp + bj * 128) = w; } }
        }
    }
};
struct FoldOrder {
    const char* WPT; const char* PMS; int idx;
    __device__ __forceinline__ bool next(int i, Unit& u) const {
        if (i > 0 || idx < 0) return false; u.pm = idx >> 2; u.pn = idx & 3; u.x0 = 0; u.x1 = 0;
        u.a = WPT + ((size_t)u.pm * 256 * 1024 + (size_t)u.pn * 256) * 2; u.b = PMS + (size_t)u.pn * 65536 * 2; return true; }
};
struct EpiFold {
    static constexpr bool HAS_MID = false; static constexpr int MID_T = 0;
    static constexpr bool HAS_POST = false;
    bf16* O;
    __device__ __forceinline__ void operator()(const f32x4 (&acc)[2][2][4][2], const Unit& u, int, int wr, int wc, int fr, int fq) const {
        const int row0 = u.pm * 256 + wr * 64 + fr, col0 = 1024 + u.pn * 256 + wc * 32 + 8 * fq;
#pragma unroll
        for (int ai = 0; ai < 2; ++ai)
#pragma unroll
            for (int m = 0; m < 4; ++m) { bf16* rowp = O + (size_t)(row0 + ai * 128 + m * 16) * 2048 + col0;
#pragma unroll
                for (int bj = 0; bj < 2; ++bj) { const f32x4 v0 = acc[ai][bj][m][0], v1 = acc[ai][bj][m][1];
                    u32x4 w; w.x = cvt_pk_bf16(v0[0], v0[1]); w.y = cvt_pk_bf16(v0[2], v0[3]); w.z = cvt_pk_bf16(v1[0], v1[1]); w.w = cvt_pk_bf16(v1[2], v1[3]);
                    *(u32x4*)(rowp + bj * 128) = w; } }
    }
};
struct EpiBranch {
    static constexpr bool HAS_MID = true; static constexpr int MID_T = 16;
    static constexpr bool HAS_POST = false;
    const unsigned char* GATE; bf16* MG;
    static __device__ __forceinline__ void dec8(const u32x2 g, float (&f)[8]) {
        constexpr float S = 1.0f / 256.0f, H = 0.5f / 256.0f;
        f[0] = (float)(g.x & 0xffu) * S + H; f[1] = (float)((g.x >> 8) & 0xffu) * S + H; f[2] = (float)((g.x >> 16) & 0xffu) * S + H; f[3] = (float)(g.x >> 24) * S + H;
        f[4] = (float)(g.y & 0xffu) * S + H; f[5] = (float)((g.y >> 8) & 0xffu) * S + H; f[6] = (float)((g.y >> 16) & 0xffu) * S + H; f[7] = (float)(g.y >> 24) * S + H;
    }
    __device__ __forceinline__ void mid(f32x4 (&acc)[2][2][4][2], const Unit& u, int wr, int wc, int fr, int fq) const {
        const unsigned off0 = (unsigned)(u.pm * 256 + wr * 64 + fr) * (unsigned)GW + (unsigned)(u.pn * 256 + wc * 32 + 8 * fq);
#pragma unroll
        for (int ai = 0; ai < 2; ++ai) {
            u32x2 ga[4][2], gb[4][2];
#pragma unroll
            for (int m = 0; m < 4; ++m) { const unsigned off = off0 + (unsigned)(ai * 128 + m * 16) * (unsigned)GW;
#pragma unroll
                for (int bj = 0; bj < 2; ++bj) { ga[m][bj] = *(const u32x2*)(GATE + off + bj * 128); gb[m][bj] = *(const u32x2*)(GATE + off + 2048 + bj * 128); } }
            asm volatile("" ::: "memory");
#pragma unroll
            for (int m = 0; m < 4; ++m)
#pragma unroll
                for (int bj = 0; bj < 2; ++bj) { float fa[8], fb[8]; dec8(ga[m][bj], fa); dec8(gb[m][bj], fb);
#pragma unroll
                    for (int e = 0; e < 4; ++e) { acc[ai][bj][m][0][e] *= fa[e] * __builtin_amdgcn_rcpf(fb[e]); acc[ai][bj][m][1][e] *= fa[4 + e] * __builtin_amdgcn_rcpf(fb[4 + e]); } }
            asm volatile("" ::: "memory");
        }
    }
    __device__ __forceinline__ void operator()(const f32x4 (&acc)[2][2][4][2], const Unit& u, int, int wr, int wc, int fr, int fq) const {
        const unsigned row0 = (unsigned)(u.pm * 256 + wr * 64 + fr), col0 = (unsigned)(u.pn * 256 + wc * 32 + 8 * fq);
        const unsigned goff0 = row0 * (unsigned)GW + 2048u + col0, moff0 = row0 * 2048u + col0;
        u32x2 gb[2][4][2];
#pragma unroll
        for (int ai = 0; ai < 2; ++ai)
#pragma unroll
            for (int m = 0; m < 4; ++m) { const unsigned goff = goff0 + (unsigned)(ai * 128 + m * 16) * (unsigned)GW;
#pragma unroll
                for (int bj = 0; bj < 2; ++bj) gb[ai][m][bj] = *(const u32x2*)(GATE + goff + bj * 128); }
        asm volatile("" ::: "memory");
#pragma unroll
        for (int ai = 0; ai < 2; ++ai)
#pragma unroll
            for (int m = 0; m < 4; ++m) { const unsigned moff = moff0 + (unsigned)(ai * 128 + m * 16) * 2048u;
#pragma unroll
                for (int bj = 0; bj < 2; ++bj) { float fb[8]; dec8(gb[ai][m][bj], fb);
                    const f32x4 v0 = acc[ai][bj][m][0], v1 = acc[ai][bj][m][1];
                    u32x4 w; w.x = cvt_pk_bf16(v0[0] * fb[0], v0[1] * fb[1]); w.y = cvt_pk_bf16(v0[2] * fb[2], v0[3] * fb[3]); w.z = cvt_pk_bf16(v1[0] * fb[4], v1[1] * fb[5]); w.w = cvt_pk_bf16(v1[2] * fb[6], v1[3] * fb[7]);
                    *(u32x4*)(MG + moff + bj * 128) = w; } }
    }
};
struct EpiOut {
    static constexpr bool HAS_MID = false; static constexpr int MID_T = 0;
    static constexpr bool HAS_POST = false;
    const float* X; bf16* H1B; float* SSQ; unsigned char* H8;
    __device__ __forceinline__ void operator()(const f32x4 (&acc)[2][2][4][2], const Unit& u, int, int wr, int wc, int fr, int fq) const {
        PT_MARK(70, 0);
        const int row0 = u.pm * 256 + wr * 64 + fr, col0 = u.pn * 256 + wc * 32 + 8 * fq;
#pragma unroll
        for (int ai = 0; ai < 2; ++ai) {
            f32x4 xr[4][2][2];
#pragma unroll
            for (int m = 0; m < 4; ++m) { const size_t off = (size_t)(row0 + ai * 128 + m * 16) * 2048 + col0;
#pragma unroll
                for (int bj = 0; bj < 2; ++bj) { xr[m][bj][0] = *(const f32x4*)(X + off + bj * 128); xr[m][bj][1] = *(const f32x4*)(X + off + bj * 128 + 4); } }
            asm volatile("" ::: "memory");
#pragma unroll
            for (int m = 0; m < 4; ++m) { const int row = row0 + ai * 128 + m * 16; const size_t off = (size_t)row * 2048 + col0; float ss = 0.f;
#pragma unroll
                for (int bj = 0; bj < 2; ++bj) { const f32x4 v0 = acc[ai][bj][m][0] + xr[m][bj][0], v1 = acc[ai][bj][m][1] + xr[m][bj][1];
                    ss += (v0[0] * v0[0] + v0[1] * v0[1]) + (v0[2] * v0[2] + v0[3] * v0[3]) + (v1[0] * v1[0] + v1[1] * v1[1]) + (v1[2] * v1[2] + v1[3] * v1[3]);
                    u32x4 w; w.x = cvt_pk_bf16(v0[0], v0[1]); w.y = cvt_pk_bf16(v0[2], v0[3]); w.z = cvt_pk_bf16(v1[0], v1[1]); w.w = cvt_pk_bf16(v1[2], v1[3]);
                    *(u32x4*)(H1B + off + bj * 128) = w;
                    f32x4 z0 = v0 * 8.0f, z1 = v1 * 8.0f;
#pragma unroll
                    for (int e = 0; e < 4; ++e) { z0[e] = __builtin_fminf(__builtin_fmaxf(z0[e], -448.0f), 448.0f); z1[e] = __builtin_fminf(__builtin_fmaxf(z1[e], -448.0f), 448.0f); }
                    int p0 = __builtin_amdgcn_cvt_pk_fp8_f32(z0[0], z0[1], 0, false); p0 = __builtin_amdgcn_cvt_pk_fp8_f32(z0[2], z0[3], p0, true);
                    int p1 = __builtin_amdgcn_cvt_pk_fp8_f32(z1[0], z1[1], 0, false); p1 = __builtin_amdgcn_cvt_pk_fp8_f32(z1[2], z1[3], p1, true);
                    *(u32x2*)(H8 + off + bj * 128) = (u32x2){(unsigned)p0, (unsigned)p1}; }
                ss += __shfl_xor(ss, 16); ss += __shfl_xor(ss, 32);
                if (fq == 0) SSQ[(size_t)(u.pn * 4 + wc) * M + row] = ss; }
            asm volatile("" ::: "memory");
        }
#if PROBE_TIME == 70
        asm volatile("s_waitcnt vmcnt(0)" ::: "memory");
#endif
        PT_MARK(70, 1);
    }
};
struct MoeOrder {
    LAS const int* ud; int nunits; const char* A; const char* B; size_t a_row_bytes  , b_exp_bytes, b_panel_bytes;
    __device__ __forceinline__ bool next(int i, Unit& u) const {
        if (i >= nunits) return false;
        const int e = __builtin_amdgcn_readfirstlane(ud[i * 8 + 0]), pn = __builtin_amdgcn_readfirstlane(ud[i * 8 + 1]), nv = __builtin_amdgcn_readfirstlane(ud[i * 8 + 2]), rs = __builtin_amdgcn_readfirstlane(ud[i * 8 + 3]);
        u.pm = e; u.pn = pn; u.x0 = nv; u.x1 = rs; u.a = A + (size_t)rs * a_row_bytes; u.b = B + (size_t)e * b_exp_bytes + (size_t)pn * b_panel_bytes; return true; }
};
struct EpiGU {
    static constexpr bool HAS_MID = false; static constexpr int MID_T = 0;
    static constexpr bool HAS_POST = false;
    bf16* HID; LAS const float* rtab;
    __device__ __forceinline__ void operator()(const f32x4 (&acc)[2][2][4][2], const Unit& u, int ui, int wr, int wc, int fr, int fq) const {
        const int col0 = u.pn * 128 + wc * 32 + 8 * fq; const int nv = u.x0, rs = u.x1;
#pragma unroll
        for (int ai = 0; ai < 2; ++ai)
#pragma unroll
            for (int m = 0; m < 4; ++m) { const int rr = ai * 128 + wr * 64 + m * 16 + fr; const float r = rtab[ui * 256 + rr] * (1.0f / 8192.0f);
                int pk[2];
#pragma unroll
                for (int n = 0; n < 2; ++n) { f32x4 g = acc[ai][0][m][n] * r; const f32x4 uu = acc[ai][1][m][n] * r;
#pragma unroll
                    for (int e = 0; e < 4; ++e) g[e] = __builtin_fminf(__builtin_fmaxf(g[e] * sigmoidf_(g[e]) * uu[e] * 8.0f, -448.0f), 448.0f);
                    int p = __builtin_amdgcn_cvt_pk_fp8_f32(g[0], g[1], 0, false); pk[n] = __builtin_amdgcn_cvt_pk_fp8_f32(g[2], g[3], p, true); }
                const int p0 = pk[0], p1 = pk[1];
                if (rr < nv) *(u32x2*)((unsigned char*)HID + (size_t)(rs + rr) * DEXP + col0) = (u32x2){(unsigned)p0, (unsigned)p1}; }
    }
};
struct EpiDown {
    static constexpr bool HAS_MID = false; static constexpr int MID_T = 0;
    static constexpr bool HAS_POST = false;
    bf16* Y; LAS const float* wtab;
    __device__ __forceinline__ void operator()(const f32x4 (&acc)[2][2][4][2], const Unit& u, int ui, int wr, int wc, int fr, int fq) const {
        const int col0 = u.pn * 256 + wc * 32 + 8 * fq; const int nv = u.x0, rs = u.x1;
#pragma unroll
        for (int ai = 0; ai < 2; ++ai)
#pragma unroll
            for (int m = 0; m < 4; ++m) { const int rr = ai * 128 + wr * 64 + m * 16 + fr; const float wt = wtab[ui * 256 + rr] * (1.0f / 4096.0f); bf16* rowp = Y + (size_t)(rs + rr) * 2048 + col0;
#pragma unroll
                for (int bj = 0; bj < 2; ++bj) { const f32x4 v0 = acc[ai][bj][m][0] * wt, v1 = acc[ai][bj][m][1] * wt;
                    u32x4 w; w.x = cvt_pk_bf16(v0[0], v0[1]); w.y = cvt_pk_bf16(v0[2], v0[3]); w.z = cvt_pk_bf16(v1[0], v1[1]); w.w = cvt_pk_bf16(v1[2], v1[3]);
                    if (rr < nv) *(u32x4*)(rowp + bj * 128) = w; } }
    }
};

__device__ __forceinline__ void meta_proj_task(Frame& F, int task) {
    const int lane = F.lane(), n0 = KOFF + 16 * task;
    const bf16* ap = F.HN() + (size_t)(M + (lane & 15)) * DM + 8 * (lane >> 4);
    const bf16* bp = F.WIN() + (size_t)(n0 + (lane & 15)) * DM + 8 * (lane >> 4);
    f32x4 acc = (f32x4){0.f, 0.f, 0.f, 0.f};
#pragma unroll 8
    for (int ks = 0; ks < 64; ++ks) { const bf16x8 a = *(const bf16x8*)(ap + 32 * ks), b = *(const bf16x8*)(bp + 32 * ks); acc = __builtin_amdgcn_mfma_f32_16x16x32_bf16(a, b, acc, 0, 0, 0); }
#pragma unroll
    for (int r = 0; r < 4; ++r) F.PROJ()[(size_t)(M + 4 * (lane >> 4) + r) * PW + n0 + (lane & 15)] = (bf16)(cvt_pk_bf16(acc[r], 0.f) & 0xffffu);
}

__device__ __forceinline__ int t5_bucket(int d) {
    if (d < 16) return d;
    return 16 + (d >= 19) + (d >= 21) + (d >= 24) + (d >= 27) + (d >= 31) + (d >= 35) + (d >= 40) + (d >= 46) + (d >= 52) + (d >= 59) + (d >= 67) + (d >= 77) + (d >= 87) + (d >= 99) + (d >= 113);
}
constexpr int A_KL = 0, A_KROW = 144;
constexpr int A_VT = 288 * 144, A_VROW = 584;
constexpr int A_BT = A_VT + 64 * 584;
static_assert(A_BT + 4096 <= RING_BYTES, "attention LDS");

template <int T>
__device__ __forceinline__ void attn_qtile(LAS const unsigned char* lds, LAS const float* BT, const bf16x8 (&qf)[4], bf16x8 (&qn)[4], const bf16* Qrow, bf16* Orow, float sink, int blk, int lane) {
    const int r32 = lane & 31, hi = lane >> 5, qi = 32 * T + r32;
    if constexpr (T < 3) {
#pragma unroll
        for (int ds = 0; ds < 4; ++ds) qn[ds] = *(const bf16x8*)(Qrow + (size_t)(32 + r32) * PW + ds * 16 + hi * 8); }
    f32x16 s[6];
#pragma unroll
    for (int ti = 0; ti < 6; ++ti) {
        const int kkb = (ti == 0) ? 0 : (ti <= 4 - T ? 32 + 32 * (T + ti - 1) : 160 + 32 * (ti - (5 - T)));
        f32x16 a = (f32x16){0.f, 0.f, 0.f, 0.f, 0.f, 0.f, 0.f, 0.f, 0.f, 0.f, 0.f, 0.f, 0.f, 0.f, 0.f, 0.f};
#pragma unroll
        for (int ds = 0; ds < 4; ++ds) { const bf16x8 kf = *(const LAS bf16x8*)(lds + A_KL + (kkb + r32) * A_KROW + ds * 32 + hi * 16); a = __builtin_amdgcn_mfma_f32_32x32x16_bf16(kf, qf[ds], a, 0, 0, 0); }
        s[ti] = a;
    }
    float mx = sink;
#pragma unroll
    for (int r = 0; r < 8; ++r) { const int i = (r & 3) + 8 * (r >> 2) + 4 * hi; int dist = 16 + 128 * blk + qi - i; dist = dist > 127 ? 127 : dist;
        const float x = s[0][r] * 0.125f + BT[dist]; s[0][r] = x; mx = fmaxf(mx, x); }
#pragma unroll
    for (int ti = 1; ti < 6; ++ti) {
        const bool prev = ti <= 4 - T; const int jt = prev ? (T + ti - 1) : (ti - (5 - T));
#pragma unroll
        for (int r = 0; r < 16; ++r) { const int i = (r & 3) + 8 * (r >> 2) + 4 * hi, j = 32 * jt + i;
            int dist; bool vis;
            if (prev) { dist = 128 + qi - j; vis = (blk > 0) && (jt > T || j > qi); } else { dist = qi - j; vis = (jt < T) || (j <= qi); }
            dist = dist < 0 ? 0 : (dist > 127 ? 127 : dist);
            const float x = vis ? s[ti][r] * 0.125f + BT[dist] : -1e30f; s[ti][r] = x; mx = fmaxf(mx, x); }
    }
    mx = fmaxf(mx, __shfl_xor(mx, 32));
    float l = 0.f;
#pragma unroll
    for (int r = 0; r < 8; ++r) { const float p = __expf(s[0][r] - mx); s[0][r] = p; l += p; }
#pragma unroll
    for (int ti = 1; ti < 6; ++ti)
#pragma unroll
        for (int r = 0; r < 16; ++r) { const float p = __expf(s[ti][r] - mx); s[ti][r] = p; l += p; }
    l += __shfl_xor(l, 32); l += __expf(sink - mx);
    f32x16 o[2];
    o[0] = (f32x16){0.f, 0.f, 0.f, 0.f, 0.f, 0.f, 0.f, 0.f, 0.f, 0.f, 0.f, 0.f, 0.f, 0.f, 0.f, 0.f}; o[1] = o[0];
#pragma unroll
    for (int ti = 0; ti < 6; ++ti) {
        const int kkb = (ti == 0) ? 0 : (ti <= 4 - T ? 32 + 32 * (T + ti - 1) : 160 + 32 * (ti - (5 - T)));
#pragma unroll
        for (int s2 = 0; s2 < 2; ++s2) {
            if (ti == 0 && s2 == 1) continue;
            u32x4 pw; pw.x = cvt_pk_bf16(s[ti][8 * s2 + 0], s[ti][8 * s2 + 1]); pw.y = cvt_pk_bf16(s[ti][8 * s2 + 2], s[ti][8 * s2 + 3]); pw.z = cvt_pk_bf16(s[ti][8 * s2 + 4], s[ti][8 * s2 + 5]); pw.w = cvt_pk_bf16(s[ti][8 * s2 + 6], s[ti][8 * s2 + 7]);
            const bf16x8 pf = __builtin_bit_cast(bf16x8, pw);
#pragma unroll
            for (int dt = 0; dt < 2; ++dt) { LAS const unsigned char* vp = lds + A_VT + (dt * 32 + r32) * A_VROW + (kkb + 16 * s2 + 4 * hi) * 2;
                const u32x2 lo = *(const LAS u32x2*)vp, hi2 = *(const LAS u32x2*)(vp + 16);
                const bf16x8 vf = __builtin_bit_cast(bf16x8, (u32x4){lo.x, lo.y, hi2.x, hi2.y});
                o[dt] = __builtin_amdgcn_mfma_f32_32x32x16_bf16(vf, pf, o[dt], 0, 0, 0); }
        }
    }
    const float inv = 1.0f / l;
#pragma unroll
    for (int dt = 0; dt < 2; ++dt)
#pragma unroll
        for (int g4 = 0; g4 < 4; ++g4) { u32x2 w; w.x = cvt_pk_bf16(o[dt][4 * g4 + 0] * inv, o[dt][4 * g4 + 1] * inv); w.y = cvt_pk_bf16(o[dt][4 * g4 + 2] * inv, o[dt][4 * g4 + 3] * inv);
            *(u32x2*)(Orow + (size_t)r32 * 2048 + dt * 32 + 8 * g4 + 4 * hi) = w; }
}

template <int W>
__device__ __forceinline__ void mixed_task(const bf16* ub  , bf16* ob  , int b, int s0) {
    constexpr int NR = 16 + W - 1;
    u32x4 u[NR];
#pragma unroll
    for (int i = 0; i < NR; ++i) { const int s = s0 - (W - 1) + i; const size_t row = s >= 0 ? (size_t)(b * SEQ + s) : (size_t)(M + 16 + s); u[i] = *(const u32x4*)(ub + row * PW); }
    constexpr float iw = 1.0f / (float)W;
#pragma unroll
    for (int t = 0; t < 16; ++t) {
        float a[8];
#pragma unroll
        for (int e = 0; e < 8; ++e) a[e] = 0.f;
#pragma unroll
        for (int j = 0; j < W; ++j) { const u32x4 v = u[t + j];
            a[0] += bf_lo(v.x); a[1] += bf_hi(v.x); a[2] += bf_lo(v.y); a[3] += bf_hi(v.y); a[4] += bf_lo(v.z); a[5] += bf_hi(v.z); a[6] += bf_lo(v.w); a[7] += bf_hi(v.w); }
        const u32x4 own = u[t + W - 1];
        u32x4 o; o.x = cvt_pk_bf16(a[0] * iw - bf_lo(own.x), a[1] * iw - bf_hi(own.x)); o.y = cvt_pk_bf16(a[2] * iw - bf_lo(own.y), a[3] * iw - bf_hi(own.y));
        o.z = cvt_pk_bf16(a[4] * iw - bf_lo(own.z), a[5] * iw - bf_hi(own.z)); o.w = cvt_pk_bf16(a[6] * iw - bf_lo(own.w), a[7] * iw - bf_hi(own.w));
        *(u32x4*)(ob + (size_t)t * 2048) = o;
    }
}

__device__ __forceinline__ void attn_unit(Frame& F, const Args& A, int b, int blk, int kvh) {
    LAS unsigned char* lds = F.lds; const int tid = F.tid(); const int m0 = b * SEQ + blk * 128;
    PT_MARK(20, 0);
    for (int c = tid; c < 288 * 8; c += NWAVES * 64) { const int kk = c >> 3, ch = c & 7; int row = -1;
        if (kk < 16) row = M + kk; else if (kk >= 160) row = m0 + (kk - 160); else if (kk >= 32 && blk > 0) row = m0 - 128 + (kk - 32);
        u32x4 kv = (u32x4){0u, 0u, 0u, 0u}, vv = kv;
        if (row >= 0) { const bf16* p = F.PROJ() + (size_t)row * PW + kvh * 64 + ch * 8; kv = *(const u32x4*)(p + KOFF); vv = *(const u32x4*)(p + VOFF); }
        *(LAS u32x4*)(lds + A_KL + kk * A_KROW + ch * 16) = kv;
        if (kk < 16 || kk >= 32) { LAS bf16* vt = (LAS bf16*)(lds + A_VT) + (size_t)(ch * 8) * 292 + kk;
            vt[0 * 292] = (bf16)(vv.x & 0xffffu); vt[1 * 292] = (bf16)(vv.x >> 16); vt[2 * 292] = (bf16)(vv.y & 0xffffu); vt[3 * 292] = (bf16)(vv.y >> 16);
            vt[4 * 292] = (bf16)(vv.z & 0xffffu); vt[5 * 292] = (bf16)(vv.z >> 16); vt[6 * 292] = (bf16)(vv.w & 0xffffu); vt[7 * 292] = (bf16)(vv.w >> 16); }
    }
    LAS float* BTall = (LAS float*)(lds + A_BT);
    for (int t = tid; t < 8 * 128; t += NWAVES * 64) { const int g = t >> 7, d = t & 127; BTall[t] = A.in[I_RELB][t5_bucket(d) * 16 + kvh * 8 + g]; }
    __syncthreads();
    PT_MARK(20, 1); PT_MARK(21, 0);
    const int g = F.wave, hq = kvh * 8 + g; const float sink = A.in[I_SINK][hq];
    const bf16* Q = F.PROJ() + (size_t)m0 * PW + hq * 64; bf16* O = F.AP() + (size_t)m0 * 2048 + hq * 64;
    LAS const float* BT = BTall + g * 128;
    bf16x8 qa[4], qb[4];
    { const int r32 = F.lane() & 31, hi = F.lane() >> 5;
#pragma unroll
      for (int ds = 0; ds < 4; ++ds) qa[ds] = *(const bf16x8*)(Q + (size_t)r32 * PW + ds * 16 + hi * 8); }
    attn_qtile<0>(lds, BT, qa, qb, Q, O, sink, blk, F.lane());
    attn_qtile<1>(lds, BT, qb, qa, Q + (size_t)32 * PW, O + (size_t)32 * 2048, sink, blk, F.lane());
    attn_qtile<2>(lds, BT, qa, qb, Q + (size_t)64 * PW, O + (size_t)64 * 2048, sink, blk, F.lane());
    attn_qtile<3>(lds, BT, qb, qa, Q + (size_t)96 * PW, O + (size_t)96 * 2048, sink, blk, F.lane());
    PT_MARK(21, 1); PT_MARK(22, 0);
    { const int grp = 2 * kvh + (F.wave & 1), r0 = 16 * (2 * (F.wave >> 1) + (F.lane() >> 5)), c8 = grp * 256 + (F.lane() & 31) * 8;
      const bf16* ub = F.PROJ() + UOFF + c8; bf16* ob = F.AP() + (size_t)(m0 + r0) * 2048 + 1024 + c8; const int s0 = blk * 128 + r0;
      if (grp == 0) mixed_task<2>(ub, ob, b, s0); else if (grp == 1) mixed_task<4>(ub, ob, b, s0); else if (grp == 2) mixed_task<8>(ub, ob, b, s0); else mixed_task<16>(ub, ob, b, s0); }
    PT_MARK(22, 1);
    __syncthreads();
}

__device__ __forceinline__ void router_group(Frame& F, const Args& A, int tg, const int dummy = 0) {
    LAS unsigned char* lds = F.lds; const int lane = F.lane(), w = F.wave, q = w & 3, kh = w >> 2;
    LAS float* part = (LAS float*)lds;
    LAS float* logit = (LAS float*)(lds + 20480);
    const int t0 = tg * 64 + q * 16;
    f32x4 acc[5];
#pragma unroll
    for (int n = 0; n < 5; ++n) acc[n] = (f32x4){0.f, 0.f, 0.f, 0.f};
    constexpr int RB_OFF = 40960, RB_ROW = 272, RB_BUF = 160 * RB_ROW;
    static_assert(RB_OFF + 2 * RB_BUF <= RING_BYTES, "router LDS");
    const int srow = F.tid() >> 4, sl16 = F.tid() & 15;
    u32x4 sb[5]; bf16x8 aa[8][4];
    const bf16* ap = F.H1B() + (size_t)(t0 + (lane & 15)) * DM + kh * 1024 + 8 * (lane >> 4);
#define RT_LOADB(cc) do { _Pragma("unroll") for (int p = 0; p < 5; ++p) { const int row = p * 32 + srow, h = row >= 80 ? 1 : 0, n = row - 80 * h; \
        sb[p] = *(const u32x4*)(F.WR() + (size_t)n * DM + 1024 * h + 128 * (cc) + 8 * sl16); } } while (0)
#define RT_STOREB(bufi) do { _Pragma("unroll") for (int p = 0; p < 5; ++p) *(LAS u32x4*)(lds + RB_OFF + (bufi) * RB_BUF + (p * 32 + srow) * RB_ROW + 16 * sl16) = sb[p]; } while (0)
#define RT_LOADA(dst, cc) do { _Pragma("unroll") for (int ks = 0; ks < 4; ++ks) dst[ks] = *(const bf16x8*)(ap + 128 * (cc) + 32 * ks); } while (0)
    PT_MARK(50, 0);
    float ss_row = 0.f;
    if (F.tid() < 64) {
#pragma unroll
        for (int p = 0; p < 32; ++p) ss_row += F.SSQ()[(size_t)p * M + tg * 64 + F.tid()]; }
    RT_LOADB(0);
#pragma unroll
    for (int cc = 0; cc < 8; ++cc) RT_LOADA(aa[cc], cc);
    RT_STOREB(0);
    __syncthreads();
#pragma unroll
    for (int cc = 0; cc < 8; ++cc) {
        if (cc < 7) { RT_LOADB(cc + 1); }
        LAS const unsigned char* bb = lds + RB_OFF + (cc & 1) * RB_BUF + (kh * 80 + (lane & 15)) * RB_ROW + 16 * (lane >> 4);
#pragma unroll
        for (int ks = 0; ks < 4; ++ks)
#pragma unroll
            for (int n = 0; n < 5; ++n) { const bf16x8 b = *(const LAS bf16x8*)(bb + n * 16 * RB_ROW + 64 * ks); acc[n] = __builtin_amdgcn_mfma_f32_16x16x32_bf16(aa[cc][ks], b, acc[n], 0, 0, 0); }
        if (cc < 7) { RT_STOREB((cc + 1) & 1); }
        __syncthreads();
    }
#undef RT_LOADB
#undef RT_STOREB
#undef RT_LOADA
    PT_MARK(50, 1); PT_MARK(51, 0);
    if (kh == 1) {
#pragma unroll
        for (int n = 0; n < 5; ++n) *(LAS f32x4*)(part + ((q * 5 + n) * 64 + lane) * 4) = acc[n]; }
    __syncthreads();
    if (kh == 0) {
#pragma unroll
        for (int n = 0; n < 5; ++n) { const f32x4 p = *(LAS const f32x4*)(part + ((q * 5 + n) * 64 + lane) * 4); const f32x4 v = acc[n] + p;
#pragma unroll
            for (int r = 0; r < 4; ++r) logit[(q * 16 + 4 * (lane >> 4) + r) * 80 + n * 16 + (lane & 15)] = v[r]; } }
    __syncthreads();
    PT_MARK(51, 1); PT_MARK(52, 0);
    if (F.tid() < 64) {
        const int tt = tg * 64 + F.tid(); LAS const float* lg = logit + F.tid() * 80;
        const float r = 1.0f / sqrtf(ss_row * (1.0f / DM) + RMS_EPS);
        float gl[8]; int grp = 0; float gmax = -3.0e38f;
#pragma unroll
        for (int j = 0; j < 8; ++j) { gl[j] = r * lg[j] + A.in[I_BRG][j]; if (gl[j] > gmax) { gmax = gl[j]; grp = j; } }
        float den = 0.f;
#pragma unroll
        for (int j = 0; j < 8; ++j) den += __expf(gl[j] - gmax);
        const float pg = 1.0f / den;
        float l1 = -3.0e38f, l2 = -3.0e38f; int i1 = 0, i2 = 0;
#pragma unroll
        for (int j = 0; j < 8; ++j) { const float v = r * lg[8 + grp * 8 + j] + A.in[I_BRE][grp * 8 + j];
            if (v > l1) { l2 = l1; i2 = i1; l1 = v; i1 = j; } else if (v > l2) { l2 = v; i2 = j; } }
        const float e1w = 1.0f / (1.0f + __expf(l2 - l1)); const float w1 = e1w * pg, w2 = (1.0f - e1w) * pg;
        const int e1 = grp * 8 + i1, e2 = grp * 8 + i2;
        const size_t dofs = dummy ? (size_t)(WS_END - WS_LTOK) / 4 : 0;
        const int p1 = (int)atomicAdd(F.ctl + CW_CNT + (dummy ? 2048 : 0) + 16 * e1, 1u), p2 = (int)atomicAdd(F.ctl + CW_CNT + (dummy ? 2048 : 0) + 16 * e2, 1u);
        F.LTOK()[dofs + e1 * CAP + p1] = tt; F.LR()[dofs + e1 * CAP + p1] = r; F.LW()[dofs + e1 * CAP + p1] = w1;
        F.LTOK()[dofs + e2 * CAP + p2] = tt; F.LR()[dofs + e2 * CAP + p2] = r; F.LW()[dofs + e2 * CAP + p2] = w2;
        ((i32x4*)((int*)F.TINFO() + dofs))[tt] = (i32x4){e1, p1, e2, p2};
    }
    PT_MARK(52, 1);
    __syncthreads();
}

template <int NPN, bool GU>
__device__ __forceinline__ int moe_setup(Frame& F) {
    LAS int* ud = (LAS int*)(F.lds + L_UD);
    if (F.wave == 0) { const int lane = lane_id();
        const int cnt = (int)__hip_atomic_load(F.ctl + CW_CNT + 16 * lane, __ATOMIC_RELAXED, __HIP_MEMORY_SCOPE_AGENT), nt = (cnt + 255) >> 8;
        int sc = cnt, st = nt;
#pragma unroll
        for (int o = 1; o < 64; o <<= 1) { const int a = __shfl_up(sc, o), b = __shfl_up(st, o); if (lane >= o) { sc += a; st += b; } }
        const int es_e = sc - cnt, ts_e = st - nt, ntiles = __shfl(st, 63);
#pragma unroll
        for (int i = 0; i < 8; ++i) { const long L = (long)i * F.G + F.vcu; const bool ok = L < (long)ntiles * NPN; const int rt = ok ? (int)(L / NPN) : 0, pn = (int)(L % NPN);
            const unsigned long long m = __ballot(ts_e <= rt && rt < ts_e + nt); const int e = m ? (int)__builtin_ctzll(m) : 0;
            const int tile = rt - __shfl(ts_e, e), ce = __shfl(cnt, e), rs = __shfl(es_e, e) + 256 * tile; int nv = ce - 256 * tile; nv = nv > 256 ? 256 : nv;
            if (lane == 0) { ud[i * 8 + 0] = e; ud[i * 8 + 1] = pn; ud[i * 8 + 2] = nv; ud[i * 8 + 3] = rs; ud[i * 8 + 4] = tile; ud[i * 8 + 5] = ok ? 1 : 0; } }
    }
    __syncthreads();
    int nunits = 0;
#pragma unroll
    for (int i = 0; i < 8; ++i) nunits += ud[i * 8 + 5];
    LAS unsigned* tab = (LAS unsigned*)(F.lds + L_TAB);
    for (int idx = F.tid(); idx < nunits * 256; idx += NWAVES * 64) { const int i = idx >> 8, rr = idx & 255; const int e = ud[i * 8 + 0], nv = ud[i * 8 + 2], tile = ud[i * 8 + 4];
        const int pos = 256 * tile + (rr < nv ? rr : nv - 1);
        if (GU) { tab[idx] = (unsigned)F.LTOK()[e * CAP + pos] * (unsigned)DM;   ((LAS float*)tab)[1024 + idx] = F.LR()[e * CAP + pos]; }
        else ((LAS float*)tab)[idx] = rr < nv ? F.LW()[e * CAP + pos] : 0.f; }
    __syncthreads();
    return nunits;
}

__device__ __forceinline__ void final_row(Frame& F, const Args& A, int t, LAS const int* es, const int lane) {
    const i32x4 ti = F.TINFO()[t];
    const size_t s1 = (size_t)(es[ti.x] + ti.y), s2 = (size_t)(es[ti.z] + ti.w);
    const u32x2* hr = (const u32x2*)(F.H1B() + (size_t)t * DM) + lane; const u32x2* y1 = (const u32x2*)(F.Y() + s1 * DM) + lane; const u32x2* y2 = (const u32x2*)(F.Y() + s2 * DM) + lane;
    const f32x4* gr = (const f32x4*)A.in[I_NFIN] + lane;
    f32x4 v[8]; float s = 0.f;
#pragma unroll
    for (int j = 0; j < 8; ++j) { const u32x2 h = hr[64 * j]; const u32x2 a = y1[64 * j], b = y2[64 * j];
        v[j].x = bf_lo(h.x) + (bf_lo(a.x) + bf_lo(b.x)); v[j].y = bf_hi(h.x) + (bf_hi(a.x) + bf_hi(b.x)); v[j].z = bf_lo(h.y) + (bf_lo(a.y) + bf_lo(b.y)); v[j].w = bf_hi(h.y) + (bf_hi(a.y) + bf_hi(b.y));
        s += (v[j].x * v[j].x + v[j].y * v[j].y) + (v[j].z * v[j].z + v[j].w * v[j].w); }
    const float r = 1.0f / sqrtf(wave_sum(s) * (1.0f / DM) + RMS_EPS);
    f32x4* o = (f32x4*)(A.out + (size_t)t * DM) + lane;
#pragma unroll
    for (int j = 0; j < 8; ++j) { const f32x4 gg = gr[64 * j]; o[64 * j] = (f32x4){v[j].x * r * gg.x, v[j].y * r * gg.y, v[j].z * r * gg.z, v[j].w * r * gg.w}; }
}

__device__ __forceinline__ void p0_probe(Frame& F, const Args& A) {
#if PROBE_SUB > 0
    if (F.vcu < PROBE_SUB) { CvtSlot job{F.vcu * (CVT_ITEMS / PROBE_SUB), CVT_ITEMS / PROBE_SUB, 0}; cvt_run(job, F.wave); }
#endif
}
__device__ __forceinline__ void p1_phase(Frame& F, const Args& A, int c) {
    if (c < 10) meta_proj_task(F, c * 8 + F.wave);
    if (c >= 10 && c < 42) {
        FoldOrder S{(const char*)F.WPT(), (const char*)F.PMS(), c - 10}; EpiFold E{F.WAB()};
        pg8::gemm_phase<EpiFold, FoldOrder, false>(F.wave, F.lds + RING_OFF, 1024, 256, 256, S, E, nullptr);
    }
    CvtSlot job{0, 0, 0};
    { int first = 0, cnt = 0;
      for (int i = 0; i <= c; ++i) { first += cnt; cnt = i < 64 ? 18 + (int)((0x57889999u >> (4 * (i & 7))) & 15u) - 8 : (i - 64 < 189 ? 26 + (int)((0x3689AAAu >> (4 * ((i - 64) % 7))) & 15u) - 8 : 26); }
      job.first = first; job.count = cnt; job.slot = c < 64 ? c % 8 - 1 : (c - 64) % 7 - 1; }
#if PROBE_SUB > 0
    job.count = 0;
#endif
    PT_MARK(30, 0);
    if (job.slot < 0) cvt_run(job, F.wave);
    { DenseOrder S{(const char*)F.HN(), (const char*)(F.WIN() + (size_t)UOFF * 2048), 64, 4, 256, F.G, c, 2048, 2048}; EpiProj E{F.PROJ(), job, F.wave, UOFF};
      pg8::gemm_phase<EpiProj, DenseOrder, false>(F.wave, F.lds + RING_OFF, 2048, 2048, 2048, S, E, nullptr); }
    PT_MARK(30, 1); PT_MARK(31, 0);
    { DenseOrder S{(const char*)F.HN8(), (const char*)F.WIN8(), 64, 21, 1344, F.G, c, 1024, 1024}; EpiGate E{F.GATE(), F.PROJ(), job, F.wave, 1};
      pg8::gemm_phase<EpiGate, DenseOrder, false, false, true>(F.wave, F.lds + RING_OFF, 1024, 1024, 1024, S, E, nullptr); PT_MARK(31, 1); }
}
__device__ __forceinline__ void p2_phase(Frame& F, const Args& A) { const int idx = F.vcu; if (idx < 256) attn_unit(F, A, idx >> 7, (idx >> 1) & 63, idx & 1); }
__device__ __forceinline__ void p3_phase(Frame& F, int c) {
    DenseOrder S{(const char*)F.AP(), (const char*)F.WAB(), 64, 8, 512, F.G, c, 2048, 2048}; EpiBranch E{F.GATE(), F.MERGED()};
    pg8::gemm_phase<EpiBranch, DenseOrder, false>(F.wave, F.lds + RING_OFF, 2048, 2048, 2048, S, E, nullptr);
}
__device__ __forceinline__ void p4_phase(Frame& F, const Args& A, int c) {
    DenseOrder S{(const char*)F.MERGED(), (const char*)F.WO(), 64, 8, 512, F.G, c, 2048, 2048}; EpiOut E{A.in[I_X], F.H1B(), F.SSQ(), F.H8()};
    pg8::gemm_phase<EpiOut, DenseOrder, false>(F.wave, F.lds + RING_OFF, 2048, 2048, 2048, S, E, nullptr);
}
__device__ __forceinline__ void p6_phase(Frame& F) {
    const int nu = moe_setup<4, true>(F);
    MoeOrder S{(LAS const int*)(F.lds + L_UD), nu, (const char*)F.H8(), (const char*)F.WGU(), 0, (size_t)1024 * 2048, (size_t)256 * 2048};
    EpiGU E{F.HID(), (LAS const float*)(F.lds + L_TAB) + 1024};
    pg8::gemm_phase<EpiGU, MoeOrder, true, false, true>(F.wave, F.lds + RING_OFF, 1024, 1024, 1024, S, E, (LAS const unsigned*)(F.lds + L_TAB));
}
__device__ __forceinline__ void p7_phase(Frame& F) {
    const int nu = moe_setup<8, false>(F);
    MoeOrder S{(LAS const int*)(F.lds + L_UD), nu, (const char*)F.HID(), (const char*)F.WD(), (size_t)DEXP, (size_t)2048 * 512, (size_t)256 * 512};
    EpiDown E{F.Y(), (LAS const float*)(F.lds + L_TAB)};
    pg8::gemm_phase<EpiDown, MoeOrder, false, false, true>(F.wave, F.lds + RING_OFF, 256, 256, 256, S, E, nullptr);
}
__device__ __forceinline__ void p8_phase(Frame& F, const Args& A) {
    LAS int* es = (LAS int*)(F.lds + L_ESTART);
    if (F.wave == 0) { const int ln = lane_id(); const int cnt = (int)__hip_atomic_load(F.ctl + CW_CNT + 16 * ln, __ATOMIC_RELAXED, __HIP_MEMORY_SCOPE_AGENT); int sc = cnt;
#pragma unroll
        for (int o = 1; o < 64; o <<= 1) { const int a = __shfl_up(sc, o); if (ln >= o) sc += a; }
        es[ln] = sc - cnt; }
    __syncthreads();
    const int lane = lane_id();
    for (int t = F.vcu * NWAVES + F.wave; t < M; t += F.G * NWAVES) final_row(F, A, t, es, lane);
}

__global__ void __launch_bounds__(NWAVES * 64, 2) mega_fwd(Args args) {
    extern __shared__ __attribute__((aligned(16))) unsigned char lds_raw[];
    Frame F;
    F.lds = (LAS unsigned char*)lds_raw;
    F.MISC = (volatile LAS unsigned*)(F.lds + L_MISC);
    F.wave = __builtin_amdgcn_readfirstlane((int)(threadIdx.x >> 6));
    F.G = gridDim.x; { const int bx = blockIdx.x; F.vcu = (F.G % 8 == 0) ? (bx % 8) * (F.G / 8) + bx / 8 : bx; }
    unsigned char* ws = args.ws;
    F.ctl = (unsigned*)(ws + WS_CTL);
    F.ws = ws;
    for (int u = F.tid(); u < (LDS_BYTES - RING_BYTES) / 4; u += NWAVES * 64) ((LAS unsigned*)(F.lds + RING_BYTES))[u] = 0u;
    __syncthreads();
    if (F.tid() == 0) { LAS unsigned long long* pp = (LAS unsigned long long*)(F.lds + L_MISC + 160);
        pp[0] = (unsigned long long)args.in[I_WG]; pp[1] = (unsigned long long)args.in[I_WU]; pp[2] = (unsigned long long)args.in[I_WD]; pp[3] = (unsigned long long)args.in[I_NFFN]; pp[4] = (unsigned long long)ws; }
    __syncthreads();
#if MK_LAUNCHES == 1
    XcdBarrier bar = xcd_barrier_post((unsigned*)(F.ctl + CW_BAR), F.MISC + 8);
#define GRID_BAR() xcd_barrier(bar)
#else
#define GRID_BAR() do { } while (0)
#endif
    const int lo = args.ph_lo, hi = args.ph_hi;
#define IN(k) (lo <= (k) && (k) < hi)
#define BOTH(k) (IN(k) && IN((k) + 1))
#define DUP(k) (PROBE_DUP == (k))
    const int c = (int)blockIdx.x;

    PT_MARK(0, 0);
    if (IN(0)) { p0_prologue(F, args); p0_probe(F, args); if (DUP(0)) { GRID_BAR(); p0_prologue(F, args); } if (BOTH(0)) GRID_BAR(); }
    PT_MARK(0, 1);
    PT_MARK(1, 0);
    if (IN(1)) { PT_MARK(35, 0); p1_phase(F, args, c); PT_MARK(35, 1); if (DUP(1)) { GRID_BAR(); p1_phase(F, args, c); } if (BOTH(1)) GRID_BAR(); }
    PT_MARK(1, 1);
    PT_MARK(2, 0);
    if (IN(2)) { p2_phase(F, args); if (DUP(2)) { GRID_BAR(); p2_phase(F, args); } if (BOTH(2)) GRID_BAR(); }
    PT_MARK(2, 1);
    PT_MARK(3, 0);
    if (IN(3)) { p3_phase(F, c); if (DUP(3)) { GRID_BAR(); p3_phase(F, c); } if (BOTH(3)) GRID_BAR(); }
    PT_MARK(3, 1);
    PT_MARK(4, 0);
    if (IN(4)) { p4_phase(F, args, c); if (DUP(4)) { GRID_BAR(); p4_phase(F, args, c); } if (BOTH(4)) GRID_BAR(); }
    PT_MARK(4, 1);
    PT_MARK(5, 0);
    if (IN(5)) { if (F.vcu < M / 64) router_group(F, args, F.vcu); if (DUP(5)) { GRID_BAR(); if (F.vcu < M / 64) router_group(F, args, F.vcu, 1); } if (BOTH(5)) GRID_BAR(); }
    PT_MARK(5, 1);
    PT_MARK(6, 0);
    if (IN(6)) { p6_phase(F); if (DUP(6)) { GRID_BAR(); p6_phase(F); } if (BOTH(6)) GRID_BAR(); }
    PT_MARK(6, 1);
    PT_MARK(7, 0);
    if (IN(7)) { p7_phase(F); if (DUP(7)) { GRID_BAR(); p7_phase(F); } if (BOTH(7)) GRID_BAR(); }
    PT_MARK(7, 1);
    PT_MARK(8, 0);
    if (IN(8)) { p8_phase(F, args); if (DUP(8)) { GRID_BAR(); p8_phase(F, args); } }
    PT_MARK(8, 1);
#if PROBE_TIME >= 0
    if (PROBE_SET((int)blockIdx.x) && F.tid() == 0) { const unsigned long long pt0 = ((unsigned long long)F.MISC[33] << 32) | F.MISC[32], pt1 = ((unsigned long long)F.MISC[35] << 32) | F.MISC[34];
        const unsigned long long te = __builtin_amdgcn_s_memrealtime(), d = 4ull * (pt1 - pt0); while (__builtin_amdgcn_s_memrealtime() - te < d) __builtin_amdgcn_s_sleep(8); }
#endif
#undef IN
#undef BOTH
#undef DUP
}

extern "C" void kernel_launch(void* const* d_in, const int* in_sizes, int n_in, void* d_out, int out_size, void* d_ws, size_t ws_size, hipStream_t stream) {
    static int grid = 0;
    if (grid == 0) {
        if (n_in != 20 || out_size != M * DM || ws_size < WS_END + (PROBE_DUP == 5 ? 16 * MiB : 0)) { fprintf(stderr, "kernel_launch: unexpected shapes (n_in %d, out %d, ws %zu); nothing launched\n", n_in, out_size, ws_size); grid = -1; return; }
        int dev = 0, cus = 0, per_cu = 0;
        if (hipGetDevice(&dev) != hipSuccess || hipDeviceGetAttribute(&cus, hipDeviceAttributeMultiprocessorCount, dev) != hipSuccess) { grid = -1; return; }
        if (hipFuncSetAttribute((const void*)mega_fwd, hipFuncAttributeMaxDynamicSharedMemorySize, LDS_BYTES) != hipSuccess) { fprintf(stderr, "kernel_launch: hipFuncSetAttribute failed\n"); grid = -1; return; }
        if (hipOccupancyMaxActiveBlocksPerMultiprocessor(&per_cu, (const void*)mega_fwd, NWAVES * 64, LDS_BYTES) != hipSuccess || per_cu < 1) { fprintf(stderr, "kernel_launch: occupancy query says %d\n", per_cu); }
        (void)hipGetLastError();
        grid = cus;
        if (grid != 256) { fprintf(stderr, "kernel_launch: built for 256 CUs, device has %d; nothing launched\n", grid); grid = -1; return; }
    }
    if (grid < 0) return;
    (void)hipMemsetAsync((char*)d_ws + WS_CTL, 0, CTL_ZERO_BYTES, stream);
    Args a{};
    for (int i = 0; i < 20; ++i) a.in[i] = (const float*)d_in[i];
    a.out = (float*)d_out; a.ws = (unsigned char*)d_ws;
#if MK_LAUNCHES == 1
    a.ph_lo = 0; a.ph_hi = NPHASE;
    hipLaunchKernelGGL(mega_fwd, dim3(grid), dim3(NWAVES * 64), LDS_BYTES, stream, a);
#else
    for (int p = 0; p < NPHASE; ++p) { a.ph_lo = p; a.ph_hi = p + 1; hipLaunchKernelGGL(mega_fwd, dim3(grid), dim3(NWAVES * 64), LDS_BYTES, stream, a); }
#endif
}
```

```cpp
#include <hip/hip_runtime.h>
#include <cstdio>
#include <cstdint>

#define GAS __attribute__((address_space(1)))
#define LAS __attribute__((address_space(3)))
typedef unsigned short bf16;
typedef short bf16x8 __attribute__((ext_vector_type(8)));
typedef float f32x2 __attribute__((ext_vector_type(2)));
typedef float f32x4 __attribute__((ext_vector_type(4)));
typedef float f32x16 __attribute__((ext_vector_type(16)));
typedef unsigned u32x2 __attribute__((ext_vector_type(2)));
typedef unsigned u32x4 __attribute__((ext_vector_type(4)));
typedef int i32x4 __attribute__((ext_vector_type(4)));

#ifndef MK_LAUNCHES
#define MK_LAUNCHES 1
#endif
#ifndef PROBE_DUP
#define PROBE_DUP -1
#endif
#ifndef PROBE_SUB
#define PROBE_SUB 0
#endif
#define PROBE_SET(b) ((b) >= 0 && (b) < 1)
#define PROBE_MULT 4
#define STAG_NPRE(c, n) (((c) & 1) ? (n) : 0)
#define CVT_P2_N 0
#define CVT_P3_N 0
#define CVT_P4_N 6
#define CVT_P1_LO 12
#define CVT_P1_HI 20
#define CVT_P1_ADJ8 0x66788aa9u
#define CVT_P1_ADJ7 0x5679aa9u
constexpr int CVT_P1_ITEMS = 64 * CVT_P1_LO + 192 * CVT_P1_HI;
static_assert(CVT_P1_ITEMS + 256 * (CVT_P2_N + CVT_P3_N + CVT_P4_N) == 6144, "expert weight items");
#define STAG_TEST 0
#define P2_ALT 1
#define PROBE_REP 1
#ifndef PROBE_TIME
#define PROBE_TIME -1
#endif
constexpr int NPHASE = 9;

constexpr int DM = 2048, SEQ = 8192, M = 16384;
constexpr int NMETA = 16, MROWS = M + 256;
constexpr int INW = 6400, KOFF = 1024, VOFF = 1152, UOFF = 1280, GAOFF = 2304, GPOFF = 4352;
constexpr int PW = 2304, GW = 4096;
constexpr int NEXP = 64, DEXP = 512, CAP = 16384;
constexpr float RMS_EPS = 1e-6f;

constexpr size_t MiB = 1u << 20;
constexpr size_t WS_CTL = 0, CTL_ZERO_BYTES = 32 * 1024;
constexpr size_t WS_WIN = 1 * MiB;
constexpr size_t WS_WAB = 26 * MiB;
constexpr size_t WS_WPT = 34 * MiB;
constexpr size_t WS_WO = 38 * MiB;
constexpr size_t WS_PMS = 46 * MiB;
constexpr size_t WS_WR = 46 * MiB + 512 * 1024;
constexpr size_t WS_SSQ = 47 * MiB;
constexpr size_t WS_LTOK = 49 * MiB, WS_LR = 53 * MiB, WS_LW = 57 * MiB;
constexpr size_t WS_TINFO = 61 * MiB;
constexpr size_t WS_WGU = 64 * MiB;
constexpr size_t WS_WIN8 = 13 * MiB;
constexpr size_t WS_HN8 = 416 * MiB;
constexpr size_t WS_H8 = 384 * MiB;
constexpr size_t WS_WD = 320 * MiB;
constexpr size_t WS_HN = 448 * MiB;
constexpr size_t WS_PROJ = 513 * MiB;
constexpr size_t WS_GATE = 593 * MiB;
constexpr size_t WS_AP = 717 * MiB;
constexpr size_t WS_H1 = 781 * MiB;
constexpr size_t WS_END = 909 * MiB;
constexpr int CW_TMO = 0, CW_CNT = 1024  , CNT_STRIDE = 32  , CW_BAR = 4096;
static_assert(CW_CNT + 64 * CNT_STRIDE <= CW_BAR, "counters");

constexpr int RING_BYTES = 131072, RING_OFF = 512;
constexpr int L_MISC = RING_OFF + RING_BYTES;
constexpr int L_ESTART = L_MISC + 256;
constexpr int L_TSTART = L_ESTART + 320;
constexpr int L_UD = L_TSTART + 320;
constexpr int L_TAB = L_UD + 256;
constexpr int L_CVT = L_TAB + 8192;
constexpr int LDS_BYTES = 157696;
static_assert(L_CVT + 16384 <= LDS_BYTES && LDS_BYTES <= 163840, "LDS map");

#define LDS_WAIT() asm volatile("s_waitcnt lgkmcnt(0)" ::: "memory")
#define VM_WAIT() asm volatile("s_waitcnt vmcnt(0)" ::: "memory")
__device__ __forceinline__ unsigned cvt_pk_bf16(float lo, float hi) { unsigned r; asm volatile("v_cvt_pk_bf16_f32 %0, %1, %2" : "=v"(r) : "v"(lo), "v"(hi)); return r; }
__device__ __forceinline__ float bf_lo(unsigned w) { return __uint_as_float(w << 16); }
__device__ __forceinline__ float bf_hi(unsigned w) { return __uint_as_float(w & 0xffff0000u); }
__device__ __forceinline__ float sigmoidf_(float x) { return __builtin_amdgcn_rcpf(1.0f + __expf(-x)); }

namespace pg8 {
constexpr int BM = 256, BK = 64, HALF = 128, HTB = HALF * BK * 2, STAGE_BYTES = 8 * HTB, NXCD = 8, WGM = 8;
__host__ __device__ __forceinline__ int lds_byte(int r, int c) { const int st = (r >> 4) * 2 + (c >> 5), rr = r & 15, cc = c & 31, ob = rr * 64 + cc * 2; return st * 1024 + (ob ^ (((ob >> 9) & 1) << 5)); }
__host__ __device__ __forceinline__ void stage_rc(int b, int& R, int& C) { const int st = b / 1024, sb = b % 1024, swz = sb ^ (((sb >> 9) & 1) << 5); R = (st >> 1) * 16 + swz / 64; C = (st & 1) * 32 + (swz % 64) / 2; }
__host__ __device__ __forceinline__ int perm32(int rho) { const int n = rho >> 4, i = rho & 15; return 8 * (i >> 2) + 4 * n + (i & 3); }

struct Unit { const char* a; const char* b; int pm, pn, x0, x1; };

__device__ __forceinline__ void tile_of(int L, int nM, int nN, int& pm, int& pn) {
    const int nwg = nM * nN; int wgid = L;
    { const int q = nwg / NXCD, r = nwg % NXCD, xcd = wgid % NXCD, off = wgid / NXCD; wgid = (xcd < r ? xcd * (q + 1) : r * (q + 1) + (xcd - r) * q) + off; }
    const int nig = WGM * nN, gid = wgid / nig, fm = gid * WGM, gsz = (nM - fm) < WGM ? (nM - fm) : WGM;
    pm = fm + ((wgid % nig) % gsz); pn = (wgid % nig) / gsz;
}

typedef int i32x8 __attribute__((ext_vector_type(8)));
template <class Epi, class Sched, bool GATHER, bool HALFSKIP = false, bool FP8 = false>
__device__ __forceinline__ void gemm_phase(const int wid  , LAS unsigned char* lds, const int lda, const int ldb, const int K, const Sched& S, const Epi& E, LAS const unsigned* rowtab  ) {
    int lane = (int)__builtin_amdgcn_mbcnt_hi(~0u, __builtin_amdgcn_mbcnt_lo(~0u, 0u)); asm volatile("" : "+v"(lane));
    const int tid = wid * 64 + lane, wr = wid >> 2, wc = wid & 3, fr = lane & 15, fq = lane >> 4;
    const int nt = K / BK;
    unsigned voffB[2], voffBh[2], cv0[2], cv1[2], nv0[2], nv1[2]; int Rr[2]; unsigned Cc[2];
#pragma unroll
    for (int i = 0; i < 2; ++i) { int R, C; stage_rc(tid * 16 + i * 8192, R, C); const int Rb = (R & ~31) + perm32(R & 31);
        voffB[i] = (unsigned)(Rb * ldb + C) * 2u; voffBh[i] = voffB[i] + (unsigned)(HALF * ldb) * 2u; Rr[i] = R; Cc[i] = (unsigned)C * 2u;
        cv0[i] = (unsigned)(R * lda + C) * 2u; cv1[i] = cv0[i] + (unsigned)(HALF * lda) * 2u; nv0[i] = cv0[i]; nv1[i] = cv1[i]; }
    const size_t kstep = (size_t)(BK * 2);
    const unsigned ldsw = (unsigned)wid * 1024u;
    const int aoff = lds_byte(wr * 64 + fr, fq * 8), boff = lds_byte(wc * 32 + fr, fq * 8);
#define PG8_SA(b, h) (((b) * 2 + (h)) * HTB)
#define PG8_SB(b, h) ((4 + (b) * 2 + (h)) * HTB)
#define PG8_STAGE2O(bufoff, gbase, v0, v1, OFF) do { \
        __builtin_amdgcn_global_load_lds((const unsigned*)((const char*)(gbase) + (v0)), (LAS unsigned*)(lds + ((bufoff) - (OFF)) + ldsw), 16, OFF, 0); \
        __builtin_amdgcn_global_load_lds((const unsigned*)((const char*)(gbase) + (v1)), (LAS unsigned*)(lds + ((bufoff) - (OFF)) + ldsw + 8192), 16, OFF, 0); } while (0)
#define PG8_STAGE2(bufoff, gbase, v0, v1) PG8_STAGE2O(bufoff, gbase, v0, v1, 0)
#define PG8_STAGEB(bufoff, gbase) PG8_STAGE2(bufoff, gbase, voffB[0], voffB[1])
#define PG8_STAGEBO(bufoff, gbase, OFF) PG8_STAGE2O(bufoff, gbase, voffB[0], voffB[1], OFF)
#define PG8_STAGEBH(bufoff, gbase, OFF) PG8_STAGE2O(bufoff, gbase, voffBh[0], voffBh[1], OFF)
#define PG8_LDA(dst, b, h) do { if constexpr (FP8) { _Pragma("unroll") for (int m = 0; m < 4; ++m) dst##8[m] = *(const LAS i32x8*)(lds + PG8_SA(b, h) + aoff8 + m * 2048); } \
        else { _Pragma("unroll") for (int m = 0; m < 4; ++m) _Pragma("unroll") for (int k = 0; k < 2; ++k) dst[m][k] = *(const LAS bf16x8*)(lds + PG8_SA(b, h) + aoff + m * 2048 + k * 1024); } } while (0)
#define PG8_LDB(dst, b, h) do { if constexpr (FP8) { _Pragma("unroll") for (int n = 0; n < 2; ++n) dst##8[n] = *(const LAS i32x8*)(lds + PG8_SB(b, h) + boff8 + n * 2048); } \
        else { _Pragma("unroll") for (int n = 0; n < 2; ++n) _Pragma("unroll") for (int k = 0; k < 2; ++k) dst[n][k] = *(const LAS bf16x8*)(lds + PG8_SB(b, h) + boff + n * 2048 + k * 1024); } } while (0)
#define PG8_MMA(ai, bj, At, Bt) do { __builtin_amdgcn_s_setprio(1); \
        if constexpr (FP8) { _Pragma("unroll") for (int m = 0; m < 4; ++m) _Pragma("unroll") for (int n = 0; n < 2; ++n) \
            asm volatile("v_mfma_scale_f32_16x16x128_f8f6f4 %0, %1, %2, %0, %3, %3 op_sel_hi:[0,0,0]" : "+v"(acc[ai][bj][m][n]) : "v"(Bt##8[n]), "v"(At##8[m]), "v"(mxscale)); } \
        else { _Pragma("unroll") for (int m = 0; m < 4; ++m) _Pragma("unroll") for (int n = 0; n < 2; ++n) _Pragma("unroll") for (int k = 0; k < 2; ++k) \
            acc[ai][bj][m][n] = __builtin_amdgcn_mfma_f32_16x16x32_bf16(Bt[n][k], At[m][k], acc[ai][bj][m][n], 0, 0, 0); } __builtin_amdgcn_s_setprio(0); } while (0)
#define PG8_WAIT_V(n) asm volatile("s_waitcnt vmcnt(" #n ")" ::: "memory")
#define PG8_WAIT_L(n) asm volatile("s_waitcnt lgkmcnt(" #n ")" ::: "memory")
#define PG8_BAR __builtin_amdgcn_s_barrier()
#define PG8_SCHED __builtin_amdgcn_sched_barrier(0)
    Unit cur, nxt; int ui = 0;
    if (!S.next(0, cur)) return;
    if constexpr (GATHER) {
#pragma unroll
        for (int i = 0; i < 2; ++i) { cv0[i] = rowtab[Rr[i]] + Cc[i]; cv1[i] = rowtab[HALF + Rr[i]] + Cc[i]; }
    }
    f32x4 acc[2][2][4][2];
#pragma unroll
    for (int a = 0; a < 2; ++a)
#pragma unroll
        for (int b = 0; b < 2; ++b)
#pragma unroll
            for (int m = 0; m < 4; ++m)
#pragma unroll
                for (int n = 0; n < 2; ++n) acc[a][b][m][n] = (f32x4){0.f, 0.f, 0.f, 0.f};
    bf16x8 At[4][2], B0[2][2], B1[2][2];
    i32x8 At8[4], B08[2], B18[2];
    const int mxscale = 0x7f7f7f7f;
    const int aoff8 = ((fq >> 1) * 1024) + (((wr * 64 + fr) & 15) * 64 + (fq & 1) * 32 ^ (((((wr * 64 + fr) & 15) * 64) >> 9) & 1) << 5) + (((wr * 64 + fr) >> 4) * 2048);
    const int boff8 = ((fq >> 1) * 1024) + (((wc * 32 + fr) & 15) * 64 + (fq & 1) * 32 ^ (((((wc * 32 + fr) & 15) * 64) >> 9) & 1) << 5) + (((wc * 32 + fr) >> 4) * 2048);
    const char* cA = cur.a; const char* cB = cur.b;
    PG8_STAGEBO(PG8_SB(0, 0), cB, 0); PG8_STAGEBH(PG8_SB(0, 1), cB, 0); PG8_STAGE2(PG8_SA(0, 0), cA, cv0[0], cv0[1]); PG8_STAGE2(PG8_SA(0, 1), cA, cv1[0], cv1[1]);
    if (wr == 1) PG8_BAR;
    PG8_WAIT_V(2); PG8_BAR;
    PG8_STAGEBO(PG8_SB(1, 0), cB, 128); PG8_STAGE2O(PG8_SA(1, 0), cA, cv0[0], cv0[1], 128); PG8_STAGEBH(PG8_SB(1, 1), cB, 128);
    PG8_WAIT_V(6); PG8_BAR;
    for (;;) {
        const bool has_next = S.next(ui + 1, nxt);
        const bool skip_hi = HALFSKIP && cur.x0 <= 128;
        const char* nA = has_next ? nxt.a : cA; const char* nB = has_next ? nxt.b : cB;
        if constexpr (GATHER) {
            if (has_next) {
#pragma unroll
                for (int i = 0; i < 2; ++i) { nv0[i] = rowtab[(ui + 1) * 256 + Rr[i]] + Cc[i]; nv1[i] = rowtab[(ui + 1) * 256 + HALF + Rr[i]] + Cc[i]; }
            } else {
#pragma unroll
                for (int i = 0; i < 2; ++i) { nv0[i] = cv0[i]; nv1[i] = cv1[i]; }
            }
        }
#pragma unroll 1
        for (int t = 0; t < nt; t += 2) {
            const bool last = (t == nt - 2);
            if constexpr (Epi::HAS_MID) { if (t == Epi::MID_T) E.mid(acc, cur, wr, wc, fr, fq); }
            const char* pA = cA + (size_t)t * kstep; const char* pB = cB + (size_t)t * kstep;
            const char* qA = last ? nA - 256 : pA; const char* qB = last ? nB - 256 : pB;
            unsigned x00, x01, x10, x11;
            if constexpr (GATHER) { x00 = last ? nv0[0] : cv0[0]; x01 = last ? nv0[1] : cv0[1]; x10 = last ? nv1[0] : cv1[0]; x11 = last ? nv1[1] : cv1[1]; }
            else { x00 = cv0[0]; x01 = cv0[1]; x10 = cv1[0]; x11 = cv1[1]; }
            PG8_LDB(B0, 0, 0); PG8_LDB(B1, 0, 1); PG8_SCHED; PG8_LDA(At, 0, 0); PG8_STAGE2O(PG8_SA(1, 1), pA, cv1[0], cv1[1], 128);
            PG8_WAIT_V(8); PG8_WAIT_L(0); PG8_BAR; PG8_MMA(0, 0, At, B0); PG8_MMA(0, 1, At, B1); PG8_BAR; PG8_SCHED;
            PG8_LDA(At, 0, 1); PG8_STAGEBO(PG8_SB(0, 0), qB, 256); PG8_STAGEBH(PG8_SB(0, 1), qB, 256); PG8_STAGE2O(PG8_SA(0, 0), qA, x00, x01, 256);
            PG8_WAIT_V(8); PG8_WAIT_L(0); PG8_BAR; if (!skip_hi) { PG8_MMA(1, 0, At, B0); PG8_MMA(1, 1, At, B1); } PG8_BAR; PG8_SCHED;
            PG8_LDB(B0, 1, 0); PG8_LDB(B1, 1, 1); PG8_SCHED; PG8_LDA(At, 1, 0); PG8_STAGE2O(PG8_SA(0, 1), qA, x10, x11, 256);
            PG8_WAIT_V(8); PG8_WAIT_L(0); PG8_BAR; PG8_MMA(0, 0, At, B0); PG8_MMA(0, 1, At, B1); PG8_BAR; PG8_SCHED;
            PG8_LDA(At, 1, 1); PG8_STAGEBO(PG8_SB(1, 0), qB, 384); PG8_STAGEBH(PG8_SB(1, 1), qB, 384); PG8_STAGE2O(PG8_SA(1, 0), qA, x00, x01, 384);
            PG8_WAIT_V(8); PG8_WAIT_L(0); PG8_BAR; if (!skip_hi) { PG8_MMA(1, 0, At, B0); PG8_MMA(1, 1, At, B1); } PG8_BAR; PG8_SCHED;
        }
        if (wr == 0) PG8_BAR;
        if constexpr (FP8) asm volatile("s_nop 15\n\ts_nop 15" ::: "memory");
        E(acc, cur, ui, wr, wc, fr, fq);
        if constexpr (Epi::HAS_POST) E.post(ui);
        if (!has_next) break;
#pragma unroll
        for (int a = 0; a < 2; ++a)
#pragma unroll
            for (int b = 0; b < 2; ++b)
#pragma unroll
                for (int m = 0; m < 4; ++m)
#pragma unroll
                    for (int n = 0; n < 2; ++n) acc[a][b][m][n] = (f32x4){0.f, 0.f, 0.f, 0.f};
        cur = nxt; cA = nA; cB = nB; ++ui;
        if constexpr (GATHER) {
#pragma unroll
            for (int i = 0; i < 2; ++i) { cv0[i] = nv0[i]; cv1[i] = nv1[i]; }
        }
        if (wr == 1) PG8_BAR;
    }
    PG8_WAIT_V(0);
    PG8_BAR;
#undef PG8_SA
#undef PG8_SB
#undef PG8_STAGE2
#undef PG8_STAGE2O
#undef PG8_STAGEB
#undef PG8_STAGEBO
#undef PG8_STAGEBH
#undef PG8_LDA
#undef PG8_LDB
#undef PG8_MMA
#undef PG8_WAIT_V
#undef PG8_WAIT_L
#undef PG8_BAR
#undef PG8_SCHED
}
}

#define XB_TMO      128
#define XB_XCNT(j)  (256  + 64 * (j))
#define XB_XSUB(j)  (1280 + 64 * (j))
#define XB_XGEN(j)  (2304 + 64 * (j))
#define XB_TOP      3328
#define XB_TOPGEN   3392
#define XCD_BAR_WORDS 3456
#define XB_SPIN_CAP (1u << 18)

__device__ __forceinline__ unsigned xb_ld(unsigned* p)              { return __hip_atomic_load(p, __ATOMIC_RELAXED, __HIP_MEMORY_SCOPE_AGENT); }
__device__ __forceinline__ unsigned xb_add(unsigned* p, unsigned v) { return __hip_atomic_fetch_add(p, v, __ATOMIC_RELAXED, __HIP_MEMORY_SCOPE_AGENT); }
__device__ __forceinline__ unsigned xb_xcc_id() { return (unsigned)__builtin_amdgcn_s_getreg((3 << 11) | 20) & 0xFu; }
#define XB_SPIN(cond, bar) do { unsigned _sp = 0; while (cond) { __builtin_amdgcn_s_sleep(1); \
    if ((++_sp & 255u) == 0u) { if (xb_ld(&(bar)[XB_TMO])) break; if (_sp > XB_SPIN_CAP) { atomicAdd(&(bar)[XB_TMO], 1u); break; } } } } while (0)

struct XcdBarrier {
    unsigned* bar; unsigned x; unsigned w;
    volatile LAS unsigned* st;
};

__device__ __forceinline__ XcdBarrier xcd_barrier_post(unsigned* bar, volatile LAS unsigned* st) {
    XcdBarrier b; b.bar = bar; b.x = xb_xcc_id(); b.st = st; b.w = (unsigned)__builtin_amdgcn_readfirstlane((int)(threadIdx.x >> 6));
    if (threadIdx.x == 0) (void)xb_add(&bar[XB_XCNT(b.x)], 1u);
    return b;
}
__device__ __forceinline__ void xcd_barrier_complete(unsigned* bar, unsigned x, unsigned& nloc, unsigned& nx) {
    const unsigned G = gridDim.x * gridDim.y * gridDim.z;
    unsigned sum, cnt, mine, sp = 0u;
    for (;;) {
        sum = 0u; cnt = 0u; mine = 0u;
#pragma unroll
        for (unsigned j = 0; j < 16; ++j) { const unsigned c = xb_ld(&bar[XB_XCNT(j)]); sum += c; cnt += (c > 0u) ? 1u : 0u; mine = (j == x) ? c : mine; }
        if (sum == G) break;
        __builtin_amdgcn_s_sleep(1);
        if ((++sp & 255u) == 0u) { if (xb_ld(&bar[XB_TMO])) break; if (sp > XB_SPIN_CAP) { atomicAdd(&bar[XB_TMO], 1u); break; } }
    }
    nloc = mine > 0u ? mine : 1u; nx = cnt > 0u ? cnt : 1u;
}

__device__ __forceinline__ void xcd_barrier(const XcdBarrier& b) {
    asm volatile("s_waitcnt vmcnt(0)" ::: "memory");
    __syncthreads();
    if (b.w == 0u && __builtin_amdgcn_mbcnt_hi(~0u, __builtin_amdgcn_mbcnt_lo(~0u, 0u)) == 0u) {
        unsigned* bar = b.bar;
        __builtin_amdgcn_s_waitcnt(0);
        unsigned nloc = b.st[0], nx = b.st[1];
        if (nloc == 0u) { xcd_barrier_complete(bar, b.x, nloc, nx); b.st[0] = nloc; b.st[1] = nx; }
        const unsigned old = xb_add(&bar[XB_XSUB(b.x)], 1u);
        const unsigned gen = old / nloc;
        if (old + 1u == (gen + 1u) * nloc) {
            __builtin_amdgcn_fence(__ATOMIC_RELEASE, "agent");
            asm volatile("s_waitcnt vmcnt(0)" ::: "memory");
            const unsigned og = xb_add(&bar[XB_TOP], 1u);
            const unsigned tg = og / nx;
            if (og + 1u == (tg + 1u) * nx) xb_add(&bar[XB_TOPGEN], 1u);
            else XB_SPIN(xb_ld(&bar[XB_TOPGEN]) == tg, bar);
            __builtin_amdgcn_fence(__ATOMIC_ACQUIRE, "agent");
            xb_add(&bar[XB_XGEN(b.x)], 1u);
            asm volatile("s_waitcnt vmcnt(0)" ::: "memory");
        } else {
            XB_SPIN(xb_ld(&bar[XB_XGEN(b.x)]) == gen, bar);
            __builtin_amdgcn_fence(__ATOMIC_ACQUIRE, "agent");
            asm volatile("s_waitcnt vmcnt(0)" ::: "memory");
        }
    }
    __syncthreads();
}

constexpr int NWAVES = 8;
#if PROBE_TIME >= 0
#define PT_MARK(k, e) do { if ((k) == PROBE_TIME && PROBE_SET((int)blockIdx.x) && __builtin_amdgcn_mbcnt_hi(~0u, __builtin_amdgcn_mbcnt_lo(~0u, 0u)) == 0u) {        const unsigned long long t_ = __builtin_amdgcn_s_memrealtime(); volatile LAS unsigned* m_ = (volatile LAS unsigned*)(unsigned)L_MISC;        m_[32 + 2 * (e)] = (unsigned)t_; m_[33 + 2 * (e)] = (unsigned)(t_ >> 32); } } while (0)
#else
#define PT_MARK(k, e) do { } while (0)
#endif
struct Args { const float* in[20]; float* out; unsigned char* ws; int ph_lo, ph_hi; };
enum { I_X = 0, I_META, I_RELB, I_NMIX, I_WIN, I_SINK, I_PMIX, I_PSCL, I_WAB, I_WPB, I_WOUT, I_NFFN, I_WRG, I_BRG, I_WRE, I_BRE, I_WG, I_WU, I_WD, I_NFIN };
struct Frame {
    LAS unsigned char* lds;
    volatile LAS unsigned* MISC;
    unsigned* ctl;
    int wave, vcu, G;
    __device__ __forceinline__ int lane() const { int t = (int)__builtin_amdgcn_mbcnt_hi(~0u, __builtin_amdgcn_mbcnt_lo(~0u, 0u)); asm volatile("" : "+v"(t)); return t; }
    __device__ __forceinline__ int tid() const { return wave * 64 + lane(); }
    unsigned char* ws;
#define WSP(name, T, off) __device__ __forceinline__ T* name() const { return (T*)(ws + (off)); }
    WSP(WIN, bf16, WS_WIN) WSP(WAB, bf16, WS_WAB) WSP(WPT, bf16, WS_WPT) WSP(WO, bf16, WS_WO) WSP(PMS, bf16, WS_PMS) WSP(WR, bf16, WS_WR) WSP(WGU, bf16, WS_WGU) WSP(WD, bf16, WS_WD)
    WSP(HN, bf16, WS_HN) WSP(PROJ, bf16, WS_PROJ) WSP(AP, bf16, WS_AP) WSP(MERGED, bf16, WS_HN) WSP(H1B, bf16, WS_AP) WSP(HID, bf16, WS_HN) WSP(Y, bf16, WS_PROJ)
    WSP(SSQ, float, WS_SSQ) WSP(H1, float, WS_H1) WSP(LR, float, WS_LR) WSP(LW, float, WS_LW) WSP(LTOK, int, WS_LTOK) WSP(TINFO, i32x4, WS_TINFO) WSP(GATE, unsigned char, WS_GATE) WSP(H8, unsigned char, WS_H8) WSP(HN8, unsigned char, WS_HN8) WSP(WIN8, unsigned char, WS_WIN8)
#undef WSP
};

__device__ __forceinline__ int lane_id() { int l = (int)__builtin_amdgcn_mbcnt_hi(~0u, __builtin_amdgcn_mbcnt_lo(~0u, 0u)); asm volatile("" : "+v"(l)); return l; }
__device__ __forceinline__ float wave_sum(float v) {
#pragma unroll
    for (int o = 1; o < 64; o <<= 1) v += __shfl_xor(v, o);
    return v;
}

template <bool SCALE>
__device__ __forceinline__ void p0_item(const float* W, int N, int k0, int n0, bf16* WT, int ldt, int wrow0, const float* ks, LAS float* scr, int lane) {
#pragma unroll 8
    for (int i = 0; i < 32; ++i) { const int kk = 2 * i + (lane >> 5); float v = W[(size_t)(k0 + kk) * N + n0 + (lane & 31)]; if constexpr (SCALE) v *= ks[k0 + kk]; scr[kk * 33 + (lane & 31)] = v; }
    LDS_WAIT(); asm volatile("" ::: "memory");
    const int c = lane & 7;
#pragma unroll
    for (int j = 0; j < 4; ++j) { const int n = (lane >> 3) + 8 * j; const LAS float* s = scr + (8 * c) * 33 + n;
        u32x4 o; o.x = cvt_pk_bf16(s[0 * 33], s[1 * 33]); o.y = cvt_pk_bf16(s[2 * 33], s[3 * 33]); o.z = cvt_pk_bf16(s[4 * 33], s[5 * 33]); o.w = cvt_pk_bf16(s[6 * 33], s[7 * 33]);
        *(u32x4*)(WT + (size_t)(wrow0 + n) * ldt + k0 + 8 * c) = o; }
    LDS_WAIT(); asm volatile("" ::: "memory");
}
__device__ __forceinline__ void p0_item8(const float* W, int N, int k0, int n0, unsigned char* WT, int ldt, int wrow0, float scl, LAS float* scr, int lane) {
#pragma unroll 8
    for (int i = 0; i < 32; ++i) { const int kk = 2 * i + (lane >> 5); scr[kk * 33 + (lane & 31)] = W[(size_t)(k0 + kk) * N + n0 + (lane & 31)] * scl; }
    LDS_WAIT(); asm volatile("" ::: "memory");
    const int c = lane & 7;
#pragma unroll
    for (int j = 0; j < 4; ++j) { const int n = (lane >> 3) + 8 * j; const LAS float* s = scr + (8 * c) * 33 + n;
        int p0 = __builtin_amdgcn_cvt_pk_fp8_f32(s[0 * 33], s[1 * 33], 0, false); p0 = __builtin_amdgcn_cvt_pk_fp8_f32(s[2 * 33], s[3 * 33], p0, true);
        int p1 = __builtin_amdgcn_cvt_pk_fp8_f32(s[4 * 33], s[5 * 33], 0, false); p1 = __builtin_amdgcn_cvt_pk_fp8_f32(s[6 * 33], s[7 * 33], p1, true);
        *(u32x2*)(WT + (size_t)(wrow0 + n) * ldt + k0 + 8 * c) = (u32x2){(unsigned)p0, (unsigned)p1}; }
    LDS_WAIT(); asm volatile("" ::: "memory");
}
template <int NR>
__device__ __forceinline__ void rms_rows_to_bf16(const float* const (&xrow)[NR], const float* g, bf16* const (&orow)[NR], unsigned char* const (&o8row)[NR], int lane) {
    const f32x4* gr = (const f32x4*)g + lane;
    f32x4 v[NR][8]; float r[NR];
#pragma unroll
    for (int q = 0; q < NR; ++q) { const f32x4* xr = (const f32x4*)xrow[q] + lane;
#pragma unroll
        for (int j = 0; j < 8; ++j) v[q][j] = xr[64 * j]; }
#pragma unroll
    for (int q = 0; q < NR; ++q) { float s = 0.f;
#pragma unroll
        for (int j = 0; j < 8; ++j) s += (v[q][j].x * v[q][j].x + v[q][j].y * v[q][j].y) + (v[q][j].z * v[q][j].z + v[q][j].w * v[q][j].w);
        r[q] = 1.0f / sqrtf(wave_sum(s) * (1.0f / DM) + RMS_EPS); }
#pragma unroll
    for (int j = 0; j < 8; ++j) { const f32x4 gg = gr[64 * j];
#pragma unroll
        for (int q = 0; q < NR; ++q) { const float y0 = v[q][j].x * r[q] * gg.x, y1 = v[q][j].y * r[q] * gg.y, y2 = v[q][j].z * r[q] * gg.z, y3 = v[q][j].w * r[q] * gg.w;
            u32x2 w; w.x = cvt_pk_bf16(y0, y1); w.y = cvt_pk_bf16(y2, y3); ((u32x2*)orow[q] + lane)[64 * j] = w;
            if (o8row[q]) { const float z0 = __builtin_fminf(__builtin_fmaxf(y0 * 8.0f, -448.0f), 448.0f), z1 = __builtin_fminf(__builtin_fmaxf(y1 * 8.0f, -448.0f), 448.0f), z2 = __builtin_fminf(__builtin_fmaxf(y2 * 8.0f, -448.0f), 448.0f), z3 = __builtin_fminf(__builtin_fmaxf(y3 * 8.0f, -448.0f), 448.0f);
                int p = __builtin_amdgcn_cvt_pk_fp8_f32(z0, z1, 0, false); p = __builtin_amdgcn_cvt_pk_fp8_f32(z2, z3, p, true); ((unsigned*)o8row[q])[lane + 64 * j] = (unsigned)p; } } }
}

struct CvtJob { const float *wg, *wu, *wd, *ks; bf16 *WGU, *WD; int first, count, slot, wave; LAS unsigned char* scr; };
constexpr int CVT_ITEMS = 3 * 2048;
__device__ __forceinline__ void cvt_decode(const CvtJob& J, int q, int wave, const float*& W, int& N, bf16*& WT, int& ldt, int& wrow0, int& k0, bool& scale) {
    const int seg = q >> 11, r = q & 2047, e = r >> 5;
    if (seg < 2) { const int kb = r & 31, n0 = 64 * wave; k0 = 64 * kb; N = 512; ldt = 2048; scale = true;
        W = (seg ? J.wu : J.wg) + (size_t)e * 2048 * 512 + n0; WT = (bf16*)((unsigned char*)J.WGU + (size_t)e * 1024 * 2048); wrow0 = 256 * (n0 >> 7) + (n0 & 127) + (seg ? 128 : 0); }
    else { const int nq = (r >> 3) & 3, kb = r & 7, n0 = 512 * nq + 64 * wave; k0 = 64 * kb; N = 2048; ldt = 512; scale = false;
        W = J.wd + (size_t)e * 512 * 2048 + n0; WT = (bf16*)((unsigned char*)J.WD + (size_t)e * 2048 * 512); wrow0 = n0; }
}
__device__ __forceinline__ void cvt_load(f32x4 (&v)[16], const float* W, int N, int k0, int lane) {
    const float* p = W + (size_t)(k0 + 8 * (lane >> 4)) * N + 4 * (lane & 15);
#pragma unroll
    for (int i = 0; i < 16; ++i) v[i] = __builtin_nontemporal_load((const f32x4*)(p + (size_t)(i + (i >> 3) * 24) * N));
}
__device__ __forceinline__ void cvt_store(const f32x4 (&v)[16], bf16* WT, int ldt, int wrow0, int k0, const float* ks, bool scale, LAS unsigned char* scr  , int lane) {
    const int nl = lane & 15, kg = lane >> 4, kq = k0 + 8 * kg;
    float s[16];
    if (scale) {
#pragma unroll
        for (int i = 0; i < 4; ++i) { const f32x4 t = *(const f32x4*)(ks + kq + 4 * (i & 1) + 32 * (i >> 1)); s[4 * i] = t.x; s[4 * i + 1] = t.y; s[4 * i + 2] = t.z; s[4 * i + 3] = t.w; }
    } else {
#pragma unroll
        for (int i = 0; i < 16; ++i) s[i] = 1.0f;
    }
    LAS unsigned char* wp0 = scr + 128 * nl + 16 * (kg ^ (nl & 7)); LAS unsigned char* wp1 = scr + 128 * nl + 16 * ((4 + kg) ^ (nl & 7));
    const int R = lane >> 3, p = lane & 7;
    LAS const unsigned char* rp = scr + 128 * R + 16 * (p ^ (R & 7));
#pragma unroll
    for (int j = 0; j < 4; ++j) {
        u32x4 o0, o1;
        o0.x = cvt_pk_bf16(v[0][j] * s[0], v[1][j] * s[1]); o0.y = cvt_pk_bf16(v[2][j] * s[2], v[3][j] * s[3]); o0.z = cvt_pk_bf16(v[4][j] * s[4], v[5][j] * s[5]); o0.w = cvt_pk_bf16(v[6][j] * s[6], v[7][j] * s[7]);
        o1.x = cvt_pk_bf16(v[8][j] * s[8], v[9][j] * s[9]); o1.y = cvt_pk_bf16(v[10][j] * s[10], v[11][j] * s[11]); o1.z = cvt_pk_bf16(v[12][j] * s[12], v[13][j] * s[13]); o1.w = cvt_pk_bf16(v[14][j] * s[14], v[15][j] * s[15]);
        *(LAS u32x4*)wp0 = o0; *(LAS u32x4*)wp1 = o1;
        LDS_WAIT();
        const u32x4 a = *(LAS const u32x4*)rp, b = *(LAS const u32x4*)(rp + 1024);
        LDS_WAIT();
        bf16* dst = WT + (size_t)(wrow0 + 4 * R + j) * ldt + k0 + 8 * p;
        __builtin_nontemporal_store(a, (u32x4*)dst); __builtin_nontemporal_store(b, (u32x4*)(dst + (size_t)32 * ldt));
    }
}
__device__ __forceinline__ void cvt_store8(const f32x4 (&v)[16], unsigned char* WT, int ldt, int wrow0, int k0, const float* ks  , float scl, LAS unsigned char* scr, int lane) {
    const int nl = lane & 15, kg = lane >> 4, R = lane >> 2, p = lane & 3, kq = k0 + 8 * kg;
    float s[16];
    if (ks) {
#pragma unroll
        for (int i = 0; i < 4; ++i) { const f32x4 t = *(const f32x4*)(ks + kq + 4 * (i & 1) + 32 * (i >> 1)); s[4 * i] = t.x * scl; s[4 * i + 1] = t.y * scl; s[4 * i + 2] = t.z * scl; s[4 * i + 3] = t.w * scl; }
    } else {
#pragma unroll
        for (int i = 0; i < 16; ++i) s[i] = scl;
    }
    LAS unsigned char* wp = scr + 80 * nl + 8 * kg; LAS const unsigned char* rp = scr + 80 * R + 16 * p;
#pragma unroll
    for (int j = 0; j < 4; ++j) {
        int a0 = __builtin_amdgcn_cvt_pk_fp8_f32(v[0][j] * s[0], v[1][j] * s[1], 0, false); a0 = __builtin_amdgcn_cvt_pk_fp8_f32(v[2][j] * s[2], v[3][j] * s[3], a0, true);
        int a1 = __builtin_amdgcn_cvt_pk_fp8_f32(v[4][j] * s[4], v[5][j] * s[5], 0, false); a1 = __builtin_amdgcn_cvt_pk_fp8_f32(v[6][j] * s[6], v[7][j] * s[7], a1, true);
        int b0 = __builtin_amdgcn_cvt_pk_fp8_f32(v[8][j] * s[8], v[9][j] * s[9], 0, false); b0 = __builtin_amdgcn_cvt_pk_fp8_f32(v[10][j] * s[10], v[11][j] * s[11], b0, true);
        int b1 = __builtin_amdgcn_cvt_pk_fp8_f32(v[12][j] * s[12], v[13][j] * s[13], 0, false); b1 = __builtin_amdgcn_cvt_pk_fp8_f32(v[14][j] * s[14], v[15][j] * s[15], b1, true);
        *(LAS u32x2*)wp = (u32x2){(unsigned)a0, (unsigned)a1}; *(LAS u32x2*)(wp + 32) = (u32x2){(unsigned)b0, (unsigned)b1};
        LDS_WAIT();
        const u32x4 o = *(LAS const u32x4*)rp;
        LDS_WAIT();
        __builtin_nontemporal_store(o, (u32x4*)(WT + (size_t)(wrow0 + 4 * R + j) * ldt + k0 + 16 * p));
    }
}
__device__ __forceinline__ void cvt_run_job(const CvtJob& J, int lane) {
    int q = J.first; const int qe = J.first + J.count;
    for (; q + 1 < qe; q += 2) {
        const float *W0, *W1; bf16 *T0, *T1; int N0, N1, l0, l1, r0, r1, k0, k1; bool s0, s1;
        cvt_decode(J, q, J.wave, W0, N0, T0, l0, r0, k0, s0); cvt_decode(J, q + 1, J.wave, W1, N1, T1, l1, r1, k1, s1);
        f32x4 va[16], vb[16]; cvt_load(va, W0, N0, k0, lane); cvt_load(vb, W1, N1, k1, lane);
        cvt_store8(va, (unsigned char*)T0, l0, r0, k0, s0 ? J.ks : nullptr, s0 ? 1024.0f : 512.0f, J.scr, lane); cvt_store8(vb, (unsigned char*)T1, l1, r1, k1, s1 ? J.ks : nullptr, s1 ? 1024.0f : 512.0f, J.scr, lane);
    }
    if (q < qe) { const float* W0; bf16* T0; int N0, l0, r0, k0; bool s0; cvt_decode(J, q, J.wave, W0, N0, T0, l0, r0, k0, s0);
        f32x4 va[16]; cvt_load(va, W0, N0, k0, lane); cvt_store8(va, (unsigned char*)T0, l0, r0, k0, s0 ? J.ks : nullptr, s0 ? 1024.0f : 512.0f, J.scr, lane); }
}

__device__ __forceinline__ void p0_prologue(Frame& F, const Args& A) {
    LAS unsigned char* scr = F.lds + F.wave * 2048;
    const int lane = lane_id();
    const int gw = F.vcu * NWAVES + F.wave, NGW = F.G * NWAVES;
    constexpr int J_IN = 32 * 100, J_AB = 16 * 32, J_PB = 16 * 32, J_WO = 32 * 32, J_WR = 32  , NJ = J_IN + J_AB + J_PB + J_WO + J_WR;
    PT_MARK(10, 0);
    auto src_of = [&](int it, const float*& W, int& N, int& k0) { int r = it;
        if (r < J_IN) { const int kb = r / 100, nb = r % 100; W = A.in[I_WIN] + 64 * nb; N = INW; k0 = 64 * kb; return; } r -= J_IN;
        if (r < J_AB) { W = A.in[I_WAB] + 64 * (r & 31); N = 2048; k0 = 64 * (r >> 5); return; } r -= J_AB;
        if (r < J_PB) { W = A.in[I_WPB] + 64 * (r & 31); N = 2048; k0 = 64 * (r >> 5); return; } r -= J_PB;
        if (r < J_WO) { W = A.in[I_WOUT] + 64 * (r & 31); N = 2048; k0 = 64 * (r >> 5); return; } r -= J_WO;
        W = A.in[I_WRE]; N = 64; k0 = 64 * r; };
    auto store_of = [&](const f32x4 (&v)[16], int it) { int r = it;
        if (r < J_IN) { const int kb = r / 100, nb = r % 100, k0 = 64 * kb, n0 = 64 * nb;
            if (nb < 36) cvt_store(v, F.WIN(), 2048, n0, k0, nullptr, false, scr, lane);
            if (nb < 20) cvt_store8(v, F.WIN8(), 2048, n0, k0, nullptr, 1024.0f, scr, lane);
            if (nb >= 36) cvt_store8(v, F.WIN8(), 2048, 1280 + 64 * (nb - 36), k0, nullptr, 1024.0f, scr, lane);
            return; } r -= J_IN;
        if (r < J_AB) { cvt_store(v, F.WAB(), 2048, 64 * (r & 31), 64 * (r >> 5), nullptr, false, scr, lane); return; } r -= J_AB;
        if (r < J_PB) { cvt_store(v, F.WPT(), 1024, 64 * (r & 31), 64 * (r >> 5), nullptr, false, scr, lane); return; } r -= J_PB;
        if (r < J_WO) { cvt_store(v, F.WO(), 2048, 64 * (r & 31), 64 * (r >> 5), nullptr, false, scr, lane); return; } r -= J_WO;
        cvt_store(v, F.WR() + (size_t)8 * 2048, 2048, 0, 64 * r, A.in[I_NFFN], true, scr, lane); };
    static_assert(NJ > 2 * 2048 && NJ <= 3 * 2048, "2 or 3 items per wave on the 256-workgroup grid");
    if (NGW == 2048) {
        const bool third = gw + 2 * NGW < NJ;
        f32x4 v0[16], v1[16], v2[16]; const float* W; int N, k0;
        src_of(gw, W, N, k0); cvt_load(v0, W, N, k0, lane); src_of(gw + NGW, W, N, k0); cvt_load(v1, W, N, k0, lane);
        if (third) { src_of(gw + 2 * NGW, W, N, k0); cvt_load(v2, W, N, k0, lane); }
        store_of(v0, gw); store_of(v1, gw + NGW);
        if (third) store_of(v2, gw + 2 * NGW);
        else { const int nsm = (3 * NGW - NJ) * 64, gt = (gw - (NJ - 2 * NGW)) * 64 + lane;
            for (int i = gt; i < 4 * 256 * 256 / 2; i += nsm) { const int e = 2 * i, g = e >> 16, j = e & 255; const float s0 = A.in[I_PSCL][g * 256 + j], s1 = A.in[I_PSCL][g * 256 + j + 1];
                ((unsigned*)F.PMS())[i] = cvt_pk_bf16(A.in[I_PMIX][e] * s0, A.in[I_PMIX][e + 1] * s1); }
            for (int i = gt; i < 16 * 2048; i += nsm) { const int n = (i >> 11) + (i >= 8 * 2048 ? 64 : 0), k = i & 2047; float v = 0.f;
                if (n < 8) v = A.in[I_WRG][k * 8 + n] * A.in[I_NFFN][k];
                F.WR()[n * 2048 + k] = (bf16)(cvt_pk_bf16(v, 0.f) & 0xffffu); } }
    }
    PT_MARK(10, 1); PT_MARK(12, 0);
    for (int m = gw; m + 3 * NGW < M; m += 4 * NGW) {
        const float* const xr[4] = {A.in[I_X] + (size_t)m * DM, A.in[I_X] + (size_t)(m + NGW) * DM, A.in[I_X] + (size_t)(m + 2 * NGW) * DM, A.in[I_X] + (size_t)(m + 3 * NGW) * DM};
        bf16* const orw[4] = {F.HN() + (size_t)m * DM, F.HN() + (size_t)(m + NGW) * DM, F.HN() + (size_t)(m + 2 * NGW) * DM, F.HN() + (size_t)(m + 3 * NGW) * DM};
        unsigned char* const o8[4] = {F.HN8() + (size_t)m * DM, F.HN8() + (size_t)(m + NGW) * DM, F.HN8() + (size_t)(m + 2 * NGW) * DM, F.HN8() + (size_t)(m + 3 * NGW) * DM};
        rms_rows_to_bf16<4>(xr, A.in[I_NMIX], orw, o8, lane); }
    if (gw < NMETA) { const float* const xr[1] = {A.in[I_META] + (size_t)gw * DM}; bf16* const orw[1] = {F.HN() + (size_t)(M + gw) * DM}; unsigned char* const o8[1] = {nullptr}; rms_rows_to_bf16<1>(xr, A.in[I_NMIX], orw, o8, lane); }
    PT_MARK(12, 1);
}


using pg8::Unit;
struct CvtSlot { int first, count, slot; };
__device__ __forceinline__ unsigned long long misc_u64(int word) { const LAS unsigned* m = (const LAS unsigned*)(unsigned)L_MISC; const unsigned lo = m[word], hi = m[word + 1];
    return ((unsigned long long)(unsigned)__builtin_amdgcn_readfirstlane((int)hi) << 32) | (unsigned)__builtin_amdgcn_readfirstlane((int)lo); }
__device__ __forceinline__ void cvt_run(const CvtSlot& S, const int wave) {
    const int lane = lane_id(); unsigned char* ws = (unsigned char*)misc_u64(48);
    CvtJob J{(const float*)misc_u64(40), (const float*)misc_u64(42), (const float*)misc_u64(44), (const float*)misc_u64(46), (bf16*)(ws + WS_WGU), (bf16*)(ws + WS_WD), S.first, S.count, S.slot, wave, (LAS unsigned char*)(unsigned)(L_CVT + wave * 2048)};
    cvt_run_job(J, lane);
}

struct DenseOrder {
    const char* A; const char* B; int nM, nN, nwg, G, c, lda, ldb;
    __device__ __forceinline__ bool next(int i, Unit& u) const {
        const long L = (long)i * G + c; if (L >= nwg) return false;
        int pm, pn; pg8::tile_of((int)L, nM, nN, pm, pn); u.pm = pm; u.pn = pn; u.x0 = 0; u.x1 = 0;
        u.a = A + (size_t)pm * 256 * lda * 2; u.b = B + (size_t)pn * 256 * ldb * 2; return true; }
};
struct EpiProj {
    static constexpr bool HAS_MID = false; static constexpr int MID_T = 0;
    static constexpr bool HAS_POST = true;
    bf16* O; CvtSlot job; int wave, colbase;
    __device__ __forceinline__ void post(int ui) const { if (ui == job.slot) cvt_run(job, wave); }
    __device__ __forceinline__ void operator()(const f32x4 (&acc)[2][2][4][2], const Unit& u, int, int wr, int wc, int fr, int fq) const {
        const int row0 = u.pm * 256 + wr * 64 + fr, col0 = colbase + u.pn * 256 + wc * 32 + 8 * fq;
#pragma unroll
        for (int ai = 0; ai < 2; ++ai)
#pragma unroll
            for (int m = 0; m < 4; ++m) { bf16* rowp = O + (size_t)(row0 + ai * 128 + m * 16) * PW + col0;
#pragma unroll
                for (int bj = 0; bj < 2; ++bj) { const f32x4 v0 = acc[ai][bj][m][0], v1 = acc[ai][bj][m][1];
                    u32x4 w; w.x = cvt_pk_bf16(v0[0], v0[1]); w.y = cvt_pk_bf16(v0[2], v0[3]); w.z = cvt_pk_bf16(v1[0], v1[1]); w.w = cvt_pk_bf16(v1[2], v1[3]);
                    *(u32x4*)(rowp + bj * 128) = w; } }
    }
};
struct EpiGate {
    static constexpr bool HAS_MID = false; static constexpr int MID_T = 0;
    static constexpr bool HAS_POST = true;
    unsigned char* G; bf16* O; CvtSlot job; int wave, n1;
    __device__ __forceinline__ void post(int ui) const { if (ui + n1 == job.slot) cvt_run(job, wave); }
    __device__ __forceinline__ void operator()(const f32x4 (&acc)[2][2][4][2], const Unit& u, int, int wr, int wc, int fr, int fq) const {
        const int row0 = u.pm * 256 + wr * 64 + fr; constexpr float S = 1.0f / 8192.0f;
        if (u.pn < 5) { const int col0 = u.pn * 256 + wc * 32 + 8 * fq;
#pragma unroll
            for (int ai = 0; ai < 2; ++ai)
#pragma unroll
                for (int m = 0; m < 4; ++m) { bf16* rowp = O + (size_t)(row0 + ai * 128 + m * 16) * PW + col0;
#pragma unroll
                    for (int bj = 0; bj < 2; ++bj) { const f32x4 v0 = acc[ai][bj][m][0] * S, v1 = acc[ai][bj][m][1] * S;
                        u32x4 w; w.x = cvt_pk_bf16(v0[0], v0[1]); w.y = cvt_pk_bf16(v0[2], v0[3]); w.z = cvt_pk_bf16(v1[0], v1[1]); w.w = cvt_pk_bf16(v1[2], v1[3]);
                        *(u32x4*)(rowp + bj * 128) = w; } }
        } else { const int col0 = (u.pn - 5) * 256 + wc * 64 + 16 * fq;
#pragma unroll
            for (int ai = 0; ai < 2; ++ai)
#pragma unroll
                for (int m = 0; m < 4; ++m) { unsigned char* rowp = G + (size_t)(row0 + ai * 128 + m * 16) * GW + col0; u32x4 w4;
#pragma unroll
                    for (int bj = 0; bj < 2; ++bj) { const f32x4 v0 = acc[ai][bj][m][0] * S, v1 = acc[ai][bj][m][1] * S; unsigned q[8];
#pragma unroll
                        for (int e = 0; e < 4; ++e) { q[e] = (unsigned)fminf(sigmoidf_(v0[e]) * 256.0f, 255.0f); q[4 + e] = (unsigned)fminf(sigmoidf_(v1[e]) * 256.0f, 255.0f); }
                        const unsigned lo = q[0] | (q[1] << 8) | (q[2] << 16) | (q[3] << 24), hi = q[4] | (q[5] << 8) | (q[6] << 16) | (q[7] << 24);
                        if (bj == 0) { w4.x = lo; w4.y = hi; } else { w4.z = lo; w4.w = hi; } }
                    *(u32x4*)rowp = w4; }
        }
    }
};
struct FoldOrder {
    const char* WPT; const char* PMS; int idx;
    __device__ __forceinline__ bool next(int i, Unit& u) const {
        if (i > 0 || idx < 0) return false; u.pm = idx >> 2; u.pn = idx & 3; u.x0 = 0; u.x1 = 0;
        u.a = WPT + ((size_t)u.pm * 256 * 1024 + (size_t)u.pn * 256) * 2; u.b = PMS + (size_t)u.pn * 65536 * 2; return true; }
};
struct EpiFold {
    static constexpr bool HAS_MID = false; static constexpr int MID_T = 0;
    static constexpr bool HAS_POST = false;
    bf16* O;
    __device__ __forceinline__ void operator()(const f32x4 (&acc)[2][2][4][2], const Unit& u, int, int wr, int wc, int fr, int fq) const {
        const int row0 = u.pm * 256 + wr * 64 + fr, col0 = 1024 + u.pn * 256 + wc * 32 + 8 * fq;
#pragma unroll
        for (int ai = 0; ai < 2; ++ai)
#pragma unroll
            for (int m = 0; m < 4; ++m) { bf16* rowp = O + (size_t)(row0 + ai * 128 + m * 16) * 2048 + col0;
#pragma unroll
                for (int bj = 0; bj < 2; ++bj) { const f32x4 v0 = acc[ai][bj][m][0], v1 = acc[ai][bj][m][1];
                    u32x4 w; w.x = cvt_pk_bf16(v0[0], v0[1]); w.y = cvt_pk_bf16(v0[2], v0[3]); w.z = cvt_pk_bf16(v1[0], v1[1]); w.w = cvt_pk_bf16(v1[2], v1[3]);
                    *(u32x4*)(rowp + bj * 128) = w; } }
    }
};
struct EpiBranch {
    static constexpr bool HAS_MID = true; static constexpr int MID_T = 16;
    static constexpr bool HAS_POST = false;
    const unsigned char* GATE; bf16* MG;
    static __device__ __forceinline__ void dec8(const u32x2 g, float (&f)[8]) {
        constexpr float S = 1.0f / 256.0f, H = 0.5f / 256.0f;
        f[0] = (float)(g.x & 0xffu) * S + H; f[1] = (float)((g.x >> 8) & 0xffu) * S + H; f[2] = (float)((g.x >> 16) & 0xffu) * S + H; f[3] = (float)(g.x >> 24) * S + H;
        f[4] = (float)(g.y & 0xffu) * S + H; f[5] = (float)((g.y >> 8) & 0xffu) * S + H; f[6] = (float)((g.y >> 16) & 0xffu) * S + H; f[7] = (float)(g.y >> 24) * S + H;
    }
    __device__ __forceinline__ void mid(f32x4 (&acc)[2][2][4][2], const Unit& u, int wr, int wc, int fr, int fq) const {
        const unsigned off0 = (unsigned)(u.pm * 256 + wr * 64 + fr) * (unsigned)GW + (unsigned)(u.pn * 256 + wc * 64 + 16 * fq);
#pragma unroll
        for (int ai = 0; ai < 2; ++ai) {
            u32x4 ga4[4], gb4[4];
#pragma unroll
            for (int m = 0; m < 4; ++m) { const unsigned off = off0 + (unsigned)(ai * 128 + m * 16) * (unsigned)GW; ga4[m] = *(const u32x4*)(GATE + off); gb4[m] = *(const u32x4*)(GATE + off + 2048); }
            asm volatile("" ::: "memory");
#pragma unroll
            for (int m = 0; m < 4; ++m)
#pragma unroll
                for (int bj = 0; bj < 2; ++bj) { float fa[8], fb[8]; dec8(bj ? (u32x2){ga4[m].z, ga4[m].w} : (u32x2){ga4[m].x, ga4[m].y}, fa); dec8(bj ? (u32x2){gb4[m].z, gb4[m].w} : (u32x2){gb4[m].x, gb4[m].y}, fb);
#pragma unroll
                    for (int e = 0; e < 4; ++e) { acc[ai][bj][m][0][e] *= fa[e] * __builtin_amdgcn_rcpf(fb[e]); acc[ai][bj][m][1][e] *= fa[4 + e] * __builtin_amdgcn_rcpf(fb[4 + e]); } }
            asm volatile("" ::: "memory");
        }
    }
    __device__ __forceinline__ void operator()(const f32x4 (&acc)[2][2][4][2], const Unit& u, int, int wr, int wc, int fr, int fq) const {
        const unsigned row0 = (unsigned)(u.pm * 256 + wr * 64 + fr), col0 = (unsigned)(u.pn * 256 + wc * 32 + 8 * fq);
        const unsigned goff0 = row0 * (unsigned)GW + 2048u + (unsigned)(u.pn * 256 + wc * 64 + 16 * fq), moff0 = row0 * 2048u + col0;
        u32x4 gb4[2][4];
#pragma unroll
        for (int ai = 0; ai < 2; ++ai)
#pragma unroll
            for (int m = 0; m < 4; ++m) gb4[ai][m] = *(const u32x4*)(GATE + goff0 + (unsigned)(ai * 128 + m * 16) * (unsigned)GW);
        asm volatile("" ::: "memory");
#pragma unroll
        for (int ai = 0; ai < 2; ++ai)
#pragma unroll
            for (int m = 0; m < 4; ++m) { const unsigned moff = moff0 + (unsigned)(ai * 128 + m * 16) * 2048u;
#pragma unroll
                for (int bj = 0; bj < 2; ++bj) { float fb[8]; dec8(bj ? (u32x2){gb4[ai][m].z, gb4[ai][m].w} : (u32x2){gb4[ai][m].x, gb4[ai][m].y}, fb);
                    const f32x4 v0 = acc[ai][bj][m][0], v1 = acc[ai][bj][m][1];
                    u32x4 w; w.x = cvt_pk_bf16(v0[0] * fb[0], v0[1] * fb[1]); w.y = cvt_pk_bf16(v0[2] * fb[2], v0[3] * fb[3]); w.z = cvt_pk_bf16(v1[0] * fb[4], v1[1] * fb[5]); w.w = cvt_pk_bf16(v1[2] * fb[6], v1[3] * fb[7]);
                    *(u32x4*)(MG + moff + bj * 128) = w; } }
    }
};
struct EpiOut {
    static constexpr bool HAS_MID = false; static constexpr int MID_T = 0;
    static constexpr bool HAS_POST = false;
    const float* X; bf16* H1B; float* SSQ; unsigned char* H8;
    __device__ __forceinline__ void operator()(const f32x4 (&acc)[2][2][4][2], const Unit& u, int, int wr, int wc, int fr, int fq) const {
        PT_MARK(70, 0);
        const int row0 = u.pm * 256 + wr * 64 + fr, col0 = u.pn * 256 + wc * 32 + 8 * fq;
#pragma unroll
        for (int ai = 0; ai < 2; ++ai) {
            f32x4 xr[4][2][2];
#pragma unroll
            for (int m = 0; m < 4; ++m) { const size_t off = (size_t)(row0 + ai * 128 + m * 16) * 2048 + col0;
#pragma unroll
                for (int bj = 0; bj < 2; ++bj) { xr[m][bj][0] = *(const f32x4*)(X + off + bj * 128); xr[m][bj][1] = *(const f32x4*)(X + off + bj * 128 + 4); } }
            asm volatile("" ::: "memory");
#pragma unroll
            for (int m = 0; m < 4; ++m) { const int row = row0 + ai * 128 + m * 16; const size_t off = (size_t)row * 2048 + col0; float ss = 0.f;
#pragma unroll
                for (int bj = 0; bj < 2; ++bj) { const f32x4 v0 = acc[ai][bj][m][0] + xr[m][bj][0], v1 = acc[ai][bj][m][1] + xr[m][bj][1];
                    ss += (v0[0] * v0[0] + v0[1] * v0[1]) + (v0[2] * v0[2] + v0[3] * v0[3]) + (v1[0] * v1[0] + v1[1] * v1[1]) + (v1[2] * v1[2] + v1[3] * v1[3]);
                    u32x4 w; w.x = cvt_pk_bf16(v0[0], v0[1]); w.y = cvt_pk_bf16(v0[2], v0[3]); w.z = cvt_pk_bf16(v1[0], v1[1]); w.w = cvt_pk_bf16(v1[2], v1[3]);
                    *(u32x4*)(H1B + off + bj * 128) = w;
                    f32x4 z0 = v0 * 8.0f, z1 = v1 * 8.0f;
#pragma unroll
                    for (int e = 0; e < 4; ++e) { z0[e] = __builtin_fminf(__builtin_fmaxf(z0[e], -448.0f), 448.0f); z1[e] = __builtin_fminf(__builtin_fmaxf(z1[e], -448.0f), 448.0f); }
                    int p0 = __builtin_amdgcn_cvt_pk_fp8_f32(z0[0], z0[1], 0, false); p0 = __builtin_amdgcn_cvt_pk_fp8_f32(z0[2], z0[3], p0, true);
                    int p1 = __builtin_amdgcn_cvt_pk_fp8_f32(z1[0], z1[1], 0, false); p1 = __builtin_amdgcn_cvt_pk_fp8_f32(z1[2], z1[3], p1, true);
                    *(u32x2*)(H8 + off + bj * 128) = (u32x2){(unsigned)p0, (unsigned)p1}; }
                ss += __shfl_xor(ss, 16); ss += __shfl_xor(ss, 32);
                if (fq == 0) SSQ[(size_t)(u.pn * 4 + wc) * M + row] = ss; }
            asm volatile("" ::: "memory");
        }
#if PROBE_TIME == 70
        asm volatile("s_waitcnt vmcnt(0)" ::: "memory");
#endif
        PT_MARK(70, 1);
    }
};
struct MoeOrder {
    LAS const int* ud; int nunits; const char* A; const char* B; size_t a_row_bytes  , b_exp_bytes, b_panel_bytes;
    __device__ __forceinline__ bool next(int i, Unit& u) const {
        if (i >= nunits) return false;
        const int e = __builtin_amdgcn_readfirstlane(ud[i * 8 + 0]), pn = __builtin_amdgcn_readfirstlane(ud[i * 8 + 1]), nv = __builtin_amdgcn_readfirstlane(ud[i * 8 + 2]), rs = __builtin_amdgcn_readfirstlane(ud[i * 8 + 3]);
        u.pm = e; u.pn = pn; u.x0 = nv; u.x1 = rs; u.a = A + (size_t)rs * a_row_bytes; u.b = B + (size_t)e * b_exp_bytes + (size_t)pn * b_panel_bytes; return true; }
};
struct EpiGU {
    static constexpr bool HAS_MID = false; static constexpr int MID_T = 0;
    static constexpr bool HAS_POST = false;
    bf16* HID; LAS const float* rtab;
    __device__ __forceinline__ void operator()(const f32x4 (&acc)[2][2][4][2], const Unit& u, int ui, int wr, int wc, int fr, int fq) const {
        const int col0 = u.pn * 128 + wc * 32 + 8 * fq; const int nv = u.x0, rs = u.x1;
#pragma unroll
        for (int ai = 0; ai < 2; ++ai)
#pragma unroll
            for (int m = 0; m < 4; ++m) { const int rr = ai * 128 + wr * 64 + m * 16 + fr; const float r = rtab[ui * 256 + rr] * (1.0f / 8192.0f);
                int pk[2];
#pragma unroll
                for (int n = 0; n < 2; ++n) { f32x4 g = acc[ai][0][m][n] * r; const f32x4 uu = acc[ai][1][m][n] * r;
#pragma unroll
                    for (int e = 0; e < 4; ++e) g[e] = __builtin_fminf(__builtin_fmaxf(g[e] * sigmoidf_(g[e]) * uu[e] * 8.0f, -448.0f), 448.0f);
                    int p = __builtin_amdgcn_cvt_pk_fp8_f32(g[0], g[1], 0, false); pk[n] = __builtin_amdgcn_cvt_pk_fp8_f32(g[2], g[3], p, true); }
                const int p0 = pk[0], p1 = pk[1];
                if (rr < nv) *(u32x2*)((unsigned char*)HID + (size_t)(rs + rr) * DEXP + col0) = (u32x2){(unsigned)p0, (unsigned)p1}; }
    }
};
struct EpiDown {
    static constexpr bool HAS_MID = false; static constexpr int MID_T = 0;
    static constexpr bool HAS_POST = false;
    bf16* Y; LAS const float* wtab;
    __device__ __forceinline__ void operator()(const f32x4 (&acc)[2][2][4][2], const Unit& u, int ui, int wr, int wc, int fr, int fq) const {
        const int col0 = u.pn * 256 + wc * 32 + 8 * fq; const int nv = u.x0, rs = u.x1;
#pragma unroll
        for (int ai = 0; ai < 2; ++ai)
#pragma unroll
            for (int m = 0; m < 4; ++m) { const int rr = ai * 128 + wr * 64 + m * 16 + fr; const float wt = wtab[ui * 256 + rr] * (1.0f / 4096.0f); bf16* rowp = Y + (size_t)(rs + rr) * 2048 + col0;
#pragma unroll
                for (int bj = 0; bj < 2; ++bj) { const f32x4 v0 = acc[ai][bj][m][0] * wt, v1 = acc[ai][bj][m][1] * wt;
                    u32x4 w; w.x = cvt_pk_bf16(v0[0], v0[1]); w.y = cvt_pk_bf16(v0[2], v0[3]); w.z = cvt_pk_bf16(v1[0], v1[1]); w.w = cvt_pk_bf16(v1[2], v1[3]);
                    if (rr < nv) *(u32x4*)(rowp + bj * 128) = w; } }
    }
};

__device__ __forceinline__ void meta_proj_task(Frame& F, int task) {
    const int lane = F.lane(), n0 = KOFF + 16 * task;
    const bf16* ap = F.HN() + (size_t)(M + (lane & 15)) * DM + 8 * (lane >> 4);
    const bf16* bp = F.WIN() + (size_t)(n0 + (lane & 15)) * DM + 8 * (lane >> 4);
    f32x4 acc = (f32x4){0.f, 0.f, 0.f, 0.f};
#pragma unroll 8
    for (int ks = 0; ks < 64; ++ks) { const bf16x8 a = *(const bf16x8*)(ap + 32 * ks), b = *(const bf16x8*)(bp + 32 * ks); acc = __builtin_amdgcn_mfma_f32_16x16x32_bf16(a, b, acc, 0, 0, 0); }
#pragma unroll
    for (int r = 0; r < 4; ++r) F.PROJ()[(size_t)(M + 4 * (lane >> 4) + r) * PW + n0 + (lane & 15)] = (bf16)(cvt_pk_bf16(acc[r], 0.f) & 0xffffu);
}

__device__ __forceinline__ int t5_bucket(int d) {
    if (d < 16) return d;
    return 16 + (d >= 19) + (d >= 21) + (d >= 24) + (d >= 27) + (d >= 31) + (d >= 35) + (d >= 40) + (d >= 46) + (d >= 52) + (d >= 59) + (d >= 67) + (d >= 77) + (d >= 87) + (d >= 99) + (d >= 113);
}
constexpr int A_KL = 0, A_KROW = 144;
constexpr int A_VT = 288 * 144, A_VROW = 584;
constexpr int A_BT = A_VT + 64 * 584;
constexpr int A_RT = A_BT + 4096, A_RT_COPY = 192 * 4, A_RT_HEAD = 4 * A_RT_COPY;
static_assert(A_RT + 8 * A_RT_HEAD <= RING_BYTES, "attention LDS");
constexpr float LOG2E = 1.4426950408889634f;

template <int T>
__device__ __forceinline__ void attn_qtile(LAS const unsigned char* lds, LAS const float* BT, LAS const unsigned char* rt  , const bf16x8 (&qf)[4], bf16x8 (&qn)[4], const bf16* Qrow, bf16* Orow, float sink  , int blk, int lane) {
    const int r32 = lane & 31, hi = lane >> 5, qi = 32 * T + r32;
    if constexpr (T < 3) {
#pragma unroll
        for (int ds = 0; ds < 4; ++ds) qn[ds] = *(const bf16x8*)(Qrow + (size_t)(32 + r32) * PW + ds * 16 + hi * 8); }
    f32x16 s[6];
#pragma unroll
    for (int ti = 0; ti < 6; ++ti) {
        const int kkb = (ti == 0) ? 0 : (ti <= 4 - T ? 32 + 32 * (T + ti - 1) : 160 + 32 * (ti - (5 - T)));
        f32x16 a = (f32x16){0.f, 0.f, 0.f, 0.f, 0.f, 0.f, 0.f, 0.f, 0.f, 0.f, 0.f, 0.f, 0.f, 0.f, 0.f, 0.f};
#pragma unroll
        for (int ds = 0; ds < 4; ++ds) { const bf16x8 kf = *(const LAS bf16x8*)(lds + A_KL + (kkb + r32) * A_KROW + ds * 32 + hi * 16); a = __builtin_amdgcn_mfma_f32_32x32x16_bf16(kf, qf[ds], a, 0, 0, 0); }
        s[ti] = a;
    }
    float mx = sink;
#pragma unroll
    for (int r = 0; r < 8; ++r) { const int i = (r & 3) + 8 * (r >> 2) + 4 * hi; int dist = 16 + 128 * blk + qi - i; dist = dist > 127 ? 127 : dist;
        const float x = s[0][r] * (0.125f * LOG2E) + BT[dist]; s[0][r] = x; mx = fmaxf(mx, x); }
#pragma unroll
    for (int ti = 1; ti < 6; ++ti) {
        const bool prev = ti <= 4 - T; const int jt = prev ? (T + ti - 1) : (ti - (5 - T));
        const int C = -32 * T + 32 * jt - (prev ? 128 : 0);
#pragma unroll
        for (int g4 = 0; g4 < 4; ++g4) { const f32x4 bv = *(const LAS f32x4*)(rt + 4 * (C + 128 + 8 * g4));
#pragma unroll
            for (int e = 0; e < 4; ++e) { float x = s[ti][4 * g4 + e] * (0.125f * LOG2E) + bv[e]; if (prev) x = blk > 0 ? x : -1e30f; s[ti][4 * g4 + e] = x; mx = fmaxf(mx, x); } }
    }
    mx = fmaxf(mx, __shfl_xor(mx, 32));
    float l = 0.f;
#pragma unroll
    for (int r = 0; r < 8; ++r) { const float p = __builtin_amdgcn_exp2f(s[0][r] - mx); s[0][r] = p; l += p; }
#pragma unroll
    for (int ti = 1; ti < 6; ++ti)
#pragma unroll
        for (int r = 0; r < 16; ++r) { const float p = __builtin_amdgcn_exp2f(s[ti][r] - mx); s[ti][r] = p; l += p; }
    l += __shfl_xor(l, 32); l += __builtin_amdgcn_exp2f(sink - mx);
    f32x16 o[2];
    o[0] = (f32x16){0.f, 0.f, 0.f, 0.f, 0.f, 0.f, 0.f, 0.f, 0.f, 0.f, 0.f, 0.f, 0.f, 0.f, 0.f, 0.f}; o[1] = o[0];
#pragma unroll
    for (int ti = 0; ti < 6; ++ti) {
        const int kkb = (ti == 0) ? 0 : (ti <= 4 - T ? 32 + 32 * (T + ti - 1) : 160 + 32 * (ti - (5 - T)));
#pragma unroll
        for (int s2 = 0; s2 < 2; ++s2) {
            if (ti == 0 && s2 == 1) continue;
            u32x4 pw; pw.x = cvt_pk_bf16(s[ti][8 * s2 + 0], s[ti][8 * s2 + 1]); pw.y = cvt_pk_bf16(s[ti][8 * s2 + 2], s[ti][8 * s2 + 3]); pw.z = cvt_pk_bf16(s[ti][8 * s2 + 4], s[ti][8 * s2 + 5]); pw.w = cvt_pk_bf16(s[ti][8 * s2 + 6], s[ti][8 * s2 + 7]);
            const bf16x8 pf = __builtin_bit_cast(bf16x8, pw);
#pragma unroll
            for (int dt = 0; dt < 2; ++dt) { LAS const unsigned char* vp = lds + A_VT + (dt * 32 + r32) * A_VROW + (kkb + 16 * s2 + 4 * hi) * 2;
                const u32x2 lo = *(const LAS u32x2*)vp, hi2 = *(const LAS u32x2*)(vp + 16);
                const bf16x8 vf = __builtin_bit_cast(bf16x8, (u32x4){lo.x, lo.y, hi2.x, hi2.y});
                o[dt] = __builtin_amdgcn_mfma_f32_32x32x16_bf16(vf, pf, o[dt], 0, 0, 0); }
        }
    }
    const float inv = 1.0f / l;
#pragma unroll
    for (int dt = 0; dt < 2; ++dt)
#pragma unroll
        for (int g4 = 0; g4 < 4; ++g4) { u32x2 w; w.x = cvt_pk_bf16(o[dt][4 * g4 + 0] * inv, o[dt][4 * g4 + 1] * inv); w.y = cvt_pk_bf16(o[dt][4 * g4 + 2] * inv, o[dt][4 * g4 + 3] * inv);
            *(u32x2*)(Orow + (size_t)r32 * 2048 + dt * 32 + 8 * g4 + 4 * hi) = w; }
}

template <int W>
__device__ __forceinline__ void mixed_task(const bf16* ub  , bf16* ob  , int b, int s0) {
    constexpr int NR = 16 + W - 1;
    u32x4 u[NR];
#pragma unroll
    for (int i = 0; i < NR; ++i) { const int s = s0 - (W - 1) + i; const size_t row = s >= 0 ? (size_t)(b * SEQ + s) : (size_t)(M + 16 + s); u[i] = *(const u32x4*)(ub + row * PW); }
    constexpr float iw = 1.0f / (float)W;
#pragma unroll
    for (int t = 0; t < 16; ++t) {
        float a[8];
#pragma unroll
        for (int e = 0; e < 8; ++e) a[e] = 0.f;
#pragma unroll
        for (int j = 0; j < W; ++j) { const u32x4 v = u[t + j];
            a[0] += bf_lo(v.x); a[1] += bf_hi(v.x); a[2] += bf_lo(v.y); a[3] += bf_hi(v.y); a[4] += bf_lo(v.z); a[5] += bf_hi(v.z); a[6] += bf_lo(v.w); a[7] += bf_hi(v.w); }
        const u32x4 own = u[t + W - 1];
        u32x4 o; o.x = cvt_pk_bf16(a[0] * iw - bf_lo(own.x), a[1] * iw - bf_hi(own.x)); o.y = cvt_pk_bf16(a[2] * iw - bf_lo(own.y), a[3] * iw - bf_hi(own.y));
        o.z = cvt_pk_bf16(a[4] * iw - bf_lo(own.z), a[5] * iw - bf_hi(own.z)); o.w = cvt_pk_bf16(a[6] * iw - bf_lo(own.w), a[7] * iw - bf_hi(own.w));
        *(u32x4*)(ob + (size_t)t * 2048) = o;
    }
}

__device__ __forceinline__ void attn_unit(Frame& F, const Args& A, int b, int blk, int kvh) {
    LAS unsigned char* lds = F.lds; const int tid = F.tid(); const int m0 = b * SEQ + blk * 128;
#pragma unroll 1
    for (int pass = 0; pass < 2; ++pass) {
    if ((pass == 0) != (P2_ALT && (blk & 1) != 0)) {
    PT_MARK(20, 0);
    u32x4 kvr[5], vvr[5];
#pragma unroll
    for (int it = 0; it < 5; ++it) { const int c = tid + it * (NWAVES * 64), kk = c >> 3, ch = c & 7; int row = -1;
        if (kk < 16) row = M + kk; else if (kk >= 160 && kk < 288) row = m0 + (kk - 160); else if (kk >= 32 && kk < 160 && blk > 0) row = m0 - 128 + (kk - 32);
        kvr[it] = (u32x4){0u, 0u, 0u, 0u}; vvr[it] = kvr[it];
        if (row >= 0) { const bf16* p = F.PROJ() + (size_t)row * PW + kvh * 64 + ch * 8; kvr[it] = *(const u32x4*)(p + KOFF); vvr[it] = *(const u32x4*)(p + VOFF); } }
    LAS float* BTall = (LAS float*)(lds + A_BT);
    for (int t = tid; t < 8 * 128; t += NWAVES * 64) { const int g = t >> 7, d = t & 127; BTall[t] = LOG2E * A.in[I_RELB][t5_bucket(d) * 16 + kvh * 8 + g]; }
    for (int t = tid; t < 8 * 4 * 192; t += NWAVES * 64) { const int g = t / 768, sh = (t / 192) & 3, d = 159 - ((t % 192) + sh);
        ((LAS float*)(lds + A_RT))[t] = (d >= 0 && d <= 127) ? LOG2E * A.in[I_RELB][t5_bucket(d) * 16 + kvh * 8 + g] : -1e30f; }
#pragma unroll
    for (int it = 0; it < 5; ++it) { const int c = tid + it * (NWAVES * 64), kk = c >> 3, ch = c & 7; const u32x4 kv = kvr[it], vv = vvr[it];
        if (kk < 288) { *(LAS u32x4*)(lds + A_KL + kk * A_KROW + ch * 16) = kv;
            if (kk < 16 || kk >= 32) { LAS bf16* vt = (LAS bf16*)(lds + A_VT) + (size_t)(ch * 8) * 292 + kk;
                vt[0 * 292] = (bf16)(vv.x & 0xffffu); vt[1 * 292] = (bf16)(vv.x >> 16); vt[2 * 292] = (bf16)(vv.y & 0xffffu); vt[3 * 292] = (bf16)(vv.y >> 16);
                vt[4 * 292] = (bf16)(vv.z & 0xffffu); vt[5 * 292] = (bf16)(vv.z >> 16); vt[6 * 292] = (bf16)(vv.w & 0xffffu); vt[7 * 292] = (bf16)(vv.w >> 16); } } }
    __syncthreads();
    PT_MARK(20, 1); PT_MARK(21, 0);
    const int g = F.wave, hq = kvh * 8 + g; const float sink = LOG2E * A.in[I_SINK][hq];
    const bf16* Q = F.PROJ() + (size_t)m0 * PW + hq * 64; bf16* O = F.AP() + (size_t)m0 * 2048 + hq * 64;
    LAS const float* BT = BTall + g * 128;
    bf16x8 qa[4], qb[4];
    { const int r32 = F.lane() & 31, hi = F.lane() >> 5;
#pragma unroll
      for (int ds = 0; ds < 4; ++ds) qa[ds] = *(const bf16x8*)(Q + (size_t)r32 * PW + ds * 16 + hi * 8); }
    LAS const unsigned char* rt;
    { const int ln = F.lane(), x0 = 159 - (ln & 31), sh = x0 & 3; rt = lds + A_RT + g * A_RT_HEAD + sh * A_RT_COPY + 4 * (x0 - sh) + 16 * (ln >> 5) - 512; }
    attn_qtile<0>(lds, BT, rt, qa, qb, Q, O, sink, blk, F.lane());
    attn_qtile<1>(lds, BT, rt, qb, qa, Q + (size_t)32 * PW, O + (size_t)32 * 2048, sink, blk, F.lane());
    attn_qtile<2>(lds, BT, rt, qa, qb, Q + (size_t)64 * PW, O + (size_t)64 * 2048, sink, blk, F.lane());
    attn_qtile<3>(lds, BT, rt, qb, qa, Q + (size_t)96 * PW, O + (size_t)96 * 2048, sink, blk, F.lane());
    PT_MARK(21, 1);
    } else {
    PT_MARK(22, 0);
    { const int ln = F.lane(), grp = F.wave & 3, r0 = 16 * (4 * (F.wave >> 2) + (ln >> 4)), c8 = grp * 256 + kvh * 128 + (ln & 15) * 8;
      const bf16* ub = F.PROJ() + UOFF + c8; bf16* ob = F.AP() + (size_t)(m0 + r0) * 2048 + 1024 + c8; const int s0 = blk * 128 + r0;
      if (grp == 0) mixed_task<2>(ub, ob, b, s0); else if (grp == 1) mixed_task<4>(ub, ob, b, s0); else if (grp == 2) mixed_task<8>(ub, ob, b, s0); else mixed_task<16>(ub, ob, b, s0); }
    PT_MARK(22, 1);
    } }
    __syncthreads();
}

__device__ __forceinline__ void router_group(Frame& F, const Args& A, int tg, const int dummy = 0) {
    LAS unsigned char* lds = F.lds; const int lane = F.lane(), w = F.wave, q = w & 3, kh = w >> 2;
    LAS float* part = (LAS float*)lds;
    LAS float* logit = (LAS float*)(lds + 20480);
    const int t0 = tg * 64 + q * 16;
    f32x4 acc[5];
#pragma unroll
    for (int n = 0; n < 5; ++n) acc[n] = (f32x4){0.f, 0.f, 0.f, 0.f};
    constexpr int RB_OFF = 40960, RB_ROW = 272, RB_BUF = 160 * RB_ROW;
    static_assert(RB_OFF + 2 * RB_BUF <= RING_BYTES, "router LDS");
    const int srow = F.tid() >> 4, sl16 = F.tid() & 15;
    u32x4 sb[5]; bf16x8 aa[8][4];
    const bf16* ap = F.H1B() + (size_t)(t0 + (lane & 15)) * DM + kh * 1024 + 8 * (lane >> 4);
#define RT_LOADB(cc) do { _Pragma("unroll") for (int p = 0; p < 5; ++p) { const int row = p * 32 + srow, h = row >= 80 ? 1 : 0, n = row - 80 * h; \
        sb[p] = *(const u32x4*)(F.WR() + (size_t)n * DM + 1024 * h + 128 * (cc) + 8 * sl16); } } while (0)
#define RT_STOREB(bufi) do { _Pragma("unroll") for (int p = 0; p < 5; ++p) *(LAS u32x4*)(lds + RB_OFF + (bufi) * RB_BUF + (p * 32 + srow) * RB_ROW + 16 * sl16) = sb[p]; } while (0)
#define RT_LOADA(dst, cc) do { _Pragma("unroll") for (int ks = 0; ks < 4; ++ks) dst[ks] = *(const bf16x8*)(ap + 128 * (cc) + 32 * ks); } while (0)
    PT_MARK(50, 0);
    float ss_row = 0.f;
    if (F.tid() < 64) {
#pragma unroll
        for (int p = 0; p < 32; ++p) ss_row += F.SSQ()[(size_t)p * M + tg * 64 + F.tid()]; }
    RT_LOADB(0);
#pragma unroll
    for (int cc = 0; cc < 8; ++cc) RT_LOADA(aa[cc], cc);
    RT_STOREB(0);
    __syncthreads();
#pragma unroll
    for (int cc = 0; cc < 8; ++cc) {
        if (cc < 7) { RT_LOADB(cc + 1); }
        LAS const unsigned char* bb = lds + RB_OFF + (cc & 1) * RB_BUF + (kh * 80 + (lane & 15)) * RB_ROW + 16 * (lane >> 4);
#pragma unroll
        for (int ks = 0; ks < 4; ++ks)
#pragma unroll
            for (int n = 0; n < 5; ++n) { const bf16x8 b = *(const LAS bf16x8*)(bb + n * 16 * RB_ROW + 64 * ks); acc[n] = __builtin_amdgcn_mfma_f32_16x16x32_bf16(aa[cc][ks], b, acc[n], 0, 0, 0); }
        if (cc < 7) { RT_STOREB((cc + 1) & 1); }
        __syncthreads();
    }
#undef RT_LOADB
#undef RT_STOREB
#undef RT_LOADA
    PT_MARK(50, 1); PT_MARK(51, 0);
    if (kh == 1) {
#pragma unroll
        for (int n = 0; n < 5; ++n) *(LAS f32x4*)(part + ((q * 5 + n) * 64 + lane) * 4) = acc[n]; }
    __syncthreads();
    if (kh == 0) {
#pragma unroll
        for (int n = 0; n < 5; ++n) { const f32x4 p = *(LAS const f32x4*)(part + ((q * 5 + n) * 64 + lane) * 4); const f32x4 v = acc[n] + p;
#pragma unroll
            for (int r = 0; r < 4; ++r) logit[(q * 16 + 4 * (lane >> 4) + r) * 80 + n * 16 + (lane & 15)] = v[r]; } }
    __syncthreads();
    PT_MARK(51, 1); PT_MARK(52, 0);
    if (F.tid() < 64) {
        const int tt = tg * 64 + F.tid(); LAS const float* lg = logit + F.tid() * 80;
        const float r = 1.0f / sqrtf(ss_row * (1.0f / DM) + RMS_EPS);
        float gl[8]; int grp = 0; float gmax = -3.0e38f;
#pragma unroll
        for (int j = 0; j < 8; ++j) { gl[j] = r * lg[j] + A.in[I_BRG][j]; if (gl[j] > gmax) { gmax = gl[j]; grp = j; } }
        float den = 0.f;
#pragma unroll
        for (int j = 0; j < 8; ++j) den += __expf(gl[j] - gmax);
        const float pg = 1.0f / den;
        float l1 = -3.0e38f, l2 = -3.0e38f; int i1 = 0, i2 = 0;
#pragma unroll
        for (int j = 0; j < 8; ++j) { const float v = r * lg[8 + grp * 8 + j] + A.in[I_BRE][grp * 8 + j];
            if (v > l1) { l2 = l1; i2 = i1; l1 = v; i1 = j; } else if (v > l2) { l2 = v; i2 = j; } }
        const float e1w = 1.0f / (1.0f + __expf(l2 - l1)); const float w1 = e1w * pg, w2 = (1.0f - e1w) * pg;
        const int e1 = grp * 8 + i1, e2 = grp * 8 + i2;
        const size_t dofs = dummy ? (size_t)(WS_END - WS_LTOK) / 4 : 0;
        LAS unsigned* lc = (LAS unsigned*)(lds + 40960);
        lc[F.tid()] = 0u; LDS_WAIT();
        const unsigned lp1 = __hip_atomic_fetch_add(lc + e1, 1u, __ATOMIC_RELAXED, __HIP_MEMORY_SCOPE_WORKGROUP), lp2 = __hip_atomic_fetch_add(lc + e2, 1u, __ATOMIC_RELAXED, __HIP_MEMORY_SCOPE_WORKGROUP); LDS_WAIT();
        { const unsigned n = lc[F.tid()]; unsigned base = 0u; if (n) base = atomicAdd(F.ctl + CW_CNT + (dummy ? 2048 : 0) + CNT_STRIDE * F.tid(), n); lc[64 + F.tid()] = base; } LDS_WAIT();
        const int p1 = (int)(lc[64 + e1] + lp1), p2 = (int)(lc[64 + e2] + lp2);
        F.LTOK()[dofs + e1 * CAP + p1] = tt; F.LR()[dofs + e1 * CAP + p1] = r; F.LW()[dofs + e1 * CAP + p1] = w1;
        F.LTOK()[dofs + e2 * CAP + p2] = tt; F.LR()[dofs + e2 * CAP + p2] = r; F.LW()[dofs + e2 * CAP + p2] = w2;
        ((i32x4*)((int*)F.TINFO() + dofs))[tt] = (i32x4){e1, p1, e2, p2};
    }
    PT_MARK(52, 1);
    __syncthreads();
}

template <int NPN, bool GU>
__device__ __forceinline__ int moe_setup(Frame& F) {
    LAS int* ud = (LAS int*)(F.lds + L_UD);
    if (F.wave == 0) { const int lane = lane_id();
        LAS int* cnts = (LAS int*)(F.lds + L_TSTART);
        int cnt;
        if (GU || MK_LAUNCHES != 1) { cnt = (int)__hip_atomic_load(F.ctl + CW_CNT + CNT_STRIDE * lane, __ATOMIC_RELAXED, __HIP_MEMORY_SCOPE_AGENT); cnts[lane] = cnt; } else cnt = cnts[lane];
        const int nt = (cnt + 255) >> 8;
        int sc = cnt, st = nt;
#pragma unroll
        for (int o = 1; o < 64; o <<= 1) { const int a = __shfl_up(sc, o), b = __shfl_up(st, o); if (lane >= o) { sc += a; st += b; } }
        const int es_e = sc - cnt, ts_e = st - nt, ntiles = __shfl(st, 63);
#pragma unroll
        for (int i = 0; i < 8; ++i) { const long L = (long)i * F.G + F.vcu; const bool ok = L < (long)ntiles * NPN; const int rt = ok ? (int)(L / NPN) : 0, pn = (int)(L % NPN);
            const unsigned long long m = __ballot(ts_e <= rt && rt < ts_e + nt); const int e = m ? (int)__builtin_ctzll(m) : 0;
            const int tile = rt - __shfl(ts_e, e), ce = __shfl(cnt, e), rs = __shfl(es_e, e) + 256 * tile; int nv = ce - 256 * tile; nv = nv > 256 ? 256 : nv;
            if (lane == 0) { ud[i * 8 + 0] = e; ud[i * 8 + 1] = pn; ud[i * 8 + 2] = nv; ud[i * 8 + 3] = rs; ud[i * 8 + 4] = tile; ud[i * 8 + 5] = ok ? 1 : 0; } }
    }
    __syncthreads();
    int nunits = 0;
#pragma unroll
    for (int i = 0; i < 8; ++i) nunits += ud[i * 8 + 5];
    LAS unsigned* tab = (LAS unsigned*)(F.lds + L_TAB);
    { const int tid = F.tid(); int tk[4]; float tr[4];
#pragma unroll
      for (int k = 0; k < 4; ++k) { const int idx = tid + k * (NWAVES * 64); tk[k] = 0; tr[k] = 0.f;
          if (idx < nunits * 256) { const int i = idx >> 8, rr = idx & 255; const int e = ud[i * 8 + 0], nv = ud[i * 8 + 2], tile = ud[i * 8 + 4]; const int pos = 256 * tile + (rr < nv ? rr : nv - 1);
              if (GU) { tk[k] = F.LTOK()[e * CAP + pos]; tr[k] = F.LR()[e * CAP + pos]; } else tr[k] = rr < nv ? F.LW()[e * CAP + pos] : 0.f; } }
#pragma unroll
      for (int k = 0; k < 4; ++k) { const int idx = tid + k * (NWAVES * 64);
          if (idx < nunits * 256) { if (GU) { tab[idx] = (unsigned)tk[k] * (unsigned)DM;   ((LAS float*)tab)[1024 + idx] = tr[k]; } else ((LAS float*)tab)[idx] = tr[k]; } } }
    __syncthreads();
    return nunits;
}

constexpr int L_UD2 = L_CVT, L_TAB2 = L_CVT + 256;
__device__ __forceinline__ int moe_setup_both(Frame& F) {
    LAS int* ud = (LAS int*)(F.lds + L_UD); LAS int* ud2 = (LAS int*)(F.lds + L_UD2);
    if (F.wave == 0) { const int lane = lane_id();
        const int cnt = (int)__hip_atomic_load(F.ctl + CW_CNT + CNT_STRIDE * lane, __ATOMIC_RELAXED, __HIP_MEMORY_SCOPE_AGENT), nt = (cnt + 255) >> 8;
        int sc = cnt, st = nt;
#pragma unroll
        for (int o = 1; o < 64; o <<= 1) { const int a = __shfl_up(sc, o), b = __shfl_up(st, o); if (lane >= o) { sc += a; st += b; } }
        const int es_e = sc - cnt, ts_e = st - nt, ntiles = __shfl(st, 63);
        ((LAS int*)(F.lds + L_ESTART))[lane] = es_e;
#pragma unroll
        for (int i = 0; i < 16; ++i) { const int NPN = i < 8 ? 4 : 8; LAS int* u = i < 8 ? ud + i * 8 : ud2 + (i - 8) * 8;
            const long L = (long)(i & 7) * F.G + F.vcu; const bool ok = L < (long)ntiles * NPN; const int rt = ok ? (int)(L / NPN) : 0, pn = (int)(L % NPN);
            const unsigned long long m = __ballot(ts_e <= rt && rt < ts_e + nt); const int e = m ? (int)__builtin_ctzll(m) : 0;
            const int tile = rt - __shfl(ts_e, e), ce = __shfl(cnt, e), rs = __shfl(es_e, e) + 256 * tile; int nv = ce - 256 * tile; nv = nv > 256 ? 256 : nv;
            if (lane == 0) { u[0] = e; u[1] = pn; u[2] = nv; u[3] = rs; u[4] = tile; u[5] = ok ? 1 : 0; } }
    }
    __syncthreads();
    int n6 = 0, n7 = 0;
#pragma unroll
    for (int i = 0; i < 8; ++i) { n6 += ud[i * 8 + 5]; n7 += ud2[i * 8 + 5]; }
    if (F.tid() == 0) F.MISC[17] = (unsigned)n7;
    LAS unsigned* tab = (LAS unsigned*)(F.lds + L_TAB); LAS float* tab2 = (LAS float*)(F.lds + L_TAB2);
    { const int tid = F.tid(); int tk[2]; float tr[2], tw[4];
#pragma unroll
      for (int k = 0; k < 2; ++k) { const int idx = tid + k * (NWAVES * 64); tk[k] = 0; tr[k] = 0.f;
          if (idx < n6 * 256) { const int i = idx >> 8, rr = idx & 255; const int e = ud[i * 8 + 0], nv = ud[i * 8 + 2], tile = ud[i * 8 + 4]; const int pos = 256 * tile + (rr < nv ? rr : nv - 1);
              tk[k] = F.LTOK()[e * CAP + pos]; tr[k] = F.LR()[e * CAP + pos]; } }
#pragma unroll
      for (int k = 0; k < 4; ++k) { const int idx = tid + k * (NWAVES * 64); tw[k] = 0.f;
          if (idx < n7 * 256) { const int i = idx >> 8, rr = idx & 255; const int e = ud2[i * 8 + 0], nv = ud2[i * 8 + 2], tile = ud2[i * 8 + 4]; const int pos = 256 * tile + (rr < nv ? rr : nv - 1);
              tw[k] = rr < nv ? F.LW()[e * CAP + pos] : 0.f; } }
#pragma unroll
      for (int k = 0; k < 2; ++k) { const int idx = tid + k * (NWAVES * 64); if (idx < n6 * 256) { tab[idx] = (unsigned)tk[k] * (unsigned)DM;   ((LAS float*)tab)[1024 + idx] = tr[k]; } }
#pragma unroll
      for (int k = 0; k < 4; ++k) { const int idx = tid + k * (NWAVES * 64); if (idx < n7 * 256) tab2[idx] = tw[k]; } }
    __syncthreads();
    return n6;
}

__device__ __forceinline__ void final_row(Frame& F, const Args& A, int t, LAS const int* es, const int lane) {
    const i32x4 ti = F.TINFO()[t];
    const size_t s1 = (size_t)(es[ti.x] + ti.y), s2 = (size_t)(es[ti.z] + ti.w);
    const u32x4* hr = (const u32x4*)(F.H1B() + (size_t)t * DM) + lane; const u32x4* y1 = (const u32x4*)(F.Y() + s1 * DM) + lane; const u32x4* y2 = (const u32x4*)(F.Y() + s2 * DM) + lane;
    const f32x4* gr = (const f32x4*)A.in[I_NFIN] + 2 * lane;
    float v[4][8]; float s = 0.f;
#pragma unroll
    for (int j = 0; j < 4; ++j) { const u32x4 h = hr[64 * j]; const u32x4 a = y1[64 * j], b = y2[64 * j];
        v[j][0] = bf_lo(h.x) + (bf_lo(a.x) + bf_lo(b.x)); v[j][1] = bf_hi(h.x) + (bf_hi(a.x) + bf_hi(b.x)); v[j][2] = bf_lo(h.y) + (bf_lo(a.y) + bf_lo(b.y)); v[j][3] = bf_hi(h.y) + (bf_hi(a.y) + bf_hi(b.y));
        v[j][4] = bf_lo(h.z) + (bf_lo(a.z) + bf_lo(b.z)); v[j][5] = bf_hi(h.z) + (bf_hi(a.z) + bf_hi(b.z)); v[j][6] = bf_lo(h.w) + (bf_lo(a.w) + bf_lo(b.w)); v[j][7] = bf_hi(h.w) + (bf_hi(a.w) + bf_hi(b.w));
#pragma unroll
        for (int e = 0; e < 8; e += 2) s += v[j][e] * v[j][e] + v[j][e + 1] * v[j][e + 1]; }
    const float r = 1.0f / sqrtf(wave_sum(s) * (1.0f / DM) + RMS_EPS);
    f32x4* o = (f32x4*)(A.out + (size_t)t * DM) + 2 * lane;
#pragma unroll
    for (int j = 0; j < 4; ++j) { const f32x4 g0 = gr[128 * j], g1 = gr[128 * j + 1];
        o[128 * j] = (f32x4){v[j][0] * r * g0.x, v[j][1] * r * g0.y, v[j][2] * r * g0.z, v[j][3] * r * g0.w};
        o[128 * j + 1] = (f32x4){v[j][4] * r * g1.x, v[j][5] * r * g1.y, v[j][6] * r * g1.z, v[j][7] * r * g1.w}; }
}

__device__ __forceinline__ void p0_probe(Frame& F, const Args& A) {
#if PROBE_SUB > 0
    if (F.vcu < PROBE_SUB) { CvtSlot job{F.vcu * (CVT_ITEMS / PROBE_SUB), CVT_ITEMS / PROBE_SUB, 0}; cvt_run(job, F.wave); }
#endif
}
__device__ __forceinline__ void p1_phase(Frame& F, const Args& A, int c) {
    if (c < 10) meta_proj_task(F, c * 8 + F.wave);
    if (c >= 10 && c < 42) {
        FoldOrder S{(const char*)F.WPT(), (const char*)F.PMS(), c - 10}; EpiFold E{F.WAB()};
        pg8::gemm_phase<EpiFold, FoldOrder, false>(F.wave, F.lds + RING_OFF, 1024, 256, 256, S, E, nullptr);
    }
    CvtSlot job{0, 0, 0};
    { int first = 0, cnt = 0;
      for (int i = 0; i <= c; ++i) { first += cnt; cnt = i < 64 ? CVT_P1_LO + (int)((CVT_P1_ADJ8 >> (4 * (i & 7))) & 15u) - 8 : (i - 64 < 189 ? CVT_P1_HI + (int)((CVT_P1_ADJ7 >> (4 * ((i - 64) % 7))) & 15u) - 8 : CVT_P1_HI); }
      job.first = first; job.count = cnt; job.slot = c < 64 ? c % 8 - 1 : (c - 64) % 7 - 1; }
#if PROBE_SUB > 0
    job.count = 0;
#endif
    PT_MARK(30, 0);
    if (job.slot < 0) cvt_run(job, F.wave);
    { DenseOrder S{(const char*)F.HN(), (const char*)(F.WIN() + (size_t)UOFF * 2048), 64, 4, 256, F.G, c, 2048, 2048}; EpiProj E{F.PROJ(), job, F.wave, UOFF};
      pg8::gemm_phase<EpiProj, DenseOrder, false>(F.wave, F.lds + RING_OFF, 2048, 2048, 2048, S, E, nullptr); }
    PT_MARK(30, 1); PT_MARK(31, 0);
    { DenseOrder S{(const char*)F.HN8(), (const char*)F.WIN8(), 64, 21, 1344, F.G, c, 1024, 1024}; EpiGate E{F.GATE(), F.PROJ(), job, F.wave, 1};
      pg8::gemm_phase<EpiGate, DenseOrder, false, false, true>(F.wave, F.lds + RING_OFF, 1024, 1024, 1024, S, E, nullptr); PT_MARK(31, 1); }
}
__device__ __forceinline__ void p2_phase(Frame& F, const Args& A) { const int idx = F.vcu;
#if CVT_P2_N > 0
    const CvtSlot job{CVT_P1_ITEMS + (int)blockIdx.x * CVT_P2_N, CVT_P2_N, 0};
#pragma unroll 1
    for (int pass = 0; pass < 2; ++pass) {
        if ((pass == 0) == ((((idx >> 1) & 63) & 1) != 0)) cvt_run(job, F.wave);
        else if (idx < 256) attn_unit(F, A, idx >> 7, (idx >> 1) & 63, idx & 1);
    }
#else
    if (idx < 256) attn_unit(F, A, idx >> 7, (idx >> 1) & 63, idx & 1);
#endif
}
__device__ __forceinline__ void p3_phase(Frame& F, int c) {
    const int first = CVT_P1_ITEMS + 256 * CVT_P2_N + c * CVT_P3_N, npre = STAG_NPRE(c, CVT_P3_N);
#pragma unroll 1
    for (int pass = 0; pass < 3; ++pass) {
        if (pass != 1) { const CvtSlot job{first + (pass ? npre : 0), pass ? CVT_P3_N - npre : npre, 0}; if (job.count > 0) cvt_run(job, F.wave); }
        else { DenseOrder S{(const char*)F.AP(), (const char*)F.WAB(), 64, 8, 512, F.G, c, 2048, 2048}; EpiBranch E{F.GATE(), F.MERGED()};
               pg8::gemm_phase<EpiBranch, DenseOrder, false>(F.wave, F.lds + RING_OFF, 2048, 2048, 2048, S, E, nullptr); }
    }
}
__device__ __forceinline__ void p4_phase(Frame& F, const Args& A, int c) {
    const int first = CVT_P1_ITEMS + 256 * (CVT_P2_N + CVT_P3_N) + c * CVT_P4_N, npre = STAG_NPRE(c, CVT_P4_N);
#pragma unroll 1
    for (int pass = 0; pass < 3; ++pass) {
        if (pass != 1) { const CvtSlot job{first + (pass ? npre : 0), pass ? CVT_P4_N - npre : npre, 0}; if (job.count > 0) cvt_run(job, F.wave); }
        else { DenseOrder S{(const char*)F.MERGED(), (const char*)F.WO(), 64, 8, 512, F.G, c, 2048, 2048}; EpiOut E{A.in[I_X], F.H1B(), F.SSQ(), F.H8()};
               pg8::gemm_phase<EpiOut, DenseOrder, false>(F.wave, F.lds + RING_OFF, 2048, 2048, 2048, S, E, nullptr); }
    }
}
__device__ __forceinline__ void p6_phase(Frame& F) {
#if MK_LAUNCHES == 1
    const int nu = moe_setup_both(F);
#else
    const int nu = moe_setup<4, true>(F);
#endif
    MoeOrder S{(LAS const int*)(F.lds + L_UD), nu, (const char*)F.H8(), (const char*)F.WGU(), 0, (size_t)1024 * 2048, (size_t)256 * 2048};
    EpiGU E{F.HID(), (LAS const float*)(F.lds + L_TAB) + 1024};
    pg8::gemm_phase<EpiGU, MoeOrder, true, false, true>(F.wave, F.lds + RING_OFF, 1024, 1024, 1024, S, E, (LAS const unsigned*)(F.lds + L_TAB));
}
__device__ __forceinline__ void p7_phase(Frame& F) {
#if STAG_TEST > 0
    if (blockIdx.x & 1) { const unsigned long long t0 = __builtin_amdgcn_s_memrealtime(); while (__builtin_amdgcn_s_memrealtime() - t0 < (unsigned long long)STAG_TEST) __builtin_amdgcn_s_sleep(4); }
#endif
#if MK_LAUNCHES == 1
    const int nu = __builtin_amdgcn_readfirstlane((int)F.MISC[17]); constexpr int UDO = L_UD2, TBO = L_TAB2;
#else
    const int nu = moe_setup<8, false>(F); constexpr int UDO = L_UD, TBO = L_TAB;
#endif
    MoeOrder S{(LAS const int*)(F.lds + UDO), nu, (const char*)F.HID(), (const char*)F.WD(), (size_t)DEXP, (size_t)2048 * 512, (size_t)256 * 512};
    EpiDown E{F.Y(), (LAS const float*)(F.lds + TBO)};
    pg8::gemm_phase<EpiDown, MoeOrder, false, false, true>(F.wave, F.lds + RING_OFF, 256, 256, 256, S, E, nullptr);
}
__device__ __forceinline__ void p8_phase(Frame& F, const Args& A) {
    LAS int* es = (LAS int*)(F.lds + L_ESTART);
#if MK_LAUNCHES != 1
    if (F.wave == 0) { const int ln = lane_id(); const int cnt = (int)__hip_atomic_load(F.ctl + CW_CNT + CNT_STRIDE * ln, __ATOMIC_RELAXED, __HIP_MEMORY_SCOPE_AGENT); int sc = cnt;
#pragma unroll
        for (int o = 1; o < 64; o <<= 1) { const int a = __shfl_up(sc, o); if (ln >= o) sc += a; }
        es[ln] = sc - cnt; }
    __syncthreads();
#endif
    const int lane = lane_id();
    for (int t = F.vcu * NWAVES + F.wave; t < M; t += F.G * NWAVES) final_row(F, A, t, es, lane);
}

__global__ void __launch_bounds__(NWAVES * 64, 2) mega_fwd(Args args) {
    extern __shared__ __attribute__((aligned(16))) unsigned char lds_raw[];
    Frame F;
    F.lds = (LAS unsigned char*)lds_raw;
    F.MISC = (volatile LAS unsigned*)(F.lds + L_MISC);
    F.wave = __builtin_amdgcn_readfirstlane((int)(threadIdx.x >> 6));
    F.G = gridDim.x; { const int bx = blockIdx.x; F.vcu = (F.G % 8 == 0) ? (bx % 8) * (F.G / 8) + bx / 8 : bx; }
    unsigned char* ws = args.ws;
    F.ctl = (unsigned*)(ws + WS_CTL);
    F.ws = ws;
    for (int u = F.tid(); u < (LDS_BYTES - RING_BYTES) / 4; u += NWAVES * 64) ((LAS unsigned*)(F.lds + RING_BYTES))[u] = 0u;
    __syncthreads();
    if (F.tid() == 0) { LAS unsigned long long* pp = (LAS unsigned long long*)(F.lds + L_MISC + 160);
        pp[0] = (unsigned long long)args.in[I_WG]; pp[1] = (unsigned long long)args.in[I_WU]; pp[2] = (unsigned long long)args.in[I_WD]; pp[3] = (unsigned long long)args.in[I_NFFN]; pp[4] = (unsigned long long)ws; }
    __syncthreads();
#if MK_LAUNCHES == 1
    XcdBarrier bar = xcd_barrier_post((unsigned*)(F.ctl + CW_BAR), F.MISC + 8);
#define GRID_BAR() xcd_barrier(bar)
#else
#define GRID_BAR() do { } while (0)
#endif
    const int lo = args.ph_lo, hi = args.ph_hi;
#define IN(k) (lo <= (k) && (k) < hi)
#define BOTH(k) (IN(k) && IN((k) + 1))
#define DUP(k) (PROBE_DUP == (k))
    const int c = (int)blockIdx.x;

    PT_MARK(0, 0);
    if (IN(0)) { p0_prologue(F, args); p0_probe(F, args); if (DUP(0)) { GRID_BAR(); p0_prologue(F, args); } if (BOTH(0)) GRID_BAR(); }
    PT_MARK(0, 1);
    PT_MARK(1, 0);
    if (IN(1)) { PT_MARK(35, 0); p1_phase(F, args, c); PT_MARK(35, 1); if (DUP(1)) { GRID_BAR(); p1_phase(F, args, c); } if (BOTH(1)) GRID_BAR(); }
    PT_MARK(1, 1);
    PT_MARK(2, 0);
    if (IN(2)) { PT_MARK(25, 0); p2_phase(F, args); PT_MARK(25, 1); if (DUP(2)) { _Pragma("unroll 1") for (int r_ = 0; r_ < PROBE_REP; ++r_) { GRID_BAR(); p2_phase(F, args); } } if (BOTH(2)) GRID_BAR(); }
    PT_MARK(2, 1);
    PT_MARK(3, 0);
    if (IN(3)) { p3_phase(F, c); if (DUP(3)) { GRID_BAR(); p3_phase(F, c); } if (BOTH(3)) GRID_BAR(); }
    PT_MARK(3, 1);
    PT_MARK(4, 0);
    if (IN(4)) { p4_phase(F, args, c); if (DUP(4)) { GRID_BAR(); p4_phase(F, args, c); } if (BOTH(4)) GRID_BAR(); }
    PT_MARK(4, 1);
    PT_MARK(5, 0);
    if (IN(5)) { if (F.vcu < M / 64) router_group(F, args, F.vcu); if (DUP(5)) { GRID_BAR(); if (F.vcu < M / 64) router_group(F, args, F.vcu, 1); } if (BOTH(5)) GRID_BAR(); }
    PT_MARK(5, 1);
    PT_MARK(6, 0);
    if (IN(6)) { p6_phase(F); if (DUP(6)) { GRID_BAR(); p6_phase(F); } if (BOTH(6)) GRID_BAR(); }
    PT_MARK(6, 1);
    PT_MARK(7, 0);
    if (IN(7)) { p7_phase(F); if (DUP(7)) { _Pragma("unroll 1") for (int r_ = 0; r_ < PROBE_REP; ++r_) { GRID_BAR(); p7_phase(F); } } if (BOTH(7)) GRID_BAR(); }
    PT_MARK(7, 1);
    PT_MARK(8, 0);
    if (IN(8)) { p8_phase(F, args); if (DUP(8)) { GRID_BAR(); p8_phase(F, args); } }
    PT_MARK(8, 1);
#if PROBE_TIME >= 0
    if (PROBE_SET((int)blockIdx.x) && F.tid() == 0) { const unsigned long long pt0 = ((unsigned long long)F.MISC[33] << 32) | F.MISC[32], pt1 = ((unsigned long long)F.MISC[35] << 32) | F.MISC[34];
        const unsigned long long te = __builtin_amdgcn_s_memrealtime(), d = (unsigned long long)PROBE_MULT * (pt1 - pt0); while (__builtin_amdgcn_s_memrealtime() - te < d) __builtin_amdgcn_s_sleep(8); }
#endif
#undef IN
#undef BOTH
#undef DUP
}

extern "C" void kernel_launch(void* const* d_in, const int* in_sizes, int n_in, void* d_out, int out_size, void* d_ws, size_t ws_size, hipStream_t stream) {
    static int grid = 0;
    if (grid == 0) {
        if (n_in != 20 || out_size != M * DM || ws_size < WS_END + (PROBE_DUP == 5 ? 16 * MiB : 0)) { fprintf(stderr, "kernel_launch: unexpected shapes (n_in %d, out %d, ws %zu); nothing launched\n", n_in, out_size, ws_size); grid = -1; return; }
        int dev = 0, cus = 0, per_cu = 0;
        if (hipGetDevice(&dev) != hipSuccess || hipDeviceGetAttribute(&cus, hipDeviceAttributeMultiprocessorCount, dev) != hipSuccess) { grid = -1; return; }
        if (hipFuncSetAttribute((const void*)mega_fwd, hipFuncAttributeMaxDynamicSharedMemorySize, LDS_BYTES) != hipSuccess) { fprintf(stderr, "kernel_launch: hipFuncSetAttribute failed\n"); grid = -1; return; }
        if (hipOccupancyMaxActiveBlocksPerMultiprocessor(&per_cu, (const void*)mega_fwd, NWAVES * 64, LDS_BYTES) != hipSuccess || per_cu < 1) { fprintf(stderr, "kernel_launch: occupancy query says %d\n", per_cu); }
        (void)hipGetLastError();
        grid = cus;
        if (grid != 256) { fprintf(stderr, "kernel_launch: built for 256 CUs, device has %d; nothing launched\n", grid); grid = -1; return; }
    }
    if (grid < 0) return;
    (void)hipMemsetAsync((char*)d_ws + WS_CTL, 0, CTL_ZERO_BYTES, stream);
    Args a{};
    for (int i = 0; i < 20; ++i) a.in[i] = (const float*)d_in[i];
    a.out = (float*)d_out; a.ws = (unsigned char*)d_ws;
#if MK_LAUNCHES == 1
    a.ph_lo = 0; a.ph_hi = NPHASE;
    hipLaunchKernelGGL(mega_fwd, dim3(grid), dim3(NWAVES * 64), LDS_BYTES, stream, a);
#else
    for (int p = 0; p < NPHASE; ++p) { a.ph_lo = p; a.ph_hi = p + 1; hipLaunchKernelGGL(mega_fwd, dim3(grid), dim3(NWAVES * 64), LDS_BYTES, stream, a); }
#endif
}
```
